# Optimizing an MI355X kernel written in HIP

```python
import jax, jax.numpy as jnp
from jax import lax
import numpy as np

D_MODEL = 1024
BATCH = 8
SEQ = 2048
DEPTH = 2
DEC_BATCH = 128
DEC_SEQ = 8
PAST_LEN = 16384
PAGE_SIZE = 128

N_EVEN = (DEPTH + 1) // 2
N_ODD = DEPTH // 2
MIX_HALF = D_MODEL // 2
A_WIDTH = MIX_HALF
CONV_W = 3
B_KDIM = 128
B_VDIM = 128
B_HEADS = MIX_HALF // B_VDIM
C_KDIM = 128
C_VDIM = 128
C_HEADS = MIX_HALF // C_VDIM
D_HDIM = 64
D_HEADS = MIX_HALF // D_HDIM
D_WIDTH = D_HEADS * D_HDIM
D_W_RANK = 64
D_A_RANK = 64
D_G_RANK = 128
D_FF = ((8 * D_MODEL // 3 + 127) // 128) * 128
N_MEM = 256
X_HEADS = 4
X_HDIM = D_MODEL // X_HEADS

CHUNK = 64
NORM_EPS = 1e-6
RWKV_GN_EPS = 64e-5
ROPE_BASE = 10000.0

EVEN_SIZES = (A_WIDTH, A_WIDTH, A_WIDTH, B_HEADS * B_KDIM, B_HEADS * B_KDIM, B_HEADS * B_VDIM, B_HEADS * B_VDIM)
C_SIZES = (C_HEADS * C_KDIM, C_HEADS * C_KDIM, C_HEADS * C_VDIM, C_HEADS * C_VDIM)
D_SIZES = (D_WIDTH, D_WIDTH, D_WIDTH, D_W_RANK, D_A_RANK, D_G_RANK)
EVEN_IN = sum(EVEN_SIZES)
C_IN = sum(C_SIZES)
D_IN = sum(D_SIZES)
ODD_IN = C_IN + D_IN
EVEN_OUT = A_WIDTH + B_HEADS * B_VDIM
ODD_OUT = C_HEADS * C_VDIM + D_WIDTH

kernel_name = "hybrid_conv_hgrn2_retnet_rwkv7_macaron_step"


def _split(t, sizes):
    idx = np.cumsum(np.array(sizes))[:-1].tolist()
    return jnp.split(t, idx, axis=-1)


def _heads(t, n):
    return t.reshape(t.shape[:-1] + (n, t.shape[-1] // n))


def _merge(t):
    return t.reshape(t.shape[:-2] + (t.shape[-2] * t.shape[-1],))


def rmsnorm(x, g):
    xf = x.astype(jnp.float32)
    y = xf * lax.rsqrt(jnp.mean(xf * xf, axis=-1, keepdims=True) + NORM_EPS)
    return (y * g.astype(jnp.float32)).astype(x.dtype)


def _head_rmsnorm(o, g):
    o = o * lax.rsqrt(jnp.mean(o * o, axis=-1, keepdims=True) + NORM_EPS)
    return _merge(o) * g.astype(jnp.float32)


def swiglu(x, w_gu, w_down):
    gate, up = jnp.split(x @ w_gu, 2, axis=-1)
    return (jax.nn.silu(gate) * up) @ w_down


def _rope(t, pos):
    half = t.shape[-1] // 2
    inv = ROPE_BASE ** (-jnp.arange(half, dtype=jnp.float32) / half)
    ang = pos.astype(jnp.float32)[:, None] * inv[None, :]
    cos = jnp.cos(ang)[None, :, None, :]
    sin = jnp.sin(ang)[None, :, None, :]
    t1, t2 = t[..., :half], t[..., half:]
    return jnp.concatenate([t1 * cos - t2 * sin, t1 * sin + t2 * cos], axis=-1)


def _chunk_len(T):
    return CHUNK if T % CHUNK == 0 else T


def _to_chunks(t, C):
    Bn, T, H, d = t.shape
    return t.reshape(Bn, T // C, C, H, d).transpose(1, 0, 3, 2, 4)


def _from_chunks(o):
    n, Bn, H, C, d = o.shape
    return o.transpose(1, 0, 3, 2, 4).reshape(Bn, n * C, H, d)


def gla_chunked(q, k, v, logf, S0):
    C = _chunk_len(q.shape[1])
    mask = jnp.tril(jnp.ones((C, C), dtype=bool))[:, :, None]

    def step(S, inp):
        qc, kc, vc, gc = inp
        b = jnp.cumsum(gc, axis=2)
        inter = jnp.einsum('bhck,bhkv->bhcv', qc * jnp.exp(b), S)
        diff = b[:, :, :, None, :] - b[:, :, None, :, :]
        dec = jnp.exp(jnp.where(mask, diff, -jnp.inf))
        att = jnp.einsum('bhik,bhjk,bhijk->bhij', qc, kc, dec)
        intra = jnp.einsum('bhij,bhjv->bhiv', att, vc)
        b_last = b[:, :, -1:, :]
        S = jnp.exp(b_last[:, :, 0, :])[..., None] * S + jnp.einsum(
            'bhck,bhcv->bhkv', kc * jnp.exp(b_last - b), vc)
        return S, inter + intra

    S, o = lax.scan(step, S0, (_to_chunks(q, C), _to_chunks(k, C), _to_chunks(v, C), _to_chunks(logf, C)))
    return _from_chunks(o), S


def retention_chunked(q, k, v, S0):
    C = _chunk_len(q.shape[1])
    lg = jnp.log1p(-jnp.exp2(-5.0 - jnp.arange(C_HEADS, dtype=jnp.float32)))[:, None]
    idx = jnp.arange(C, dtype=jnp.float32)
    q_dec = jnp.exp(lg * (idx + 1.0))[None, :, :, None]
    k_dec = jnp.exp(lg * (C - 1.0 - idx))[None, :, :, None]
    rel = idx[:, None] - idx[None, :]
    dmask = jnp.where(rel >= 0, jnp.exp(lg[:, :, None] * jnp.maximum(rel, 0.0)), 0.0)
    chunk_dec = jnp.exp(lg * C)[None, :, :, None]

    def step(S, inp):
        qc, kc, vc = inp
        inter = jnp.einsum('bhck,bhkv->bhcv', qc, S) * q_dec
        att = jnp.einsum('bhik,bhjk->bhij', qc, kc) * dmask
        intra = jnp.einsum('bhij,bhjv->bhiv', att, vc)
        S = chunk_dec * S + jnp.einsum('bhck,bhcv->bhkv', kc * k_dec, vc)
        return S, inter + intra

    S, o = lax.scan(step, S0, (_to_chunks(q, C), _to_chunks(k, C), _to_chunks(v, C)))
    return _from_chunks(o), S


def rwkv7_scan(r, w, k, v, a_vec, b_vec, S0):
    def step(S, inp):
        rt, wt, kt, vt, at, bt = inp
        sa = jnp.einsum('bhvk,bhk->bhv', S, at)
        S = S * wt[:, :, None, :] + sa[..., None] * bt[:, :, None, :] + vt[..., None] * kt[:, :, None, :]
        return S, jnp.einsum('bhvk,bhk->bhv', S, rt)

    xs = tuple(t.transpose(1, 0, 2, 3) for t in (r, w, k, v, a_vec, b_vec))
    S, o = lax.scan(step, S0, xs)
    return o.transpose(1, 0, 2, 3), S


def even_mixer(h, conv_buf, s_hgrn, w_in, w_out, conv_w, lb, gnorm):
    f32 = jnp.float32
    p = (h @ w_in).astype(f32)
    v_a, b_a, c_a, q_b, f_b, i_b, g_b = _split(p, EVEN_SIZES)
    u = c_a * v_a
    T = u.shape[1]
    ext = jnp.concatenate([conv_buf.astype(f32), u], axis=1)
    cw = conv_w.astype(f32)
    conv = sum(ext[:, j:j + T] * cw[j] for j in range(CONV_W))
    y_a = b_a * conv
    new_buf = ext[:, T:]
    lbf = lb.astype(f32)
    f = lbf + (1.0 - lbf) * jax.nn.sigmoid(f_b)
    q = _heads(jax.nn.silu(q_b), B_HEADS)
    k = _heads(1.0 - f, B_HEADS)
    logf = _heads(jnp.log(f), B_HEADS)
    v = _heads(i_b, B_HEADS)
    o, s_new = gla_chunked(q, k, v, logf, s_hgrn.astype(f32))
    y_b = _head_rmsnorm(o, gnorm) * jax.nn.silu(g_b)
    y = jnp.concatenate([y_a, y_b], axis=-1).astype(h.dtype) @ w_out
    return y, new_buf, s_new


def odd_mixer(h, pos, s_ret, s_rwkv, shift_prev, w_in, w_out, ret_gnorm, mu, w0, w2, a0, a2, g2,
              k_k, k_a, r_k, lnx_g, lnx_b):
    f32 = jnp.float32
    p = (h @ w_in).astype(f32)
    pc, pd = p[..., :C_IN], p[..., C_IN:]
    q, k, v, g = _split(pc, C_SIZES)
    q = _rope(_heads(q, C_HEADS), pos)
    k = _rope(_heads(k, C_HEADS), pos) * (C_KDIM ** -0.5)
    o_c, s_ret_new = retention_chunked(q, k, _heads(v, C_HEADS), s_ret.astype(f32))
    y_c = _head_rmsnorm(o_c, ret_gnorm) * jax.nn.silu(g)
    prev = jnp.concatenate([shift_prev.astype(f32)[:, None], pd[:, :-1]], axis=1)
    pm = pd + mu.astype(f32) * (prev - pd)
    r, kd, vd, w_dn, a_dn, g_dn = _split(pm, D_SIZES)
    w_log = -jax.nn.softplus(-(w0.astype(f32) + jnp.tanh(w_dn) @ w2.astype(f32))) - 0.5
    decay = jnp.exp(-jnp.exp(w_log))
    a = jax.nn.sigmoid(a0.astype(f32) + a_dn @ a2.astype(f32))
    gate = jax.nn.sigmoid(g_dn) @ g2.astype(f32)
    kk = _heads(kd * k_k.astype(f32), D_HEADS)
    kk = kk / jnp.maximum(jnp.linalg.norm(kk, axis=-1, keepdims=True), 1e-12)
    kd = kd * (1.0 + (a - 1.0) * k_a.astype(f32))
    r_h, k_h, v_h, a_h = (_heads(t, D_HEADS) for t in (r, kd, vd, a))
    o_d, s_rwkv_new = rwkv7_scan(r_h, _heads(decay, D_HEADS), k_h, v_h, -kk, kk * a_h, s_rwkv.astype(f32))
    mean = jnp.mean(o_d, axis=-1, keepdims=True)
    var = jnp.mean(jnp.square(o_d - mean), axis=-1, keepdims=True)
    on = _merge((o_d - mean) * lax.rsqrt(var + RWKV_GN_EPS)) * lnx_g.astype(f32) + lnx_b.astype(f32)
    bonus = _merge(jnp.sum(r_h * k_h * r_k.astype(f32), axis=-1, keepdims=True) * v_h)
    y_d = (on + bonus) * gate
    y = jnp.concatenate([y_c, y_d], axis=-1).astype(h.dtype) @ w_out
    return y, s_ret_new, s_rwkv_new, pd[:, -1]


def mem_kv(mem, mem_g, w_kv):
    k, v = jnp.split(rmsnorm(mem, mem_g) @ w_kv, 2, axis=-1)
    return _heads(k, X_HEADS), _heads(v, X_HEADS)


def cross_attend(h, mk, mv, wq, wo):
    q = _heads(h @ wq, X_HEADS)
    s = jnp.einsum('bthd,bmhd->bhtm', q, mk.astype(q.dtype)).astype(jnp.float32) * (X_HDIM ** -0.5)
    pr = jax.nn.softmax(s, axis=-1).astype(h.dtype)
    o = jnp.einsum('bhtm,bmhd->bthd', pr, mv.astype(h.dtype))
    return _merge(o) @ wo


def trunk(x, pos0, conv_buf, s_hgrn, s_ret, s_rwkv, s_shift, mem_k, mem_v, prm):
    T = x.shape[1]
    pos = pos0 + jnp.arange(T, dtype=jnp.int32)
    lb_all = jnp.cumsum(jax.nn.softmax(prm['hgrn_lb'].astype(jnp.float32), axis=0), axis=0)
    n_conv, n_hgrn, n_ret, n_rwkv, n_shift = [], [], [], [], []
    for l in range(DEPTH):
        x = x + 0.5 * swiglu(rmsnorm(x, prm['ffn1_norm'][l]), prm['ffn1_w_gu'][l], prm['ffn1_w_down'][l])
        h = rmsnorm(x, prm['mix_norm'][l])
        j = l // 2
        if l % 2 == 0:
            y, cb, sh = even_mixer(h, conv_buf[j], s_hgrn[j], prm['even_w_in'][j], prm['even_w_out'][j],
                                   prm['conv_w'][j], lb_all[j], prm['hgrn_gnorm'][j])
            n_conv.append(cb.astype(x.dtype))
            n_hgrn.append(sh.astype(x.dtype))
        else:
            y, sr, sw, ss = odd_mixer(h, pos, s_ret[j], s_rwkv[j], s_shift[j], prm['odd_w_in'][j],
                                      prm['odd_w_out'][j], prm['ret_gnorm'][j], prm['rwkv_mu'][j],
                                      prm['rwkv_w0'][j], prm['rwkv_w2'][j], prm['rwkv_a0'][j],
                                      prm['rwkv_a2'][j], prm['rwkv_g2'][j], prm['rwkv_k_k'][j],
                                      prm['rwkv_k_a'][j], prm['rwkv_r_k'][j], prm['rwkv_lnx_g'][j],
                                      prm['rwkv_lnx_b'][j])
            n_ret.append(sr.astype(x.dtype))
            n_rwkv.append(sw.astype(x.dtype))
            n_shift.append(ss.astype(x.dtype))
        x = x + y.astype(x.dtype)
        x = x + cross_attend(rmsnorm(x, prm['xattn_norm'][l]), mem_k[l], mem_v[l],
                             prm['xattn_wq'][l], prm['xattn_wo'][l])
        x = x + 0.5 * swiglu(rmsnorm(x, prm['ffn2_norm'][l]), prm['ffn2_w_gu'][l], prm['ffn2_w_down'][l])
    y = rmsnorm(x, prm['final_norm'])
    return (y, jnp.stack(n_conv), jnp.stack(n_hgrn), jnp.stack(n_ret), jnp.stack(n_rwkv), jnp.stack(n_shift))


def setup_inputs(seed: int = 0) -> dict:
    key = jax.random.key(seed)
    keys = jax.random.split(key, 64)
    counter = iter(range(64))
    f32 = jnp.float32

    def nrm(shape, scale=1.0):
        return jax.random.normal(keys[next(counter)], shape, f32) * scale

    def gain(shape):
        return 1.0 + 0.05 * jax.random.normal(keys[next(counter)], shape, f32)

    def unif(shape, lo, hi):
        return jax.random.uniform(keys[next(counter)], shape, f32, lo, hi)

    d = D_MODEL
    return {
        'x_prompt': nrm((BATCH, SEQ, d)),
        'x_sample': nrm((DEC_BATCH, DEC_SEQ, d)),
        'state_conv': nrm((N_EVEN, DEC_BATCH, CONV_W - 1, A_WIDTH)),
        'state_hgrn': nrm((N_EVEN, DEC_BATCH, B_HEADS, B_KDIM, B_VDIM), 0.5),
        'state_ret': nrm((N_ODD, DEC_BATCH, C_HEADS, C_KDIM, C_VDIM)),
        'state_rwkv': nrm((N_ODD, DEC_BATCH, D_HEADS, D_HDIM, D_HDIM), 0.5),
        'state_shift': nrm((N_ODD, DEC_BATCH, D_IN)),
        'cache_mem_k': nrm((DEPTH, DEC_BATCH, N_MEM, X_HEADS, X_HDIM)),
        'cache_mem_v': nrm((DEPTH, DEC_BATCH, N_MEM, X_HEADS, X_HDIM)),
        'mem_prompt': nrm((BATCH, N_MEM, d)),
        'ffn1_norm': gain((DEPTH, d)),
        'ffn1_w_gu': nrm((DEPTH, d, 2 * D_FF), d ** -0.5),
        'ffn1_w_down': nrm((DEPTH, D_FF, d), D_FF ** -0.5),
        'mix_norm': gain((DEPTH, d)),
        'even_w_in': nrm((N_EVEN, d, EVEN_IN), d ** -0.5),
        'even_w_out': nrm((N_EVEN, EVEN_OUT, d), EVEN_OUT ** -0.5),
        'conv_w': nrm((N_EVEN, CONV_W, A_WIDTH), CONV_W ** -0.5),
        'hgrn_lb': nrm((N_EVEN + 1, B_HEADS * B_KDIM), 0.5),
        'hgrn_gnorm': gain((N_EVEN, B_HEADS * B_VDIM)),
        'odd_w_in': nrm((N_ODD, d, ODD_IN), d ** -0.5),
        'odd_w_out': nrm((N_ODD, ODD_OUT, d), ODD_OUT ** -0.5),
        'ret_gnorm': gain((N_ODD, C_HEADS * C_VDIM)),
        'rwkv_mu': unif((N_ODD, D_IN), 0.0, 1.0),
        'rwkv_w0': unif((N_ODD, D_WIDTH), -5.0, 0.5),
        'rwkv_w2': nrm((N_ODD, D_W_RANK, D_WIDTH), D_W_RANK ** -0.5),
        'rwkv_a0': nrm((N_ODD, D_WIDTH), 0.1),
        'rwkv_a2': nrm((N_ODD, D_A_RANK, D_WIDTH), D_A_RANK ** -0.5),
        'rwkv_g2': nrm((N_ODD, D_G_RANK, D_WIDTH), D_G_RANK ** -0.5),
        'rwkv_k_k': 0.85 + nrm((N_ODD, D_WIDTH), 0.05),
        'rwkv_k_a': gain((N_ODD, D_WIDTH)),
        'rwkv_r_k': nrm((N_ODD, D_HEADS, D_HDIM), 0.1),
        'rwkv_lnx_g': gain((N_ODD, D_WIDTH)),
        'rwkv_lnx_b': nrm((N_ODD, D_WIDTH), 0.01),
        'xattn_norm': gain((DEPTH, d)),
        'mem_norm': gain((DEPTH, d)),
        'xattn_wq': nrm((DEPTH, d, d), d ** -0.5),
        'xattn_wkv': nrm((DEPTH, d, 2 * d), d ** -0.5),
        'xattn_wo': nrm((DEPTH, d, d), d ** -0.5),
        'ffn2_norm': gain((DEPTH, d)),
        'ffn2_w_gu': nrm((DEPTH, d, 2 * D_FF), d ** -0.5),
        'ffn2_w_down': nrm((DEPTH, D_FF, d), D_FF ** -0.5),
        'final_norm': gain((d,)),
    }


def reference(x_prompt, x_sample, state_conv, state_hgrn, state_ret, state_rwkv, state_shift,
              cache_mem_k, cache_mem_v, mem_prompt, ffn1_norm, ffn1_w_gu, ffn1_w_down, mix_norm,
              even_w_in, even_w_out, conv_w, hgrn_lb, hgrn_gnorm, odd_w_in, odd_w_out, ret_gnorm,
              rwkv_mu, rwkv_w0, rwkv_w2, rwkv_a0, rwkv_a2, rwkv_g2, rwkv_k_k, rwkv_k_a, rwkv_r_k,
              rwkv_lnx_g, rwkv_lnx_b, xattn_norm, mem_norm, xattn_wq, xattn_wkv, xattn_wo,
              ffn2_norm, ffn2_w_gu, ffn2_w_down, final_norm):
    prm = {
        'ffn1_norm': ffn1_norm, 'ffn1_w_gu': ffn1_w_gu, 'ffn1_w_down': ffn1_w_down,
        'mix_norm': mix_norm, 'even_w_in': even_w_in, 'even_w_out': even_w_out, 'conv_w': conv_w,
        'hgrn_lb': hgrn_lb, 'hgrn_gnorm': hgrn_gnorm, 'odd_w_in': odd_w_in, 'odd_w_out': odd_w_out,
        'ret_gnorm': ret_gnorm, 'rwkv_mu': rwkv_mu, 'rwkv_w0': rwkv_w0, 'rwkv_w2': rwkv_w2,
        'rwkv_a0': rwkv_a0, 'rwkv_a2': rwkv_a2, 'rwkv_g2': rwkv_g2, 'rwkv_k_k': rwkv_k_k,
        'rwkv_k_a': rwkv_k_a, 'rwkv_r_k': rwkv_r_k, 'rwkv_lnx_g': rwkv_lnx_g, 'rwkv_lnx_b': rwkv_lnx_b,
        'xattn_norm': xattn_norm, 'xattn_wq': xattn_wq, 'xattn_wo': xattn_wo,
        'ffn2_norm': ffn2_norm, 'ffn2_w_gu': ffn2_w_gu, 'ffn2_w_down': ffn2_w_down,
        'final_norm': final_norm,
    }
    mks, mvs = [], []
    for l in range(DEPTH):
        mk, mv = mem_kv(mem_prompt, mem_norm[l], xattn_wkv[l])
        mks.append(mk)
        mvs.append(mv)
    mem_k_p = jnp.stack(mks)
    mem_v_p = jnp.stack(mvs)
    dt = x_prompt.dtype
    zc = jnp.zeros((N_EVEN, BATCH, CONV_W - 1, A_WIDTH), dt)
    zh = jnp.zeros((N_EVEN, BATCH, B_HEADS, B_KDIM, B_VDIM), dt)
    zr = jnp.zeros((N_ODD, BATCH, C_HEADS, C_KDIM, C_VDIM), dt)
    zw = jnp.zeros((N_ODD, BATCH, D_HEADS, D_HDIM, D_HDIM), dt)
    zs = jnp.zeros((N_ODD, BATCH, D_IN), dt)
    y_prompt, conv_p, hgrn_p, ret_p, rwkv_p, shift_p = trunk(
        x_prompt, 0, zc, zh, zr, zw, zs, mem_k_p, mem_v_p, prm)
    y_sample, conv_s, hgrn_s, ret_s, rwkv_s, shift_s = trunk(
        x_sample, PAST_LEN, state_conv, state_hgrn, state_ret, state_rwkv, state_shift,
        cache_mem_k, cache_mem_v, prm)
    return (y_prompt, y_sample, conv_p, hgrn_p, ret_p, rwkv_p, shift_p, mem_k_p, mem_v_p,
            conv_s, hgrn_s, ret_s, rwkv_s, shift_s)
```

```cpp
#include <hip/hip_runtime.h>
#include <hip/hip_cooperative_groups.h>
#include <cstdio>
#include <cstdint>
namespace pg8 {
#define PG8_LAS __attribute__((address_space(3)))
typedef unsigned short bf16_t;
typedef short bf16x8 __attribute__((ext_vector_type(8)));
typedef float f32x4 __attribute__((ext_vector_type(4)));
typedef unsigned u32x4 __attribute__((ext_vector_type(4)));
constexpr int BM = 256, BK = 64, HALF = 128, HTB = HALF * BK * 2  , STAGE_BYTES = 8 * HTB, NXCD = 8, WGM = 8;

__host__ __device__ __forceinline__ int lds_byte(int r, int c) { const int st = (r >> 4) * 2 + (c >> 5), rr = r & 15, cc = c & 31, ob = rr * 64 + cc * 2; return st * 1024 + (ob ^ (((ob >> 9) & 1) << 5)); }
__host__ __device__ __forceinline__ void stage_rc(int b, int& R, int& C) { const int st = b / 1024, sb = b % 1024, swz = sb ^ (((sb >> 9) & 1) << 5); R = (st >> 1) * 16 + swz / 64; C = (st & 1) * 32 + (swz % 64) / 2; }
__host__ __device__ __forceinline__ int perm32(int rho) { const int n = rho >> 4, i = rho & 15; return 8 * (i >> 2) + 4 * n + (i & 3); }

struct Unit { int pm, pn, ks; };
struct Gemm { const bf16_t* A; const bf16_t* Bt; int M, N, K, ld; };

struct StaticOrder {
    int nM, nN, nwg, G, c, S;
    __host__ __device__ void init(int M, int N, int G_, int c_, int S_ = 1) { nM = M / BM; nN = N / BM; nwg = nM * nN; G = G_; c = c_; S = S_; }
    __host__ __device__ bool next(int i, Unit& u) const {
        const long L = (long)i * G + c;
        if (S > 1) { if (L >= (long)nwg * S) return false; const int r = (int)(L % nwg); u.ks = (int)(L / nwg); u.pm = r / nN; u.pn = r % nN; return true; }
        u.ks = 0;
        if (L >= nwg) return false;
        int wgid = (int)L; { const int q = nwg / NXCD, r = nwg % NXCD, xcd = wgid % NXCD, off = wgid / NXCD; wgid = (xcd < r ? xcd * (q + 1) : r * (q + 1) + (xcd - r) * q) + off; }
        const int nig = WGM * nN, gid = wgid / nig, fm = gid * WGM, gsz = (nM - fm) < WGM ? (nM - fm) : WGM;
        u.pm = fm + ((wgid % nig) % gsz); u.pn = (wgid % nig) / gsz; return true;
    }
    __device__ __forceinline__ void a_ready(const Unit&) const {}
    __device__ __forceinline__ void done(const Unit&) const {}
};

__device__ __forceinline__ unsigned cvt_pk_bf16(float lo, float hi) { unsigned r; asm volatile("v_cvt_pk_bf16_f32 %0, %1, %2" : "=v"(r) : "v"(lo), "v"(hi)); return r; }
typedef unsigned u32x2 __attribute__((ext_vector_type(2)));
__device__ __forceinline__ float fsigmoid(float x) { return __builtin_amdgcn_rcpf(1.f + __builtin_amdgcn_exp2f(-1.4426950408889634f * x)); }
__device__ __forceinline__ float fsilu(float x) { return x * fsigmoid(x); }
typedef unsigned long long ssq_t;
__device__ __forceinline__ ssq_t ssq_fix(float s) { return (ssq_t)(s * 16777216.0f); }
__device__ __forceinline__ float ssq_val(ssq_t v) { return (float)(unsigned)(v >> 32) * 256.0f + (float)(unsigned)v * (1.0f / 16777216.0f); }
enum EpiMode { EM_SWIGLU = 0, EM_SCALE = 1, EM_RESID = 2, EM_MEMKV = 3, EM_PARTIAL = 4 };
struct EpiAny {
    static constexpr bool AFTER_DRAIN = false;
    static constexpr int RED_OFF = 139264 + 1024 + 8192;
    int mode;
    __device__ __forceinline__ bool perm() const { return mode <= EM_SCALE; }
    void* p0; const float* p1; const float* p2; void* p3; int ldc; float scale;
    __device__ __forceinline__ void operator()(const f32x4 (&acc)[2][2][4][2], const Unit& u, int wr, int wc, int fr_, int fq_) const {
        int fr = fr_, fq = fq_; asm volatile("" : "+v"(fr), "+v"(fq));
        bf16_t* const O = (bf16_t*)p0; const ssq_t* const ssq = (const ssq_t*)p1;
        bf16_t* const xb = (bf16_t*)p0; ssq_t* const ssq_out = (ssq_t*)p3;
        float* const outk = (float*)p0; float* const outv = outk + 4194304; bf16_t* const kb = (bf16_t*)p3; bf16_t* const vt = kb + 4194304;
        const int rl0 = wr * 64 + fr;
        if (mode == EM_SWIGLU) {
            typedef float f32x2e __attribute__((ext_vector_type(2)));
            const int col0 = u.pn * HALF + wc * 32 + 8 * fq;
            float rsv[8];
#pragma unroll
            for (int q = 0; q < 8; ++q) rsv[q] = ssq_val(ssq[u.pm * BM + rl0 + (q >> 2) * HALF + (q & 3) * 16]);
#pragma unroll
            for (int ai = 0; ai < 2; ++ai)
#pragma unroll
                for (int m = 0; m < 4; ++m) {
                    const int row = u.pm * BM + rl0 + ai * HALF + m * 16;
                    const float rs = __builtin_amdgcn_rsqf(rsv[ai * 4 + m] * (1.0f / 1024.0f) + 1e-6f);
                    const float c1 = -1.4426950408889634f * rs, c2 = rs * rs;
                    unsigned wq[4];
#pragma unroll
                    for (int n = 0; n < 2; ++n)
#pragma unroll
                        for (int hp = 0; hp < 2; ++hp) {
                            const f32x2e g = {acc[ai][0][m][n][2 * hp], acc[ai][0][m][n][2 * hp + 1]}, uu = {acc[ai][1][m][n][2 * hp], acc[ai][1][m][n][2 * hp + 1]};
                            const f32x2e t = g * c1; f32x2e ex; ex.x = __builtin_amdgcn_exp2f(t.x); ex.y = __builtin_amdgcn_exp2f(t.y);
                            const f32x2e d = ex + 1.0f; f32x2e r; r.x = __builtin_amdgcn_rcpf(d.x); r.y = __builtin_amdgcn_rcpf(d.y);
                            const f32x2e y = (g * uu) * (r * c2);
                            wq[2 * n + hp] = cvt_pk_bf16(y.x, y.y);
                        }
                    u32x4 w; w.x = wq[0]; w.y = wq[1]; w.z = wq[2]; w.w = wq[3];
                    *(u32x4*)(O + (size_t)row * ldc + col0) = w;
                }
        } else if (mode == EM_SCALE) {
            const int col0 = u.pn * BM + wc * 32 + 8 * fq;
            float rsv[8];
#pragma unroll
            for (int q = 0; q < 8; ++q) rsv[q] = ssq ? ssq_val(ssq[u.pm * BM + rl0 + (q >> 2) * HALF + (q & 3) * 16]) : 0.f;
#pragma unroll
            for (int ai = 0; ai < 2; ++ai)
#pragma unroll
                for (int m = 0; m < 4; ++m) {
                    const int row = u.pm * BM + rl0 + ai * HALF + m * 16;
                    const float rs = ssq ? __builtin_amdgcn_rsqf(rsv[ai * 4 + m] * (1.0f / 1024.0f) + 1e-6f) : 1.0f;
#pragma unroll
                    for (int bj = 0; bj < 2; ++bj) {
                        const f32x4 v0 = acc[ai][bj][m][0] * rs, v1 = acc[ai][bj][m][1] * rs;
                        u32x4 w; w.x = cvt_pk_bf16(v0[0], v0[1]); w.y = cvt_pk_bf16(v0[2], v0[3]); w.z = cvt_pk_bf16(v1[0], v1[1]); w.w = cvt_pk_bf16(v1[2], v1[3]);
                        *(u32x4*)(O + (size_t)row * ldc + col0 + bj * HALF) = w;
                    }
                }
        } else if (mode == EM_RESID) {
            const int col0 = u.pn * BM + wc * 32 + 4 * fq;
            bf16_t* const xrow = xb + (size_t)(u.pm * BM) * 1024;
#pragma unroll
            for (int ai = 0; ai < 2; ++ai) {
                u32x2 xr[4][2][2];
#pragma unroll
                for (int m = 0; m < 4; ++m)
#pragma unroll
                    for (int bj = 0; bj < 2; ++bj)
#pragma unroll
                        for (int n = 0; n < 2; ++n) xr[m][bj][n] = *(const u32x2*)(xrow + (size_t)(rl0 + ai * HALF + m * 16) * 1024 + col0 + bj * HALF + n * 16);
#pragma unroll
                for (int m = 0; m < 4; ++m) {
                    const int rl = rl0 + ai * HALF + m * 16; const int row = u.pm * BM + rl;
                    float s = 0.f;
#pragma unroll
                    for (int bj = 0; bj < 2; ++bj)
#pragma unroll
                        for (int n = 0; n < 2; ++n) {
                            const int c = col0 + bj * HALF + n * 16;
                            const u32x2 q = xr[m][bj][n];
                            const f32x4 xi = {__uint_as_float(q.x << 16), __uint_as_float(q.x & 0xffff0000u), __uint_as_float(q.y << 16), __uint_as_float(q.y & 0xffff0000u)};
                            const f32x4 v = xi + acc[ai][bj][m][n] * scale;
                            s += (v[0] * v[0] + v[1] * v[1]) + (v[2] * v[2] + v[3] * v[3]);
                            u32x2 w; w.x = cvt_pk_bf16(v[0], v[1]); w.y = cvt_pk_bf16(v[2], v[3]);
                            *(u32x2*)(xrow + (size_t)rl * 1024 + c) = w;
                        }
                    s += __shfl_xor(s, 16); s += __shfl_xor(s, 32);
                    if (fq == 0) __hip_atomic_fetch_add(ssq_out + row, ssq_fix(s), __ATOMIC_RELAXED, __HIP_MEMORY_SCOPE_AGENT);
                }
            }
        } else if (mode == EM_PARTIAL) {
            bf16_t* slab = (bf16_t*)p0 + ((size_t)((u.pm * 4 + u.pn) * ldc + u.ks) * 8 + (wr * 4 + wc)) * (32 * 64 * 4) + (fq * 16 + fr) * 4;
            float one = 1.0f; asm volatile("" : "+v"(one));
#pragma unroll
            for (int ai = 0; ai < 2; ++ai)
#pragma unroll
                for (int bj = 0; bj < 2; ++bj)
#pragma unroll
                    for (int m = 0; m < 4; ++m)
#pragma unroll
                        for (int n = 0; n < 2; ++n) { const f32x4 v = acc[ai][bj][m][n] * one; u32x2 w; w.x = cvt_pk_bf16(v[0], v[1]); w.y = cvt_pk_bf16(v[2], v[3]);
                            *(u32x2*)(slab + (((ai * 2 + bj) * 4 + m) * 2 + n) * 256) = w; }
        } else {
            const int col0 = u.pn * BM + wc * 32 + 4 * fq;
            float rsv[8];
#pragma unroll
            for (int q = 0; q < 8; ++q) rsv[q] = ssq_val(ssq[u.pm * BM + rl0 + (q >> 2) * HALF + (q & 3) * 16]);
            const bool isv = ((u.pn * BM) & 2047) >= 1024;
            PG8_LAS bf16_t* const patch = (PG8_LAS bf16_t*)(size_t)(RED_OFF + (wr * 4 + wc) * 640);
#pragma unroll
            for (int ai = 0; ai < 2; ++ai)
#pragma unroll
                for (int m = 0; m < 4; ++m) {
                    const int row = u.pm * BM + rl0 + ai * HALF + m * 16;
                    const float rs = __builtin_amdgcn_rsqf(rsv[ai * 4 + m] * (1.0f / 1024.0f) + 1e-6f);
#pragma unroll
                    for (int bj = 0; bj < 2; ++bj)
#pragma unroll
                        for (int n = 0; n < 2; ++n) {
                            const int cg = col0 + bj * HALF + n * 16; const int l = cg >> 11, c = cg & 1023;
                            const f32x4 v = acc[ai][bj][m][n] * rs;
                            float* dst = (isv ? outv : outk) + ((size_t)l * 2048 + row) * 1024 + c;
                            *(f32x4*)dst = v;
                            const unsigned q0 = cvt_pk_bf16(v[0], v[1]), q1 = cvt_pk_bf16(v[2], v[3]);
                            if (!isv) { u32x2 w; w.x = q0; w.y = q1; *(u32x2*)(kb + ((size_t)l * 2048 + row) * 1024 + c) = w; }
                            else {
                                PG8_LAS bf16_t* pw = patch + (4 * fq) * 20 + fr;
                                pw[0] = (bf16_t)(q0 & 0xffffu); pw[20] = (bf16_t)(q0 >> 16); pw[40] = (bf16_t)(q1 & 0xffffu); pw[60] = (bf16_t)(q1 >> 16);
                                asm volatile("s_waitcnt lgkmcnt(0)" ::: "memory");
                                const u32x2 tv = *(const PG8_LAS u32x2*)(patch + fr * 20 + 4 * fq);
                                asm volatile("s_waitcnt lgkmcnt(0)" ::: "memory");
                                const int R0 = u.pm * BM + wr * 64 + ai * HALF + m * 16, C0 = (u.pn * BM + wc * 32 + bj * HALF + n * 16) & 1023;
                                const int rr = R0 + 4 * fq, b = rr >> 8, mm = rr & 255, cc = C0 + fr, h = cc >> 8, d = cc & 255;
                                *(u32x2*)(vt + ((((size_t)l * 8 + b) * 4 + h) * 256 + d) * 256 + mm) = tv;
                            }
                        }
                }
        }
    }
    template <class... T> __device__ __forceinline__ void fused(T&&...) const {}
};

template <class Epi, class Sched, bool ALIGN_EPI = false, bool SP2 = false>
__device__ __forceinline__ void gemm_phase(PG8_LAS unsigned char* lds, const Gemm g, const Sched& S, const Epi& E, int wave0) {
    int tid_l = wave0 * 64 + (int)__builtin_amdgcn_mbcnt_hi(~0u, __builtin_amdgcn_mbcnt_lo(~0u, 0u)); asm volatile("" : "+v"(tid_l));
    const int tid = tid_l, wid = __builtin_amdgcn_readfirstlane(tid >> 6), lane = tid & 63, wr = wid >> 2, wc = wid & 3, fr = lane & 15, fq = lane >> 4;
    const int K = g.K, LD = g.ld, nt = K / BK;
    unsigned voffA[2], voffB[2];
#pragma unroll
    for (int i = 0; i < 2; ++i) { int R, C; stage_rc(tid * 16 + i * 8192, R, C); const int Rb = E.perm() ? ((R & ~31) + perm32(R & 31)) : R;
        voffA[i] = (unsigned)(R * LD + C) * 2u; voffB[i] = (unsigned)(Rb * LD + C) * 2u; }
    const size_t kstep = (size_t)(BK * 2);
    const size_t hstep = (size_t)HALF * LD * 2;
    const size_t tstep = 2 * hstep;
    const unsigned ldsw = (unsigned)wid * 1024u;
    const int aoff = lds_byte(wr * 64 + fr, fq * 8), boff = lds_byte(wc * 32 + fr, fq * 8);
#define PG8_SA(b, h) (((b) * 2 + (h)) * HTB)
#define PG8_SB(b, h) ((4 + (b) * 2 + (h)) * HTB)
#define PG8_STAGE(bufoff, gbase, voff) do { _Pragma("unroll") for (int _i = 0; _i < 2; ++_i) \
        __builtin_amdgcn_global_load_lds((const unsigned*)((const char*)(gbase) + (voff)[_i]), (PG8_LAS unsigned*)(lds + (bufoff) + ldsw + _i * 8192), 16, 0, 0); } while (0)
#define PG8_LDA(dst, b, h) do { _Pragma("unroll") for (int m = 0; m < 4; ++m) _Pragma("unroll") for (int k = 0; k < 2; ++k) dst[m][k] = *(const PG8_LAS bf16x8*)(lds + PG8_SA(b, h) + aoff + m * 2048 + k * 1024); } while (0)
#define PG8_LDB(dst, b, h) do { _Pragma("unroll") for (int n = 0; n < 2; ++n) _Pragma("unroll") for (int k = 0; k < 2; ++k) dst[n][k] = *(const PG8_LAS bf16x8*)(lds + PG8_SB(b, h) + boff + n * 2048 + k * 1024); } while (0)
#define PG8_MMA(ai, bj, At, Bt) do { __builtin_amdgcn_s_setprio(1); _Pragma("unroll") for (int m = 0; m < 4; ++m) _Pragma("unroll") for (int n = 0; n < 2; ++n) _Pragma("unroll") for (int k = 0; k < 2; ++k) \
        acc[ai][bj][m][n] = __builtin_amdgcn_mfma_f32_16x16x32_bf16(Bt[n][k], At[m][k], acc[ai][bj][m][n], 0, 0, 0); __builtin_amdgcn_s_setprio(0); } while (0)
#define PG8_WAIT_V(n) asm volatile("s_waitcnt vmcnt(" #n ")" ::: "memory")
#define PG8_WAIT_L(n) asm volatile("s_waitcnt lgkmcnt(" #n ")" ::: "memory")
#define PG8_BAR __builtin_amdgcn_s_barrier()
#define PG8_SCHED __builtin_amdgcn_sched_barrier(0)
    Unit cur, nxt; int ui = 0;
    if (!S.next(0, cur)) return;
    f32x4 acc[2][2][4][2];
#pragma unroll
    for (int a = 0; a < 2; ++a)
#pragma unroll
        for (int b = 0; b < 2; ++b)
#pragma unroll
            for (int m = 0; m < 4; ++m)
#pragma unroll
                for (int n = 0; n < 2; ++n) acc[a][b][m][n] = (f32x4){0.f, 0.f, 0.f, 0.f};
    bf16x8 At[4][2], B0[2][2], B1[2][2];
    const char* cA = (const char*)g.A + (size_t)cur.pm * tstep + (size_t)cur.ks * K * 2; const char* cB = (const char*)g.Bt + (size_t)cur.pn * tstep + (size_t)cur.ks * K * 2;
    S.a_ready(cur);
    if constexpr (SP2) {
        PG8_STAGE(PG8_SB(0, 0), cB, voffB); PG8_STAGE(PG8_SB(0, 1), cB + hstep, voffB); PG8_STAGE(PG8_SA(0, 0), cA, voffA); PG8_STAGE(PG8_SA(0, 1), cA + hstep, voffA);
        if (wr == 1) PG8_BAR;
        PG8_WAIT_V(2); PG8_BAR;
        PG8_STAGE(PG8_SB(1, 0), cB + kstep, voffB); PG8_STAGE(PG8_SA(1, 0), cA + kstep, voffA); PG8_STAGE(PG8_SB(1, 1), cB + hstep + kstep, voffB);
        PG8_WAIT_V(6); PG8_BAR;
    } else {
        PG8_STAGE(PG8_SB(0, 0), cB, voffB); PG8_STAGE(PG8_SA(0, 0), cA, voffA); PG8_STAGE(PG8_SB(0, 1), cB + hstep, voffB); PG8_STAGE(PG8_SA(0, 1), cA + hstep, voffA);
        if (wr == 1) PG8_BAR;
        PG8_WAIT_V(4); PG8_BAR;
        PG8_STAGE(PG8_SB(1, 0), cB + kstep, voffB); PG8_STAGE(PG8_SA(1, 0), cA + kstep, voffA); PG8_STAGE(PG8_SB(1, 1), cB + hstep + kstep, voffB);
        PG8_WAIT_V(6); PG8_BAR;
    }
    for (;;) {
        const bool has_next = S.next(ui + 1, nxt);
        const char* nA = has_next ? (const char*)g.A + (size_t)nxt.pm * tstep + (size_t)nxt.ks * K * 2 : cA; const char* nB = has_next ? (const char*)g.Bt + (size_t)nxt.pn * tstep + (size_t)nxt.ks * K * 2 : cB;
        for (int t = 0; t < nt; t += 2) {
            const bool last = (t == nt - 2);
            const char* a1 = cA + (size_t)(t + 1) * kstep;
            const char* a2 = last ? nA : cA + (size_t)(t + 2) * kstep; const char* b2 = last ? nB : cB + (size_t)(t + 2) * kstep;
            const char* a3 = a2 + kstep; const char* b3 = b2 + kstep;
            if (last && has_next) S.a_ready(nxt);
            if constexpr (SP2) {
            PG8_LDB(B0, 0, 0); PG8_LDB(B1, 0, 1); PG8_SCHED; PG8_LDA(At, 0, 0); PG8_STAGE(PG8_SA(1, 1), a1 + hstep, voffA);
            PG8_WAIT_V(8); PG8_WAIT_L(0); PG8_BAR; PG8_MMA(0, 0, At, B0); PG8_MMA(0, 1, At, B1); PG8_BAR; PG8_SCHED;
            PG8_LDA(At, 0, 1); PG8_STAGE(PG8_SB(0, 0), b2, voffB); PG8_STAGE(PG8_SB(0, 1), b2 + hstep, voffB); PG8_STAGE(PG8_SA(0, 0), a2, voffA);
            PG8_WAIT_V(8); PG8_WAIT_L(0); PG8_BAR; PG8_MMA(1, 0, At, B0); PG8_MMA(1, 1, At, B1); PG8_BAR; PG8_SCHED;
            PG8_LDB(B0, 1, 0); PG8_LDB(B1, 1, 1); PG8_SCHED; PG8_LDA(At, 1, 0); PG8_STAGE(PG8_SA(0, 1), a2 + hstep, voffA);
            PG8_WAIT_V(8); PG8_WAIT_L(0); PG8_BAR; PG8_MMA(0, 0, At, B0); PG8_MMA(0, 1, At, B1); PG8_BAR; PG8_SCHED;
            PG8_LDA(At, 1, 1); PG8_STAGE(PG8_SB(1, 0), b3, voffB); PG8_STAGE(PG8_SB(1, 1), b3 + hstep, voffB); PG8_STAGE(PG8_SA(1, 0), a3, voffA);
            PG8_WAIT_V(8); PG8_WAIT_L(0); PG8_BAR; PG8_MMA(1, 0, At, B0); PG8_MMA(1, 1, At, B1); PG8_BAR; PG8_SCHED;
            } else {
            PG8_LDB(B0, 0, 0); PG8_SCHED; PG8_LDA(At, 0, 0); PG8_STAGE(PG8_SA(1, 1), a1 + hstep, voffA);
            PG8_WAIT_L(8); PG8_BAR; PG8_WAIT_L(0); PG8_MMA(0, 0, At, B0); PG8_BAR; PG8_SCHED;
            PG8_LDB(B1, 0, 1); PG8_STAGE(PG8_SB(0, 0), b2, voffB);
            PG8_BAR; PG8_WAIT_L(0); PG8_MMA(0, 1, At, B1); PG8_BAR;
            PG8_LDA(At, 0, 1); PG8_STAGE(PG8_SA(0, 0), a2, voffA);
            PG8_BAR; PG8_WAIT_L(0); PG8_MMA(1, 0, At, B0); PG8_BAR; PG8_SCHED;
            PG8_STAGE(PG8_SB(0, 1), b2 + hstep, voffB);
            PG8_WAIT_V(6); PG8_BAR; PG8_MMA(1, 1, At, B1); PG8_BAR;
            PG8_LDB(B0, 1, 0); PG8_SCHED; PG8_LDA(At, 1, 0); PG8_STAGE(PG8_SA(0, 1), a2 + hstep, voffA);
            PG8_WAIT_L(8); PG8_BAR; PG8_WAIT_L(0); PG8_MMA(0, 0, At, B0); PG8_BAR; PG8_SCHED;
            PG8_LDB(B1, 1, 1); PG8_STAGE(PG8_SB(1, 0), b3, voffB);
            PG8_BAR; PG8_WAIT_L(0); PG8_MMA(0, 1, At, B1); PG8_BAR;
            PG8_LDA(At, 1, 1); PG8_STAGE(PG8_SA(1, 0), a3, voffA);
            PG8_BAR; PG8_WAIT_L(0); PG8_MMA(1, 0, At, B0); PG8_BAR; PG8_SCHED;
            PG8_STAGE(PG8_SB(1, 1), b3 + hstep, voffB);
            PG8_WAIT_V(6); PG8_BAR; PG8_MMA(1, 1, At, B1); PG8_BAR;
            }
        }
        if constexpr (ALIGN_EPI) { if (wr == 0) PG8_BAR; }
        if constexpr (!Epi::AFTER_DRAIN) { E(acc, cur, wr, wc, fr, fq); S.done(cur); }
        if (!has_next) break;
#pragma unroll
        for (int a = 0; a < 2; ++a)
#pragma unroll
            for (int b = 0; b < 2; ++b)
#pragma unroll
                for (int m = 0; m < 4; ++m)
#pragma unroll
                    for (int n = 0; n < 2; ++n) acc[a][b][m][n] = (f32x4){0.f, 0.f, 0.f, 0.f};
        cur = nxt; cA = nA; cB = nB; ++ui;
        if constexpr (ALIGN_EPI) { if (wr == 1) PG8_BAR; }
    }
    PG8_WAIT_V(0);
    if constexpr (!ALIGN_EPI) { if (wr == 0) PG8_BAR; }
    PG8_BAR;
    if constexpr (Epi::AFTER_DRAIN) { E.fused(acc, cur, wr, wc, fr, fq, lds, wid, lane); S.done(cur); }
#undef PG8_SA
#undef PG8_SB
#undef PG8_STAGE
#undef PG8_LDA
#undef PG8_LDB
#undef PG8_MMA
#undef PG8_WAIT_V
#undef PG8_WAIT_L
#undef PG8_BAR
#undef PG8_SCHED
}
}

namespace cg = cooperative_groups;
#define LAS __attribute__((address_space(3)))
typedef unsigned short bf16;
typedef float f32x4 __attribute__((ext_vector_type(4)));
typedef unsigned u32x4v __attribute__((ext_vector_type(4)));
typedef unsigned u32x2v __attribute__((ext_vector_type(2)));
typedef short bf16x8 __attribute__((ext_vector_type(8)));
typedef short s16x4 __attribute__((ext_vector_type(4)));
typedef float f32x16 __attribute__((ext_vector_type(16)));

constexpr int D = 1024, MP = 16384, MS = 1024, MT = 17408, FF = 2816, NGU = 5632, EIN = 3584, OIN = 3840, PLD = 3840;
constexpr int NCHP = 1024, NCHS = 512, NCH = 1536;
constexpr int NWAVES = 8, NTHR = 512;
enum { I_XP = 0, I_XS, I_SCONV, I_SHGRN, I_SRET, I_SRWKV, I_SSHIFT, I_CMK, I_CMV, I_MEM, I_F1N, I_F1GU, I_F1DN, I_MIXN, I_EWIN, I_EWOUT, I_CONVW, I_HLB, I_HGN,
       I_OWIN, I_OWOUT, I_RGN, I_MU, I_W0, I_W2, I_A0, I_A2, I_G2, I_KK, I_KA, I_RK, I_LNG, I_LNB, I_XN, I_MEMN, I_WQ, I_WKV, I_WO, I_F2N, I_F2GU, I_F2DN, I_FN, N_IN };
constexpr size_t O_Y = 0, O_CONVP = O_Y + (size_t)MT * D, O_HGRNP = O_CONVP + 8192, O_RETP = O_HGRNP + 524288, O_RWKVP = O_RETP + 524288, O_SHIFTP = O_RWKVP + 262144,
                 O_MKP = O_SHIFTP + 14336, O_MVP = O_MKP + 4194304, O_CONVS = O_MVP + 4194304, O_HGRNS = O_CONVS + 131072, O_RETS = O_HGRNS + 8388608, O_RWKVS = O_RETS + 8388608,
                 O_SHIFTS = O_RWKVS + 4194304, O_END = O_SHIFTS + 229376;
static_assert(O_END == 48879616, "output size");

constexpr size_t MiB = 1u << 20;
constexpr size_t al(size_t x) { return (x + MiB - 1) / MiB * MiB; }
constexpr size_t WS_CTL = 0, CTL_ZERO_BYTES = 2 * MiB;
constexpr size_t CTL_SSQ_OFF = 65536;
constexpr size_t CTL_SSQM_OFF = 65536 + (size_t)9 * 17408 * 8;
static_assert(CTL_SSQM_OFF + 2048 * 8 <= CTL_ZERO_BYTES, "control block");
constexpr size_t WS_GU1 = CTL_ZERO_BYTES, SZ_GU = al((size_t)NGU * D * 2);
constexpr size_t WS_DN1 = WS_GU1 + 2 * SZ_GU, SZ_DN = al((size_t)D * FF * 2);
constexpr size_t WS_WIN = WS_DN1 + 2 * SZ_DN, SZ_WIN = al((size_t)OIN * D * 2);
constexpr size_t WS_WOUT = WS_WIN + 2 * SZ_WIN, SZ_SQ = al((size_t)D * D * 2);
constexpr size_t WS_WQ = WS_WOUT + 2 * SZ_SQ;
constexpr size_t WS_WO = WS_WQ + 2 * SZ_SQ;
constexpr size_t WS_WKV = WS_WO + 2 * SZ_SQ;
constexpr size_t WS_GU2 = WS_WKV + al((size_t)4096 * D * 2);
constexpr size_t WS_DN2 = WS_GU2 + 2 * SZ_GU;
constexpr size_t WS_LORA = WS_DN2 + 2 * SZ_DN;
constexpr size_t WS_X = WS_LORA + al((size_t)1536 * 256 * 2);
constexpr size_t WS_XB = WS_X + al((size_t)MT * D * 4);
constexpr size_t WS_HB = WS_XB + al((size_t)MT * D * 2);
constexpr size_t WS_PB = WS_HB + al((size_t)MT * FF * 2);
constexpr size_t WS_YM = WS_PB + al((size_t)MT * PLD * 2);
constexpr size_t WS_QB = WS_YM + al((size_t)MT * D * 2);
constexpr size_t WS_OB = WS_QB + al((size_t)MT * D * 2);
constexpr size_t WS_DS = WS_OB + al((size_t)MT * D * 2);
constexpr size_t WS_DEC = WS_DS + al((size_t)NCHP * 16384 * 4);
constexpr size_t WS_LB = WS_DEC + al((size_t)NCHP * 128 * 4);
constexpr size_t WS_AP = WS_LB + al((size_t)MT * 1536 * 2);
constexpr size_t WS_MEMB = WS_AP + al((size_t)MT * 256 * 2);
constexpr size_t WS_KB = WS_MEMB + al((size_t)2048 * D * 2);
constexpr size_t WS_VT = WS_KB + al((size_t)2 * 2048 * D * 2);
constexpr size_t WS_RREC = WS_VT + al((size_t)2 * 2048 * D * 2);
constexpr size_t WS_RGB = WS_RREC + al((size_t)9216 * 18432);
constexpr size_t WS_SLAB = WS_RGB + al((size_t)9216 * 16 * 64 * 4);
constexpr size_t WS_END = WS_SLAB + al((size_t)16 * 11 * 262144);
static_assert(WS_VT - WS_KB == 4194304 * 2 && O_MVP - O_MKP == 4194304, "epilogue layout assumptions");
constexpr int CW_BAR = 4096;

constexpr int MAIN_BYTES = 139264;
constexpr int LDSCTL_OFF = MAIN_BYTES, MISC_OFF = LDSCTL_OFF + 320;
constexpr int PRM_OFF = MAIN_BYTES + 1024;
constexpr int LDS_BYTES = 160 * 1024;
static_assert(LDS_BYTES <= 160 * 1024 && pg8::EpiAny::RED_OFF == PRM_OFF + 8192 && pg8::EpiAny::RED_OFF + 8 * 640 <= LDS_BYTES, "LDS");

#define RLX_AGENT __ATOMIC_RELAXED, __HIP_MEMORY_SCOPE_AGENT
__device__ __forceinline__ int lane_id_v() { int x; asm volatile("v_mbcnt_lo_u32_b32 %0, -1, 0\n\tv_mbcnt_hi_u32_b32 %0, -1, %0" : "=v"(x)); return x; }
__device__ __forceinline__ float bf2f(bf16 u) { return __uint_as_float((unsigned)u << 16); }
__device__ __forceinline__ void unpack8(const u32x4v w, float (&f)[8]) {
    f[0] = __uint_as_float(w.x << 16); f[1] = __uint_as_float(w.x & 0xffff0000u); f[2] = __uint_as_float(w.y << 16); f[3] = __uint_as_float(w.y & 0xffff0000u);
    f[4] = __uint_as_float(w.z << 16); f[5] = __uint_as_float(w.z & 0xffff0000u); f[6] = __uint_as_float(w.w << 16); f[7] = __uint_as_float(w.w & 0xffff0000u);
}
__device__ __forceinline__ unsigned f2bf(float f) { unsigned u = __builtin_bit_cast(unsigned, f); return (u + 0x7fffu + ((u >> 16) & 1u)) >> 16; }
__device__ __forceinline__ unsigned pk2(float lo, float hi) { return f2bf(lo) | (f2bf(hi) << 16); }
template <int CTRL> __device__ __forceinline__ float dpp_f(float x) { return __builtin_bit_cast(float, __builtin_amdgcn_update_dpp(0, __builtin_bit_cast(int, x), CTRL, 0xF, 0xF, true)); }
__device__ __forceinline__ float wave_sum(float v) {
    v += dpp_f<0xB1>(v); v += dpp_f<0x4E>(v); v += dpp_f<0x141>(v); v += dpp_f<0x140>(v);
    const int iv = __builtin_bit_cast(int, v);
    return (__builtin_bit_cast(float, __builtin_amdgcn_readlane(iv, 0)) + __builtin_bit_cast(float, __builtin_amdgcn_readlane(iv, 16))) +
           (__builtin_bit_cast(float, __builtin_amdgcn_readlane(iv, 32)) + __builtin_bit_cast(float, __builtin_amdgcn_readlane(iv, 48)));
}
__device__ __forceinline__ float wave_max(float v) {
    v = fmaxf(v, dpp_f<0xB1>(v)); v = fmaxf(v, dpp_f<0x4E>(v)); v = fmaxf(v, dpp_f<0x141>(v)); v = fmaxf(v, dpp_f<0x140>(v));
    const int iv = __builtin_bit_cast(int, v);
    return fmaxf(fmaxf(__builtin_bit_cast(float, __builtin_amdgcn_readlane(iv, 0)), __builtin_bit_cast(float, __builtin_amdgcn_readlane(iv, 16))),
                 fmaxf(__builtin_bit_cast(float, __builtin_amdgcn_readlane(iv, 32)), __builtin_bit_cast(float, __builtin_amdgcn_readlane(iv, 48))));
}
__device__ __forceinline__ float fexp(float x) { return __builtin_amdgcn_exp2f(1.4426950408889634f * x); }
__device__ __forceinline__ float flog(float x) { return __builtin_amdgcn_logf(x) * 0.6931471805599453f; }
__device__ __forceinline__ float fsig(float x) { return __builtin_amdgcn_rcpf(1.f + __builtin_amdgcn_exp2f(-1.4426950408889634f * x)); }
__device__ __forceinline__ float fsilu(float x) { return x * fsig(x); }

#define XB_TMO      128
#define XB_XCNT(j)  (256  + 64 * (j))
#define XB_XSUB(j)  (1280 + 64 * (j))
#define XB_XGEN(j)  (2304 + 64 * (j))
#define XB_TOP      3328
#define XB_TOPGEN   3392
#define XCD_BAR_WORDS 3456
#define XB_SPIN_CAP (1u << 18)

__device__ __forceinline__ unsigned xb_ld(unsigned* p)              { return __hip_atomic_load(p, __ATOMIC_RELAXED, __HIP_MEMORY_SCOPE_AGENT); }
__device__ __forceinline__ unsigned xb_add(unsigned* p, unsigned v) { return __hip_atomic_fetch_add(p, v, __ATOMIC_RELAXED, __HIP_MEMORY_SCOPE_AGENT); }
__device__ __forceinline__ unsigned xb_xcc_id() { return (unsigned)__builtin_amdgcn_s_getreg((3 << 11) | 20) & 0xFu; }
#define XB_SPIN(cond, bar) do { unsigned _sp = 0; while (cond) { __builtin_amdgcn_s_sleep(1); \
    if ((++_sp & 255u) == 0u) { if (xb_ld(&(bar)[XB_TMO])) break; if (_sp > XB_SPIN_CAP) { atomicAdd(&(bar)[XB_TMO], 1u); break; } } } } while (0)

struct XcdBarrier {
    unsigned* bar; unsigned x; int w0;
    volatile LAS unsigned* st;
};

__device__ __forceinline__ XcdBarrier xcd_barrier_post(unsigned* bar, volatile LAS unsigned* st) {
    XcdBarrier b; b.bar = bar; b.x = xb_xcc_id(); b.st = st;
    if (threadIdx.x == 0) (void)xb_add(&bar[XB_XCNT(b.x)], 1u);
    return b;
}
__device__ __forceinline__ void xcd_barrier_complete(unsigned* bar, unsigned x, unsigned& nloc, unsigned& nx) {
    const unsigned G = gridDim.x * gridDim.y * gridDim.z;
    unsigned sum, cnt, mine, sp = 0u;
    for (;;) {
        sum = 0u; cnt = 0u; mine = 0u;
#pragma unroll
        for (unsigned j = 0; j < 16; ++j) { const unsigned c = xb_ld(&bar[XB_XCNT(j)]); sum += c; cnt += (c > 0u) ? 1u : 0u; }
        mine = xb_ld(&bar[XB_XCNT(x)]);
        if (sum == G) break;
        __builtin_amdgcn_s_sleep(1);
        if ((++sp & 255u) == 0u) { if (xb_ld(&bar[XB_TMO])) break; if (sp > XB_SPIN_CAP) { atomicAdd(&bar[XB_TMO], 1u); break; } }
    }
    nloc = mine > 0u ? mine : 1u; nx = cnt > 0u ? cnt : 1u;
}

__device__ __forceinline__ void xcd_barrier(const XcdBarrier& b) {
    asm volatile("s_waitcnt vmcnt(0)" ::: "memory");
    __syncthreads();
    if (b.w0 == 0 && __builtin_amdgcn_mbcnt_hi(~0u, __builtin_amdgcn_mbcnt_lo(~0u, 0u)) == 0u) {
        unsigned* bar = b.bar; asm volatile("" : "+s"(bar));
        __builtin_amdgcn_s_waitcnt(0);
        unsigned nloc = b.st[0], nx = b.st[1];
        if (nloc == 0u) { xcd_barrier_complete(bar, b.x, nloc, nx); b.st[0] = nloc; b.st[1] = nx; }
        const unsigned old = xb_add(&bar[XB_XSUB(b.x)], 1u);
        const unsigned gen = old / nloc;
        if (old + 1u == (gen + 1u) * nloc) {
            __builtin_amdgcn_fence(__ATOMIC_RELEASE, "agent");
            asm volatile("s_waitcnt vmcnt(0)" ::: "memory");
            const unsigned og = xb_add(&bar[XB_TOP], 1u);
            const unsigned tg = og / nx;
            if (og + 1u == (tg + 1u) * nx) xb_add(&bar[XB_TOPGEN], 1u);
            else XB_SPIN(xb_ld(&bar[XB_TOPGEN]) == tg, bar);
            __builtin_amdgcn_fence(__ATOMIC_ACQUIRE, "agent");
            xb_add(&bar[XB_XGEN(b.x)], 1u);
            asm volatile("s_waitcnt vmcnt(0)" ::: "memory");
        } else {
            XB_SPIN(xb_ld(&bar[XB_XGEN(b.x)]) == gen, bar);
            __builtin_amdgcn_fence(__ATOMIC_ACQUIRE, "agent");
            asm volatile("s_waitcnt vmcnt(0)" ::: "memory");
        }
    }
    __syncthreads();
}
struct Args { const float* in[42]; float* out; unsigned char* ws; };
typedef const __attribute__((address_space(4))) Args* ArgsP;
__device__ __forceinline__ ArgsP kargs() { ArgsP p = (ArgsP)__builtin_amdgcn_kernarg_segment_ptr(); asm volatile("" : "+s"(p)); return p; }

#define LDS_WAIT() asm volatile("s_waitcnt lgkmcnt(0)" ::: "memory")

typedef float f32x2p __attribute__((ext_vector_type(2)));
__device__ __forceinline__ void transpose_item(const float* W, int K, int N, const float* g, bf16* WT, int dest_row0, int k0, int n0, LAS float* scr, int lane) {
    f32x2p wv[32];
    const int cl = (lane & 31) * 2, rh = lane >> 5;
#pragma unroll
    for (int i = 0; i < 32; ++i) wv[i] = *(const f32x2p*)(W + (size_t)(k0 + 2 * i + rh) * N + n0 + cl);
    if (g) {
#pragma unroll
        for (int i = 0; i < 32; ++i) wv[i] *= g[k0 + 2 * i + rh];
    }
#pragma unroll
    for (int i = 0; i < 32; ++i) { const int kk = 2 * i + rh; scr[kk * 65 + cl] = wv[i].x; scr[kk * 65 + cl + 1] = wv[i].y; }
    LDS_WAIT(); asm volatile("" ::: "memory");
    const int c = lane & 7;
#pragma unroll
    for (int j = 0; j < 8; ++j) { const int n = (lane >> 3) + 8 * j; const LAS float* s = scr + (8 * c) * 65 + n;
        u32x4v o; o.x = pk2(s[0 * 65], s[1 * 65]); o.y = pk2(s[2 * 65], s[3 * 65]); o.z = pk2(s[4 * 65], s[5 * 65]); o.w = pk2(s[6 * 65], s[7 * 65]);
        *(u32x4v*)(WT + (size_t)(dest_row0 + n) * K + k0 + 8 * c) = o; }
    LDS_WAIT(); asm volatile("" ::: "memory");
}
struct WSeg { const float* W; const float* g; bf16* WT; int K, N, mode; };
__device__ __forceinline__ WSeg get_seg(ArgsP a, int s) {
    unsigned char* ws = a->ws; WSeg r; r.g = nullptr; r.mode = 0; r.K = D; r.N = D;
    const int l = s & 1;
    switch (s >> 1) {
    case 0: r.W = a->in[I_F1GU] + (size_t)l * D * NGU; r.g = a->in[I_F1N] + l * D; r.WT = (bf16*)(ws + WS_GU1 + l * SZ_GU); r.N = NGU; r.mode = 1; break;
    case 1: r.W = a->in[I_F1DN] + (size_t)l * FF * D; r.WT = (bf16*)(ws + WS_DN1 + l * SZ_DN); r.K = FF; break;
    case 2: if (l == 0) { r.W = a->in[I_EWIN]; r.g = a->in[I_MIXN]; r.WT = (bf16*)(ws + WS_WIN); r.N = EIN; } else { r.W = a->in[I_OWIN]; r.g = a->in[I_MIXN] + D; r.WT = (bf16*)(ws + WS_WIN + SZ_WIN); r.N = OIN; } break;
    case 3: r.W = l == 0 ? a->in[I_EWOUT] : a->in[I_OWOUT]; r.WT = (bf16*)(ws + WS_WOUT + l * SZ_SQ); break;
    case 4: r.W = a->in[I_WQ] + (size_t)l * D * D; r.g = a->in[I_XN] + l * D; r.WT = (bf16*)(ws + WS_WQ + l * SZ_SQ); break;
    case 5: r.W = a->in[I_WKV] + (size_t)l * D * 2048; r.g = a->in[I_MEMN] + l * D; r.WT = (bf16*)(ws + WS_WKV) + (size_t)l * 2048 * D; r.N = 2048; break;
    case 6: r.W = a->in[I_WO] + (size_t)l * D * D; r.WT = (bf16*)(ws + WS_WO + l * SZ_SQ); break;
    case 7: r.W = a->in[I_F2GU] + (size_t)l * D * NGU; r.g = a->in[I_F2N] + l * D; r.WT = (bf16*)(ws + WS_GU2 + l * SZ_GU); r.N = NGU; r.mode = 1; break;
    default: r.W = a->in[I_F2DN] + (size_t)l * FF * D; r.WT = (bf16*)(ws + WS_DN2 + l * SZ_DN); r.K = FF; break;
    }
    return r;
}
__device__ __forceinline__ void convert_weights(ArgsP a, LAS unsigned char* lds, unsigned mask, int gw, int NGW, int tid) {
    const int lane = tid & 63, wave = tid >> 6;
    LAS float* scr = (LAS float*)(lds + wave * 16640);
    int base = 0;
    for (int s = 0; s < 18; ++s) {
        if (!((mask >> s) & 1u)) continue;
        const WSeg sg = get_seg(a, s);
        const int nblk = sg.N / 64, cnt = (sg.K / 64) * nblk;
        int it = base + ((gw - base) % NGW + NGW) % NGW;
        for (; it < base + cnt; it += NGW) {
            const int r = it - base, kb = r / nblk, nb = r % nblk, n0 = 64 * nb;
            int dr = n0;
            if (sg.mode == 1) { const int hh = n0 < FF ? n0 : n0 - FF; dr = 256 * (hh >> 7) + (hh & 127) + (n0 < FF ? 0 : 128); }
            transpose_item(sg.W, sg.K, sg.N, sg.g, sg.WT, dr, 64 * kb, n0, scr, lane);
        }
        base += cnt;
    }
}
constexpr unsigned WMASK_PRO = (1u << 0),
                   WMASK_T0 = (1u << 2) | (1u << 4),
                   WMASK_T2 = (1u << 6) | (1u << 10) | (1u << 11) | (1u << 8) | (1u << 12),
                   WMASK_T4 = (1u << 14) | (1u << 16),
                   WMASK_T5 = (1u << 1) | (1u << 3) | (1u << 5),
                   WMASK_T6 = (1u << 7) | (1u << 9) | (1u << 13) | (1u << 15) | (1u << 17);
static_assert((WMASK_PRO | WMASK_T0 | WMASK_T2 | WMASK_T4 | WMASK_T5 | WMASK_T6) == 0x3ffffu &&
              (WMASK_PRO + WMASK_T0 + WMASK_T2 + WMASK_T4 + WMASK_T5 + WMASK_T6) == 0x3ffffu, "every segment exactly once");
__device__ __forceinline__ void p0_prologue(ArgsP a, LAS unsigned char* lds, int vcu, int G, int tid) {
    const int lane = tid & 63, wave = tid >> 6;
    const int gw = vcu * NWAVES + wave, NGW = G * NWAVES;
    unsigned char* ws = a->ws;
    convert_weights(a, lds, WMASK_PRO, gw, NGW, tid);
    {
        bf16* LW = (bf16*)(ws + WS_LORA);
        const float* w2 = a->in[I_W2]; const float* a2 = a->in[I_A2]; const float* g2 = a->in[I_G2];
        for (int e = (vcu * NTHR + tid); e < 1536 * 256; e += G * NTHR) {
            const int n = e >> 8, k = e & 255; float v = 0.f;
            if (n < 512) { if (k < 64) v = w2[k * 512 + n]; }
            else if (n < 1024) { if (k >= 64 && k < 128) v = a2[(k - 64) * 512 + (n - 512)]; }
            else { if (k >= 128) v = g2[(k - 128) * 512 + (n - 1024)]; }
            LW[e] = (bf16)f2bf(v);
        }
    }
    {
        pg8::ssq_t* ssq0 = (pg8::ssq_t*)(ws + WS_CTL + CTL_SSQ_OFF);
        pg8::ssq_t* ssqm = (pg8::ssq_t*)(ws + WS_CTL + CTL_SSQM_OFF);
        bf16* XB = (bf16*)(ws + WS_XB); bf16* MB = (bf16*)(ws + WS_MEMB);
        for (int m0 = gw; m0 < MT + 2048; m0 += 2 * NGW) {
            f32x4 v[2][4]; bf16* dst[2]; pg8::ssq_t* sq[2]; bool ok[2];
#pragma unroll
            for (int q = 0; q < 2; ++q) {
                const int m = m0 + q * NGW; ok[q] = m < MT + 2048; const int mm = ok[q] ? m : m0;
                const float* src;
                if (mm < MP) { src = a->in[I_XP] + (size_t)mm * D; dst[q] = XB + (size_t)mm * D; sq[q] = ssq0 + mm; }
                else if (mm < MT) { src = a->in[I_XS] + (size_t)(mm - MP) * D; dst[q] = XB + (size_t)mm * D; sq[q] = ssq0 + mm; }
                else { src = a->in[I_MEM] + (size_t)(mm - MT) * D; dst[q] = MB + (size_t)(mm - MT) * D; sq[q] = ssqm + (mm - MT); }
                const f32x4* xr = (const f32x4*)src + lane;
#pragma unroll
                for (int j = 0; j < 4; ++j) v[q][j] = xr[64 * j];
            }
#pragma unroll
            for (int q = 0; q < 2; ++q) {
                float s = 0.f;
#pragma unroll
                for (int j = 0; j < 4; ++j) s += (v[q][j].x * v[q][j].x + v[q][j].y * v[q][j].y) + (v[q][j].z * v[q][j].z + v[q][j].w * v[q][j].w);
                s = wave_sum(s);
                if (ok[q]) {
                    u32x2v* o8 = (u32x2v*)dst[q] + lane;
#pragma unroll
                    for (int j = 0; j < 4; ++j) { u32x2v w; w.x = pk2(v[q][j].x, v[q][j].y); w.y = pk2(v[q][j].z, v[q][j].w); o8[64 * j] = w; }
                    if (lane == 0) *sq[q] = pg8::ssq_fix(s);
                }
            }
        }
    }
}

struct ChunkInfo { int row0, h, b, pos0; bool sample; };
__device__ __forceinline__ ChunkInfo chunk_info(int cid) {
    ChunkInfo c;
    if (cid < NCHP) { c.b = cid >> 7; c.h = (cid >> 5) & 3; const int ch = cid & 31; c.row0 = c.b * 2048 + ch * 64; c.pos0 = ch * 64; c.sample = false; }
    else { const int j = cid - NCHP; c.b = j >> 2; c.h = j & 3; c.row0 = MP + c.b * 8; c.pos0 = 16384; c.sample = true; }
    return c;
}


__device__ __forceinline__ void rope_cs(int pos, float inv, float& c, float& s) {
    const float ang = (float)pos * inv;
    const double rev = (double)ang * 0.15915494309189535;
    const float fr = (float)(rev - __builtin_rint(rev));
    s = __builtin_amdgcn_sinf(fr); c = __builtin_amdgcn_cosf(fr);
}
__device__ __forceinline__ float ret_lg2(int h) { return __log2f(1.0f - __builtin_amdgcn_exp2f(-5.0f - (float)h)); }

constexpr int CB_QM = 0, CB_KM = 17408, CB_ATT = 34816, CB_VVT = 44032, CB_ST = 62464, CB_BC = 97280, CB_SK = 130048, CB_PART = 130560;
constexpr int CB_GI = CB_BC;
__device__ __forceinline__ bf16x8 ldsfrag(const LAS unsigned char* p) { return *(const LAS bf16x8*)p; }
__device__ __forceinline__ int tsw(int r, int t) { return r * 72 + ((((t >> 3) ^ (r >> 3)) & 7) << 3) + (t & 7); }
__device__ __forceinline__ int tsf(int r, int chunk) { return r * 144 + (((chunk ^ (r >> 3)) & 7) << 4); }
__device__ __forceinline__ void cumsum64(LAS float* bc, LAS float* tot, int tid) {
    const int k = tid & 127, seg = tid >> 7; float v[16]; float s = 0.f;
#pragma unroll
    for (int i = 0; i < 16; ++i) { s += bc[(16 * seg + i) * 128 + k]; v[i] = s; }
    tot[seg * 128 + k] = s;
    __syncthreads();
    float off = 0.f;
#pragma unroll
    for (int q = 0; q < 3; ++q) if (q < seg) off += tot[q * 128 + k];
#pragma unroll
    for (int i = 0; i < 16; ++i) bc[(16 * seg + i) * 128 + k] = v[i] + off;
    __syncthreads();
}
__device__ __forceinline__ void chunk_a_core64_bf16(const LAS unsigned char* lds, bf16* dS, int tid) {
    const int lane = tid & 63, wave = __builtin_amdgcn_readfirstlane(tid >> 6), ij = lane & 15, kq = lane >> 4;
    f32x4 acc[8];
#pragma unroll
    for (int q = 0; q < 8; ++q) acc[q] = (f32x4){0.f, 0.f, 0.f, 0.f};
#pragma unroll
    for (int s = 0; s < 2; ++s) {
        const bf16x8 kf = ldsfrag(lds + tsf(16 * wave + ij, 4 * s + kq));
#pragma unroll
        for (int q = 0; q < 8; ++q) acc[q] = __builtin_amdgcn_mfma_f32_16x16x32_bf16(ldsfrag(lds + CB_VVT + tsf(16 * q + ij, 4 * s + kq)), kf, acc[q], 0, 0, 0);
    }
    bf16* dst = dS + (size_t)(16 * wave + ij) * 128 + 32 * kq;
    float one = 1.0f; asm volatile("" : "+v"(one));
#pragma unroll
    for (int q2 = 0; q2 < 4; ++q2) {
        const f32x4 a0 = acc[2 * q2] * one, a1 = acc[2 * q2 + 1] * one;
        u32x4v w; w.x = pg8::cvt_pk_bf16(a0[0], a0[1]); w.y = pg8::cvt_pk_bf16(a0[2], a0[3]); w.z = pg8::cvt_pk_bf16(a1[0], a1[1]); w.w = pg8::cvt_pk_bf16(a1[2], a1[3]);
        *(u32x4v*)(dst + 8 * q2) = w;
    }
}
__device__ __forceinline__ void chunk_c_core64_bf16(LAS unsigned char* lds, const bf16* S, const float* gn, const bf16* gate, bf16* yout, int tid) {
    const int lane = tid & 63, wave = __builtin_amdgcn_readfirstlane(tid >> 6), ij = lane & 15, kq = lane >> 4;
    const LAS float* sk = (const LAS float*)(lds + CB_SK); LAS float* part = (LAS float*)(lds + CB_PART);
    {
        u32x4v sv[2][2], gv[2];
#pragma unroll
        for (int q = 0; q < 2; ++q) { const int p = tid + 512 * q, kp = p >> 4, c = p & 15;
            sv[q][0] = *(const u32x4v*)(S + (size_t)(2 * kp) * 128 + 8 * c); sv[q][1] = *(const u32x4v*)(S + (size_t)(2 * kp + 1) * 128 + 8 * c);
            gv[q] = *(const u32x4v*)(gate + (size_t)(p >> 4) * PLD + 8 * (p & 15)); }
#pragma unroll
        for (int q = 0; q < 2; ++q) { const int p = tid + 512 * q; *(LAS u32x4v*)(lds + CB_GI + (p >> 4) * 272 + 16 * (p & 15)) = gv[q]; }
#pragma unroll
        for (int q = 0; q < 2; ++q) { const int p = tid + 512 * q, k = 2 * (p >> 4), c = p & 15, vq = 4 * (c >> 2), q0 = (c & 3) * 2; const float sc0 = sk[k], sc1 = sk[k + 1];
            const unsigned wa[4] = {sv[q][0].x, sv[q][0].y, sv[q][0].z, sv[q][0].w}, wb[4] = {sv[q][1].x, sv[q][1].y, sv[q][1].z, sv[q][1].w};
#pragma unroll
            for (int j = 0; j < 8; ++j) { const int v = 16 * (q0 + (j >> 2)) + vq + (j & 3);
                const float fa = (j & 1) ? __uint_as_float(wa[j >> 1] & 0xffff0000u) : __uint_as_float(wa[j >> 1] << 16);
                const float fb = (j & 1) ? __uint_as_float(wb[j >> 1] & 0xffff0000u) : __uint_as_float(wb[j >> 1] << 16);
                LAS unsigned* dst = (LAS unsigned*)((LAS bf16*)(lds + CB_ST) + v * 136 + (((k >> 3) ^ ((v >> 3) & 7)) << 3) + (k & 7));
                dst[0] = pk2(fa * sc0, fb * sc1); }
        }
    }
    {
        const int t0 = 16 * (wave >> 1), j0 = 32 * (wave & 1);
        f32x4 c0 = (f32x4){0.f, 0.f, 0.f, 0.f}, c1 = c0;
#pragma unroll
        for (int s = 0; s < 4; ++s) { const bf16x8 af = ldsfrag(lds + CB_QM + (t0 + ij) * 272 + 64 * s + 16 * kq);
            c0 = __builtin_amdgcn_mfma_f32_16x16x32_bf16(af, ldsfrag(lds + CB_KM + (j0 + ij) * 272 + 64 * s + 16 * kq), c0, 0, 0, 0);
            c1 = __builtin_amdgcn_mfma_f32_16x16x32_bf16(af, ldsfrag(lds + CB_KM + (j0 + 16 + ij) * 272 + 64 * s + 16 * kq), c1, 0, 0, 0); }
        LAS bf16* ab = (LAS bf16*)(lds + CB_ATT);
#pragma unroll
        for (int r = 0; r < 4; ++r) { const int t = t0 + 4 * kq + r; int j = j0 + ij; ab[t * 72 + j] = (bf16)f2bf((j <= t) ? c0[r] : 0.f); j += 16; ab[t * 72 + j] = (bf16)f2bf((j <= t) ? c1[r] : 0.f); }
    }
    __syncthreads();
    const int t0 = 16 * (wave >> 1), vb = 64 * (wave & 1);
    f32x4 o[4];
#pragma unroll
    for (int q = 0; q < 4; ++q) o[q] = (f32x4){0.f, 0.f, 0.f, 0.f};
#pragma unroll
    for (int s = 0; s < 4; ++s) { const bf16x8 af = ldsfrag(lds + CB_QM + (t0 + ij) * 272 + 64 * s + 16 * kq);
#pragma unroll
        for (int q = 0; q < 4; ++q) { const int v = vb + 16 * q + ij; o[q] = __builtin_amdgcn_mfma_f32_16x16x32_bf16(af, ldsfrag(lds + CB_ST + v * 272 + 16 * ((4 * s + kq) ^ ((v >> 3) & 7))), o[q], 0, 0, 0); } }
#pragma unroll
    for (int s = 0; s < 2; ++s) { const bf16x8 af = ldsfrag(lds + CB_ATT + (t0 + ij) * 144 + 64 * s + 16 * kq);
#pragma unroll
        for (int q = 0; q < 4; ++q) o[q] = __builtin_amdgcn_mfma_f32_16x16x32_bf16(af, ldsfrag(lds + CB_VVT + tsf(vb + 16 * q + ij, 4 * s + kq)), o[q], 0, 0, 0); }
    float ss[4];
#pragma unroll
    for (int r = 0; r < 4; ++r) { float s = (o[0][r] * o[0][r] + o[1][r] * o[1][r]) + (o[2][r] * o[2][r] + o[3][r] * o[3][r]);
        s += dpp_f<0xB1>(s); s += dpp_f<0x4E>(s); s += dpp_f<0x141>(s); s += dpp_f<0x140>(s); ss[r] = s; }
    if (ij == 0) {
#pragma unroll
        for (int r = 0; r < 4; ++r) part[(wave & 1) * 64 + t0 + 4 * kq + r] = ss[r];
    }
    __syncthreads();
    float gnv[4];
#pragma unroll
    for (int q = 0; q < 4; ++q) gnv[q] = gn[vb + 16 * q + ij];
    LAS bf16* yo = (LAS bf16*)(lds + CB_QM);
    const LAS bf16* gi = (const LAS bf16*)(lds + CB_GI);
#pragma unroll
    for (int r = 0; r < 4; ++r) {
        const int t = t0 + 4 * kq + r;
        const float rs = __builtin_amdgcn_rsqf((part[t] + part[64 + t]) * (1.0f / 128.0f) + 1e-6f);
#pragma unroll
        for (int q = 0; q < 4; ++q) { const int v = vb + 16 * q + ij; yo[t * 136 + v] = (bf16)f2bf(o[q][r] * rs * gnv[q] * fsilu(bf2f(gi[t * 136 + v]))); }
    }
    __syncthreads();
#pragma unroll
    for (int q = 0; q < 2; ++q) { const int p = tid + 512 * q; *(u32x4v*)(yout + (size_t)(p >> 4) * D + 8 * (p & 15)) = *(const LAS u32x4v*)(lds + CB_QM + (p >> 4) * 272 + 16 * (p & 15)); }
    __syncthreads();
}
__device__ __forceinline__ void hgrn_a64(int cid, const bf16* P, bf16* DS, float* DEC, const LAS float* lbv, LAS unsigned char* lds, int tid) {
    const ChunkInfo ci = chunk_info(cid);
    LAS float* bc = (LAS float*)(lds + CB_BC); LAS float* tot = (LAS float*)(lds + CB_SK);
    LAS bf16* kdT = (LAS bf16*)lds; LAS bf16* vvT = (LAS bf16*)(lds + CB_VVT);
    u32x4v fw[2], iw[2];
#pragma unroll
    for (int j = 0; j < 2; ++j) { const int p = tid + 512 * j, t = p >> 4, k0 = 8 * (p & 15); const bf16* pr = P + (size_t)(ci.row0 + t) * PLD + ci.h * 128 + k0;
        fw[j] = *(const u32x4v*)(pr + 2048); iw[j] = *(const u32x4v*)(pr + 2560); }
    float omf[2][8];
#pragma unroll
    for (int j = 0; j < 2; ++j) {
        const int p = tid + 512 * j, t = p >> 4, k0 = 8 * (p & 15);
        float fb[8]; unpack8(fw[j], fb);
        const f32x4 l0 = *(const LAS f32x4*)(lbv + ci.h * 128 + k0), l1 = *(const LAS f32x4*)(lbv + ci.h * 128 + k0 + 4);
        f32x4 lg[2];
#pragma unroll
        for (int i = 0; i < 8; ++i) { const float lb = (i < 4) ? l0[i & 3] : l1[i & 3]; const float f = lb + (1.f - lb) * fsig(fb[i]); lg[i >> 2][i & 3] = flog(f); omf[j][i] = 1.f - f; }
        *(LAS f32x4*)(bc + t * 128 + k0) = lg[0]; *(LAS f32x4*)(bc + t * 128 + k0 + 4) = lg[1];
        const unsigned iv[4] = {iw[j].x, iw[j].y, iw[j].z, iw[j].w};
#pragma unroll
        for (int i = 0; i < 8; ++i) vvT[tsw(k0 + i, t)] = (bf16)((i & 1) ? (iv[i >> 1] >> 16) : (iv[i >> 1] & 0xffffu));
    }
    __syncthreads();
    cumsum64(bc, tot, tid);
#pragma unroll
    for (int j = 0; j < 2; ++j) {
        const int p = tid + 512 * j, t = p >> 4, k0 = 8 * (p & 15);
        const f32x4 e0 = *(const LAS f32x4*)(bc + 63 * 128 + k0), e1 = *(const LAS f32x4*)(bc + 63 * 128 + k0 + 4), c0 = *(const LAS f32x4*)(bc + t * 128 + k0), c1 = *(const LAS f32x4*)(bc + t * 128 + k0 + 4);
#pragma unroll
        for (int i = 0; i < 8; ++i) { const float d = ((i < 4) ? e0[i & 3] : e1[i & 3]) - ((i < 4) ? c0[i & 3] : c1[i & 3]); kdT[tsw(k0 + i, t)] = (bf16)f2bf(omf[j][i] * fexp(d)); }
    }
    if (tid < 128) DEC[cid * 128 + tid] = fexp(bc[63 * 128 + tid]);
    __syncthreads();
    chunk_a_core64_bf16(lds, DS + (size_t)cid * 16384, tid);
    __syncthreads();
}
__device__ __forceinline__ void hgrn_c64(int cid, const bf16* P, const bf16* DS, const float* gnorm, bf16* YM, const LAS float* lbv, LAS unsigned char* lds, int tid) {
    const ChunkInfo ci = chunk_info(cid);
    LAS float* bc = (LAS float*)(lds + CB_BC);
    LAS bf16* qmB = (LAS bf16*)(lds + CB_QM); LAS bf16* kmB = (LAS bf16*)(lds + CB_KM); LAS bf16* vvT = (LAS bf16*)(lds + CB_VVT); LAS float* sk = (LAS float*)(lds + CB_SK);
    u32x4v qw[2], fw[2], iw[2];
#pragma unroll
    for (int j = 0; j < 2; ++j) { const int p = tid + 512 * j, t = p >> 4, k0 = 8 * (p & 15); const bf16* pr = P + (size_t)(ci.row0 + t) * PLD + ci.h * 128 + k0;
        qw[j] = *(const u32x4v*)(pr + 1536); fw[j] = *(const u32x4v*)(pr + 2048); iw[j] = *(const u32x4v*)(pr + 2560); }
    float omf[2][8], sq[2][8];
#pragma unroll
    for (int j = 0; j < 2; ++j) {
        const int p = tid + 512 * j, t = p >> 4, k0 = 8 * (p & 15);
        float fb[8], qb[8]; unpack8(fw[j], fb); unpack8(qw[j], qb);
        const f32x4 l0 = *(const LAS f32x4*)(lbv + ci.h * 128 + k0), l1 = *(const LAS f32x4*)(lbv + ci.h * 128 + k0 + 4);
        f32x4 lg[2];
#pragma unroll
        for (int i = 0; i < 8; ++i) { const float lb = (i < 4) ? l0[i & 3] : l1[i & 3]; const float f = lb + (1.f - lb) * fsig(fb[i]); lg[i >> 2][i & 3] = flog(f); omf[j][i] = 1.f - f; sq[j][i] = fsilu(qb[i]); }
        *(LAS f32x4*)(bc + t * 128 + k0) = lg[0]; *(LAS f32x4*)(bc + t * 128 + k0 + 4) = lg[1];
        const unsigned iv[4] = {iw[j].x, iw[j].y, iw[j].z, iw[j].w};
#pragma unroll
        for (int i = 0; i < 8; ++i) vvT[tsw(k0 + i, t)] = (bf16)((i & 1) ? (iv[i >> 1] >> 16) : (iv[i >> 1] & 0xffffu));
    }
    __syncthreads();
    cumsum64(bc, (LAS float*)(lds + CB_ST), tid);
    if (tid < 128) sk[tid] = fexp(bc[32 * 128 + tid]);
#pragma unroll
    for (int j = 0; j < 2; ++j) {
        const int p = tid + 512 * j, t = p >> 4, k0 = 8 * (p & 15);
        const f32x4 m0 = *(const LAS f32x4*)(bc + 32 * 128 + k0), m1 = *(const LAS f32x4*)(bc + 32 * 128 + k0 + 4), c0 = *(const LAS f32x4*)(bc + t * 128 + k0), c1 = *(const LAS f32x4*)(bc + t * 128 + k0 + 4);
        float qv[8], kv[8];
#pragma unroll
        for (int i = 0; i < 8; ++i) { const float d = ((i < 4) ? c0[i & 3] : c1[i & 3]) - ((i < 4) ? m0[i & 3] : m1[i & 3]); qv[i] = sq[j][i] * fexp(d); kv[i] = omf[j][i] * fexp(-d); }
        u32x4v qo, ko; qo.x = pk2(qv[0], qv[1]); qo.y = pk2(qv[2], qv[3]); qo.z = pk2(qv[4], qv[5]); qo.w = pk2(qv[6], qv[7]); ko.x = pk2(kv[0], kv[1]); ko.y = pk2(kv[2], kv[3]); ko.z = pk2(kv[4], kv[5]); ko.w = pk2(kv[6], kv[7]);
        *(LAS u32x4v*)(qmB + t * 136 + k0) = qo; *(LAS u32x4v*)(kmB + t * 136 + k0) = ko;
    }
    __syncthreads();
    chunk_c_core64_bf16(lds, DS + (size_t)cid * 16384, gnorm + ci.h * 128, P + (size_t)ci.row0 * PLD + 3072 + ci.h * 128, YM + (size_t)ci.row0 * D + 512 + ci.h * 128, tid);
}
__device__ __forceinline__ void ret_a64(int cid, const bf16* P, bf16* DS, const LAS float* invf, LAS unsigned char* lds, int tid) {
    const ChunkInfo ci = chunk_info(cid);
    LAS bf16* kdT = (LAS bf16*)lds; LAS bf16* vvT = (LAS bf16*)(lds + CB_VVT);
    const float lg2 = ret_lg2(ci.h);
    const int t = tid >> 3, i0 = 8 * (tid & 7);
    const bf16* pr = P + (size_t)(ci.row0 + t) * PLD + ci.h * 128 + i0;
    const u32x4v k1w = *(const u32x4v*)(pr + 512), k2w = *(const u32x4v*)(pr + 512 + 64), v1w = *(const u32x4v*)(pr + 1024), v2w = *(const u32x4v*)(pr + 1024 + 64);
    float k1[8], k2[8]; unpack8(k1w, k1); unpack8(k2w, k2);
    const unsigned v1v[4] = {v1w.x, v1w.y, v1w.z, v1w.w}, v2v[4] = {v2w.x, v2w.y, v2w.z, v2w.w};
    const f32x4 f0 = *(const LAS f32x4*)(invf + i0), f1 = *(const LAS f32x4*)(invf + i0 + 4);
    const float sc = 0.08838834764831845f * __builtin_amdgcn_exp2f(lg2 * (float)(63 - t));
#pragma unroll
    for (int j = 0; j < 8; ++j) {
        const int i = i0 + j;
        float c, s; rope_cs(ci.pos0 + t, (j < 4) ? f0[j & 3] : f1[j & 3], c, s);
        kdT[tsw(i, t)] = (bf16)f2bf((k1[j] * c - k2[j] * s) * sc); kdT[tsw(64 + i, t)] = (bf16)f2bf((k1[j] * s + k2[j] * c) * sc);
        vvT[tsw(i, t)] = (bf16)((j & 1) ? (v1v[j >> 1] >> 16) : (v1v[j >> 1] & 0xffffu)); vvT[tsw(64 + i, t)] = (bf16)((j & 1) ? (v2v[j >> 1] >> 16) : (v2v[j >> 1] & 0xffffu));
    }
    __syncthreads();
    chunk_a_core64_bf16(lds, DS + (size_t)cid * 16384, tid);
    __syncthreads();
}
__device__ __forceinline__ void ret_c64(int cid, const bf16* P, const bf16* DS, const float* gnorm, bf16* YM, const LAS float* invf, LAS unsigned char* lds, int tid) {
    const ChunkInfo ci = chunk_info(cid);
    LAS bf16* qmB = (LAS bf16*)(lds + CB_QM); LAS bf16* kmB = (LAS bf16*)(lds + CB_KM); LAS bf16* vvT = (LAS bf16*)(lds + CB_VVT); LAS float* sk = (LAS float*)(lds + CB_SK);
    const float lg2 = ret_lg2(ci.h);
    const int t = tid >> 3, i0 = 8 * (tid & 7);
    const bf16* pr = P + (size_t)(ci.row0 + t) * PLD + ci.h * 128 + i0;
    const u32x4v q1w = *(const u32x4v*)(pr), q2w = *(const u32x4v*)(pr + 64), k1w = *(const u32x4v*)(pr + 512), k2w = *(const u32x4v*)(pr + 512 + 64), v1w = *(const u32x4v*)(pr + 1024), v2w = *(const u32x4v*)(pr + 1024 + 64);
    float q1[8], q2[8], k1[8], k2[8]; unpack8(q1w, q1); unpack8(q2w, q2); unpack8(k1w, k1); unpack8(k2w, k2);
    const unsigned v1v[4] = {v1w.x, v1w.y, v1w.z, v1w.w}, v2v[4] = {v2w.x, v2w.y, v2w.z, v2w.w};
    const f32x4 f0 = *(const LAS f32x4*)(invf + i0), f1 = *(const LAS f32x4*)(invf + i0 + 4);
    const float dq = __builtin_amdgcn_exp2f(lg2 * (float)(t - 32)), dk = 0.08838834764831845f * __builtin_amdgcn_exp2f(lg2 * (float)(32 - t));
    float qa[8], qb[8], ka[8], kb[8];
#pragma unroll
    for (int j = 0; j < 8; ++j) {
        const int i = i0 + j;
        float c, s; rope_cs(ci.pos0 + t, (j < 4) ? f0[j & 3] : f1[j & 3], c, s);
        qa[j] = (q1[j] * c - q2[j] * s) * dq; qb[j] = (q1[j] * s + q2[j] * c) * dq; ka[j] = (k1[j] * c - k2[j] * s) * dk; kb[j] = (k1[j] * s + k2[j] * c) * dk;
        vvT[tsw(i, t)] = (bf16)((j & 1) ? (v1v[j >> 1] >> 16) : (v1v[j >> 1] & 0xffffu)); vvT[tsw(64 + i, t)] = (bf16)((j & 1) ? (v2v[j >> 1] >> 16) : (v2v[j >> 1] & 0xffffu));
    }
    { u32x4v w; w.x = pk2(qa[0], qa[1]); w.y = pk2(qa[2], qa[3]); w.z = pk2(qa[4], qa[5]); w.w = pk2(qa[6], qa[7]); *(LAS u32x4v*)(qmB + t * 136 + i0) = w;
      w.x = pk2(qb[0], qb[1]); w.y = pk2(qb[2], qb[3]); w.z = pk2(qb[4], qb[5]); w.w = pk2(qb[6], qb[7]); *(LAS u32x4v*)(qmB + t * 136 + 64 + i0) = w;
      w.x = pk2(ka[0], ka[1]); w.y = pk2(ka[2], ka[3]); w.z = pk2(ka[4], ka[5]); w.w = pk2(ka[6], ka[7]); *(LAS u32x4v*)(kmB + t * 136 + i0) = w;
      w.x = pk2(kb[0], kb[1]); w.y = pk2(kb[2], kb[3]); w.z = pk2(kb[4], kb[5]); w.w = pk2(kb[6], kb[7]); *(LAS u32x4v*)(kmB + t * 136 + 64 + i0) = w; }
    if (tid < 128) sk[tid] = __builtin_amdgcn_exp2f(lg2 * 33.0f);
    __syncthreads();
    chunk_c_core64_bf16(lds, DS + (size_t)cid * 16384, gnorm + ci.h * 128, P + (size_t)ci.row0 * PLD + 1536 + ci.h * 128, YM + (size_t)ci.row0 * D + ci.h * 128, tid);
}

__device__ __forceinline__ void sample_state_load(const float* S0, float (&S)[32], int tid) {
    const int v = tid & 127, kq = tid >> 7;
#pragma unroll
    for (int i = 0; i < 32; ++i) S[i] = S0[(size_t)(kq * 32 + i) * 128 + v];
}
__device__ __forceinline__ void sample_rec_core(float (&S)[32], float* Sout, const float* gn, bf16* yout  , LAS unsigned char* lds, int tid) {
    const LAS float* dk = (const LAS float*)lds; const LAS float* kk = dk + 1024; const LAS float* qq = kk + 1024; const LAS float* vv = qq + 1024; const LAS float* gg = vv + 1024; LAS float* op = (LAS float*)(lds + 20480);
    const int v = tid & 127, kq = tid >> 7, lane = tid & 63, w = tid >> 6;
#pragma unroll 1
    for (int t = 0; t < 8; ++t) {
        const float x = vv[t * 128 + v]; float o = 0.f;
        const LAS f32x4* d4 = (const LAS f32x4*)(dk + t * 128 + kq * 32); const LAS f32x4* k4 = (const LAS f32x4*)(kk + t * 128 + kq * 32); const LAS f32x4* q4 = (const LAS f32x4*)(qq + t * 128 + kq * 32);
#pragma unroll
        for (int i = 0; i < 8; ++i) {
            const f32x4 d = d4[i], k = k4[i], q = q4[i];
            S[4 * i + 0] = d.x * S[4 * i + 0] + k.x * x; o += q.x * S[4 * i + 0];
            S[4 * i + 1] = d.y * S[4 * i + 1] + k.y * x; o += q.y * S[4 * i + 1];
            S[4 * i + 2] = d.z * S[4 * i + 2] + k.z * x; o += q.z * S[4 * i + 2];
            S[4 * i + 3] = d.w * S[4 * i + 3] + k.w * x; o += q.w * S[4 * i + 3];
        }
        op[(t * 4 + kq) * 128 + v] = o;
    }
#pragma unroll
    for (int i = 0; i < 32; ++i) Sout[(size_t)(kq * 32 + i) * 128 + v] = S[i];
    __syncthreads();
    {
        float o0 = 0.f, o1 = 0.f;
#pragma unroll
        for (int q = 0; q < 4; ++q) { o0 += op[(w * 4 + q) * 128 + lane]; o1 += op[(w * 4 + q) * 128 + 64 + lane]; }
        const float rs = __builtin_amdgcn_rsqf(wave_sum(o0 * o0 + o1 * o1) * (1.0f / 128.0f) + 1e-6f);
        yout[(size_t)w * D + lane] = (bf16)f2bf(o0 * rs * gn[lane] * fsilu(gg[w * 128 + lane]));
        yout[(size_t)w * D + 64 + lane] = (bf16)f2bf(o1 * rs * gn[64 + lane] * fsilu(gg[w * 128 + 64 + lane]));
    }
    __syncthreads();
}
__device__ __forceinline__ void hgrn_sample_unit(int j  , const bf16* P, const float* state_s, float* out_s, const float* gnorm, bf16* YM, const LAS float* lbv, LAS unsigned char* lds, int tid) {
    const int b = j >> 2, h = j & 3, row0 = MP + b * 8;
    LAS float* dk = (LAS float*)lds; LAS float* kk = dk + 1024; LAS float* qq = kk + 1024; LAS float* vv = qq + 1024; LAS float* gg = vv + 1024;
    float S[32]; sample_state_load(state_s + (size_t)j * 16384, S, tid);
#pragma unroll
    for (int q = 0; q < 2; ++q) {
        const int e = tid + 512 * q, t = e >> 7, k = e & 127; const size_t ro = (size_t)(row0 + t) * PLD + h * 128 + k;
        const float fb = bf2f(P[ro + 2048]), ib = bf2f(P[ro + 2560]), qb = bf2f(P[ro + 1536]), gb = bf2f(P[ro + 3072]); const float lb = lbv[h * 128 + k];
        const float f = lb + (1.f - lb) * fsig(fb);
        dk[e] = f; kk[e] = 1.f - f; qq[e] = fsilu(qb); vv[e] = ib; gg[e] = gb;
    }
    __syncthreads();
    sample_rec_core(S, out_s + (size_t)j * 16384, gnorm + h * 128, YM + (size_t)row0 * D + 512 + h * 128, lds, tid);
}
__device__ __forceinline__ void ret_sample_unit(int j, const bf16* P, const float* state_s, float* out_s, const float* gnorm, bf16* YM, const LAS float* invf, LAS unsigned char* lds, int tid) {
    const int b = j >> 2, h = j & 3, row0 = MP + b * 8;
    LAS float* dk = (LAS float*)lds; LAS float* kk = dk + 1024; LAS float* qq = kk + 1024; LAS float* vv = qq + 1024; LAS float* gg = vv + 1024;
    const float gam = 1.0f - __builtin_amdgcn_exp2f(-5.0f - (float)h);
    float S[32]; sample_state_load(state_s + (size_t)j * 16384, S, tid);
    {
        const int t = tid >> 6, i = tid & 63; const size_t ro = (size_t)(row0 + t) * PLD + h * 128 + i;
        float c, s; rope_cs(16384 + t, invf[i], c, s);
        const float q1 = bf2f(P[ro]), q2 = bf2f(P[ro + 64]), k1 = bf2f(P[ro + 512]), k2 = bf2f(P[ro + 512 + 64]);
        qq[t * 128 + i] = q1 * c - q2 * s; qq[t * 128 + 64 + i] = q1 * s + q2 * c;
        kk[t * 128 + i] = (k1 * c - k2 * s) * 0.08838834764831845f; kk[t * 128 + 64 + i] = (k1 * s + k2 * c) * 0.08838834764831845f;
        dk[t * 128 + i] = gam; dk[t * 128 + 64 + i] = gam;
        vv[t * 128 + i] = bf2f(P[ro + 1024]); vv[t * 128 + 64 + i] = bf2f(P[ro + 1024 + 64]);
        gg[t * 128 + i] = bf2f(P[ro + 1536]); gg[t * 128 + 64 + i] = bf2f(P[ro + 1536 + 64]);
    }
    __syncthreads();
    sample_rec_core(S, out_s + (size_t)j * 16384, gnorm + h * 128, YM + (size_t)row0 * D + h * 128, lds, tid);
}

template <bool HGRN> __device__ __forceinline__ void chunk_scan(const bf16* DS, bf16* SB, const float* DEC, float* out_p, int gtid, int gthreads) {
    for (int e4 = gtid; e4 < 32 * 4096; e4 += gthreads) {
        const int bh = e4 >> 12, kv4 = e4 & 4095, k = kv4 >> 5, vp = (kv4 & 31) * 4;
        float gC = 0.f; if (!HGRN) gC = __builtin_amdgcn_exp2f(ret_lg2(bh & 3) * 64.0f);
        const bf16* p0 = DS + (size_t)(bh * 32) * 16384 + kv4 * 4; bf16* p1 = SB + (size_t)(bh * 32) * 16384 + kv4 * 4;
        f32x4 S = (f32x4){0.f, 0.f, 0.f, 0.f};
#pragma unroll 1
        for (int c0 = 0; c0 < 32; c0 += 16) {
            u32x2v tv[16]; float dv[16];
#pragma unroll
            for (int c = 0; c < 16; ++c) { tv[c] = *(const u32x2v*)(p0 + (size_t)(c0 + c) * 16384); dv[c] = HGRN ? DEC[(bh * 32 + c0 + c) * 128 + k] : gC; }
#pragma unroll
            for (int c = 0; c < 16; ++c) {
                u32x2v o; o.x = pg8::cvt_pk_bf16(S[0], S[1]); o.y = pg8::cvt_pk_bf16(S[2], S[3]);
                *(u32x2v*)(p1 + (size_t)(c0 + c) * 16384) = o;
                const f32x4 t = {__uint_as_float(tv[c].x << 16), __uint_as_float(tv[c].x & 0xffff0000u), __uint_as_float(tv[c].y << 16), __uint_as_float(tv[c].y & 0xffff0000u)};
                S = S * dv[c] + t;
            }
        }
        *(f32x4*)(out_p + (size_t)bh * 16384 + k * 128 + 16 * ((vp >> 2) & 7) + 4 * (vp >> 5)) = S;
    }
}

__device__ __forceinline__ void conv_phase(const bf16* P, const float* cw, const float* sconv, bf16* YM, float* conv_p, float* conv_s, int gtid, int gthreads) {
    for (int it = gtid; it < (MT / 4) * 64; it += gthreads) {
        const int row0 = (it >> 6) * 4, c = (it & 63) * 8;
        int t0, T, b; if (row0 < MP) { b = row0 >> 11; t0 = row0 & 2047; T = 2048; } else { const int r2 = row0 - MP; b = r2 >> 3; t0 = r2 & 7; T = 8; }
        const bool first = (t0 == 0);
        const bf16* pr = P + (size_t)row0 * PLD + c;
        u32x4v va[6], ca[6], ba[4];
#pragma unroll
        for (int q = 0; q < 6; ++q) { const int dq = (first && q < 2) ? 2 : q;
            va[q] = *(const u32x4v*)(pr + (long)(dq - 2) * PLD); ca[q] = *(const u32x4v*)(pr + (long)(dq - 2) * PLD + 1024); }
#pragma unroll
        for (int r = 0; r < 4; ++r) ba[r] = *(const u32x4v*)(pr + (long)r * PLD + 512);
        f32x4 w0[2], w1[2], w2[2];
#pragma unroll
        for (int h = 0; h < 2; ++h) { w0[h] = *(const f32x4*)(cw + c + 4 * h); w1[h] = *(const f32x4*)(cw + 512 + c + 4 * h); w2[h] = *(const f32x4*)(cw + 1024 + c + 4 * h); }
        f32x4 s0[2], s1[2];
#pragma unroll
        for (int h = 0; h < 2; ++h) { s0[h] = (f32x4){0.f, 0.f, 0.f, 0.f}; s1[h] = s0[h]; }
        if (first && row0 >= MP) {
#pragma unroll
            for (int h = 0; h < 2; ++h) { s0[h] = *(const f32x4*)(sconv + (b * 2 + 0) * 512 + c + 4 * h); s1[h] = *(const f32x4*)(sconv + (b * 2 + 1) * 512 + c + 4 * h); } }
        float u[6][8];
#pragma unroll
        for (int q = 0; q < 6; ++q) { float fa[8], fc[8]; unpack8(va[q], fa); unpack8(ca[q], fc);
#pragma unroll
            for (int j = 0; j < 8; ++j) u[q][j] = fc[j] * fa[j]; }
        if (first) {
#pragma unroll
            for (int j = 0; j < 8; ++j) { u[0][j] = s0[j >> 2][j & 3]; u[1][j] = s1[j >> 2][j & 3]; } }
#pragma unroll
        for (int r = 0; r < 4; ++r) {
            float fb[8], y[8]; unpack8(ba[r], fb);
#pragma unroll
            for (int j = 0; j < 8; ++j) y[j] = fb[j] * (w0[j >> 2][j & 3] * u[r][j] + w1[j >> 2][j & 3] * u[r + 1][j] + w2[j >> 2][j & 3] * u[r + 2][j]);
            u32x4v o; o.x = pk2(y[0], y[1]); o.y = pk2(y[2], y[3]); o.z = pk2(y[4], y[5]); o.w = pk2(y[6], y[7]);
            *(u32x4v*)(YM + (size_t)(row0 + r) * D + c) = o;
        }
        if (t0 + 4 == T) {
#pragma unroll
            for (int i = 0; i < 2; ++i) { float* op = ((row0 < MP) ? conv_p : conv_s) + (b * 2 + i) * 512 + c;
                *(f32x4*)op = (f32x4){u[4 + i][0], u[4 + i][1], u[4 + i][2], u[4 + i][3]}; *(f32x4*)(op + 4) = (f32x4){u[4 + i][4], u[4 + i][5], u[4 + i][6], u[4 + i][7]}; }
        }
    }
}

__device__ __forceinline__ float pd_mix(const bf16* P, int row, int t, int b, bool sample, int col  , const float* mu, const float* sshift) {
    const float cur = bf2f(P[(size_t)row * PLD + 2048 + col]);
    const float prev = (t > 0) ? bf2f(P[(size_t)(row - 1) * PLD + 2048 + col]) : (sample ? sshift[b * 1792 + col] : 0.f);
    return cur + mu[col] * (prev - cur);
}
__device__ __forceinline__ float ftanh(float x) { return 1.0f - 2.0f * __builtin_amdgcn_rcpf(1.0f + __builtin_amdgcn_exp2f(2.885390081777927f * x)); }
__device__ __forceinline__ void lora_prep_phase(const bf16* P, const float* mu, const float* sshift, bf16* AP, float* shift_p, float* shift_s, int gtid, int gthreads) {
    for (int it = gtid; it < (MT / 4) * 32; it += gthreads) {
        const int row0 = (it >> 5) * 4, j0 = (it & 31) * 8;
        int t0, b; bool sample; if (row0 < MP) { b = row0 >> 11; t0 = row0 & 2047; sample = false; } else { const int r2 = row0 - MP; b = r2 >> 3; t0 = r2 & 7; sample = true; }
        const bf16* pr = P + (size_t)row0 * PLD + 2048 + 1536 + j0;
        u32x4v rv[5];
#pragma unroll
        for (int q = 0; q < 5; ++q) { const int dq = (t0 == 0 && q == 0) ? 1 : q; rv[q] = *(const u32x4v*)(pr + (long)(dq - 1) * PLD); }
        const f32x4 m0 = *(const f32x4*)(mu + 1536 + j0), m1 = *(const f32x4*)(mu + 1536 + j0 + 4);
        f32x4 h0 = (f32x4){0.f, 0.f, 0.f, 0.f}, h1 = h0;
        if (t0 == 0 && sample) { h0 = *(const f32x4*)(sshift + b * 1792 + 1536 + j0); h1 = *(const f32x4*)(sshift + b * 1792 + 1536 + j0 + 4); }
        float prv[8];
        if (t0 == 0) {
#pragma unroll
            for (int j = 0; j < 8; ++j) prv[j] = (j < 4) ? h0[j & 3] : h1[j & 3];
        } else unpack8(rv[0], prv);
#pragma unroll
        for (int r = 0; r < 4; ++r) {
            float cur[8], y[8]; unpack8(rv[r + 1], cur);
#pragma unroll
            for (int j = 0; j < 8; ++j) { const float x = cur[j] + ((j < 4) ? m0[j & 3] : m1[j & 3]) * (prv[j] - cur[j]); y[j] = (j0 < 64) ? ftanh(x) : (j0 < 128) ? x : fsig(x); prv[j] = cur[j]; }
            u32x4v o; o.x = pk2(y[0], y[1]); o.y = pk2(y[2], y[3]); o.z = pk2(y[4], y[5]); o.w = pk2(y[6], y[7]);
            *(u32x4v*)(AP + (size_t)(row0 + r) * 256 + j0) = o;
        }
    }
    for (int e = gtid; e < (8 + 128) * 1792; e += gthreads) {
        const int bb = e / 1792, col = e % 1792;
        if (bb < 8) shift_p[e] = bf2f(P[(size_t)(bb * 2048 + 2047) * PLD + 2048 + col]);
        else shift_s[(bb - 8) * 1792 + col] = bf2f(P[(size_t)(MP + (bb - 8) * 8 + 7) * PLD + 2048 + col]);
    }
}

typedef float f32x2 __attribute__((ext_vector_type(2)));
struct RwkvPar { float w0, a0, k_k, k_a, r_k, lng, lnb; };
struct RwkvRaw { float r, kd, vd, lw, la, gt; };
__device__ __forceinline__ RwkvRaw rwkv_load_raw(const bf16* P, const bf16* LB, const float* mu, const float* sshift, int row, int t, int b, bool sample, int hc) {
    RwkvRaw x;
    x.r = pd_mix(P, row, t, b, sample, hc, mu, sshift);
    x.kd = pd_mix(P, row, t, b, sample, 512 + hc, mu, sshift);
    x.vd = pd_mix(P, row, t, b, sample, 1024 + hc, mu, sshift);
    x.lw = bf2f(LB[(size_t)row * 1536 + hc]); x.la = bf2f(LB[(size_t)row * 1536 + 512 + hc]); x.gt = bf2f(LB[(size_t)row * 1536 + 1024 + hc]);
    return x;
}
__device__ __forceinline__ RwkvPar rwkv_params(ArgsP a, int hc) {
    RwkvPar p; p.w0 = a->in[I_W0][hc]; p.a0 = a->in[I_A0][hc]; p.k_k = a->in[I_KK][hc]; p.k_a = a->in[I_KA][hc]; p.r_k = a->in[I_RK][hc]; p.lng = a->in[I_LNG][hc]; p.lnb = a->in[I_LNB][hc]; return p;
}

constexpr int NRCP = 8192, NRC = 9216;
constexpr int REC_BYTES = 18432, REC_Q1T = 0, REC_Q2T = 2176, REC_GT = 2944, REC_HT = 11648, REC_VT = 14720, REC_GC = 17792;
__device__ __forceinline__ void rwkv_r1_unit4(int cu4, ArgsP a, const bf16* P, const bf16* LB, unsigned char* RREC, float* RGB, LAS unsigned char* lds, int tid) {
    constexpr int RL = 68;
    const int lane = tid & 63, g4 = __builtin_amdgcn_readfirstlane(tid >> 7), wl = __builtin_amdgcn_readfirstlane((tid >> 6) & 1), tg = tid & 127;
    const int cu = cu4 * 4 + g4;
    const bool sample = cu >= NRCP;
    int b, h, row0, t0, ntok;
    if (!sample) { const int bh = cu >> 7, c = cu & 127; b = bh >> 3; h = bh & 7; row0 = b * 2048 + c * 16; t0 = c * 16; ntok = 16; }
    else { const int bh = cu - NRCP; b = bh >> 3; h = bh & 7; row0 = MP + b * 8; t0 = 0; ntok = 8; }
    const int hc = h * 64 + lane;
    LAS float* base = (LAS float*)(lds + g4 * 34816);
    LAS float* Rr = base; LAS float* Kk = Rr + 16 * RL; LAS float* Aa = Kk + 16 * RL; LAS float* Bb = Aa + 16 * RL;
    LAS float* Ww = Bb + 16 * RL;
    LAS float* MAT = Ww;
    LAS float* TT = MAT + 1024;
    LAS float* P2 = TT + 256;
    LAS float* P1 = P2 + 256;
    LAS float* GC = P1 + 1088;
    LAS float* Vv = GC + 64;
    unsigned char* rec = RREC + (size_t)cu * REC_BYTES;
    bf16* q1t = (bf16*)(rec + REC_Q1T); bf16* q2t = (bf16*)(rec + REC_Q2T); bf16* gt = (bf16*)(rec + REC_GT); bf16* ht = (bf16*)(rec + REC_HT); bf16* vt = (bf16*)(rec + REC_VT);
    {
        const int tt = lane >> 3, c0 = 8 * (lane & 7), hc0 = h * 64 + c0, tl = wl * 8 + tt;
        const bool live = tl < ntok;
        const int row = row0 + (live ? tl : 0), t = t0 + (live ? tl : 0);
        const bf16* pr = P + (size_t)row * PLD + 2048 + hc0; const bf16* lr = LB + (size_t)row * 1536 + hc0;
        const bool hasprev = t > 0;
        const bf16* pp = hasprev ? pr - PLD : pr;
        u32x4v cw[3], pw[3], lw_[3];
#pragma unroll
        for (int g = 0; g < 3; ++g) { cw[g] = *(const u32x4v*)(pr + 512 * g); pw[g] = *(const u32x4v*)(pp + 512 * g); lw_[g] = *(const u32x4v*)(lr + 512 * g); }
        const float* mu = a->in[I_MU];
        f32x4 mv[3][2], sh[3][2];
#pragma unroll
        for (int g = 0; g < 3; ++g)
#pragma unroll
            for (int hq = 0; hq < 2; ++hq) { mv[g][hq] = *(const f32x4*)(mu + 512 * g + hc0 + 4 * hq); sh[g][hq] = (f32x4){0.f, 0.f, 0.f, 0.f}; }
        if (!hasprev && sample) {
#pragma unroll
            for (int g = 0; g < 3; ++g)
#pragma unroll
                for (int hq = 0; hq < 2; ++hq) sh[g][hq] = *(const f32x4*)(a->in[I_SSHIFT] + (size_t)b * 1792 + 512 * g + hc0 + 4 * hq);
        }
        f32x4 pw0[2], pa0[2], pkk[2], pka[2], prk[2];
#pragma unroll
        for (int hq = 0; hq < 2; ++hq) { pw0[hq] = *(const f32x4*)(a->in[I_W0] + hc0 + 4 * hq); pa0[hq] = *(const f32x4*)(a->in[I_A0] + hc0 + 4 * hq); pkk[hq] = *(const f32x4*)(a->in[I_KK] + hc0 + 4 * hq);
            pka[hq] = *(const f32x4*)(a->in[I_KA] + hc0 + 4 * hq); prk[hq] = *(const f32x4*)(a->in[I_RK] + hc0 + 4 * hq); }
        float xr[8], xk[8], xv[8], xlw[8], xla[8], xgt[8];
        {
            float cur[8], prv[8];
#pragma unroll
            for (int g = 0; g < 3; ++g) {
                unpack8(cw[g], cur); unpack8(pw[g], prv);
#pragma unroll
                for (int j = 0; j < 8; ++j) { const float pv = hasprev ? prv[j] : sh[g][j >> 2][j & 3]; const float m = mv[g][j >> 2][j & 3]; const float y = cur[j] + m * (pv - cur[j]);
                    if (g == 0) xr[j] = y; else if (g == 1) xk[j] = y; else xv[j] = y; }
            }
            unpack8(lw_[0], xlw); unpack8(lw_[1], xla); unpack8(lw_[2], xgt);
        }
        float wd[8], km[8], av_[8], bv_[8], kkr[8], asg[8];
        float n2 = 0.f, cf = 0.f;
#pragma unroll
        for (int j = 0; j < 8; ++j) {
            const float z = -(pw0[j >> 2][j & 3] + xlw[j]);
            const float sp = (z > 20.f) ? z : flog(1.f + fexp(z));
            wd[j] = fexp(-fexp(-sp - 0.5f));
            asg[j] = fsig(pa0[j >> 2][j & 3] + xla[j]);
            kkr[j] = xk[j] * pkk[j >> 2][j & 3]; n2 += kkr[j] * kkr[j];
            km[j] = xk[j] * (1.f + (asg[j] - 1.f) * pka[j >> 2][j & 3]);
            cf += xr[j] * km[j] * prk[j >> 2][j & 3];
        }
        n2 += dpp_f<0xB1>(n2); n2 += dpp_f<0x4E>(n2); n2 += dpp_f<0x141>(n2);
        cf += dpp_f<0xB1>(cf); cf += dpp_f<0x4E>(cf); cf += dpp_f<0x141>(cf);
        const float inrm = 1.0f / fmaxf(sqrtf(n2), 1e-12f);
#pragma unroll
        for (int j = 0; j < 8; ++j) { const float kk = kkr[j] * inrm; av_[j] = -kk; bv_[j] = kk * asg[j]; }
        if (live) {
            u32x4v g0, g1;
            g0.x = pk2(xgt[0], cf * xv[0]); g0.y = pk2(xgt[1], cf * xv[1]); g0.z = pk2(xgt[2], cf * xv[2]); g0.w = pk2(xgt[3], cf * xv[3]);
            g1.x = pk2(xgt[4], cf * xv[4]); g1.y = pk2(xgt[5], cf * xv[5]); g1.z = pk2(xgt[6], cf * xv[6]); g1.w = pk2(xgt[7], cf * xv[7]);
            unsigned* gp = (unsigned*)RGB + ((size_t)cu * 16 + tl) * 64 + c0;
            *(u32x4v*)gp = g0; *(u32x4v*)(gp + 4) = g1;
        } else {
#pragma unroll
            for (int j = 0; j < 8; ++j) { xr[j] = 0.f; wd[j] = 1.f; km[j] = 0.f; xv[j] = 0.f; av_[j] = 0.f; bv_[j] = 0.f; }
        }
#pragma unroll
        for (int hq = 0; hq < 2; ++hq) {
            *(LAS f32x4*)(Rr + tl * RL + c0 + 4 * hq) = (f32x4){xr[4 * hq], xr[4 * hq + 1], xr[4 * hq + 2], xr[4 * hq + 3]};
            *(LAS f32x4*)(Ww + tl * 64 + c0 + 4 * hq) = (f32x4){wd[4 * hq], wd[4 * hq + 1], wd[4 * hq + 2], wd[4 * hq + 3]};
            *(LAS f32x4*)(Kk + tl * RL + c0 + 4 * hq) = (f32x4){km[4 * hq], km[4 * hq + 1], km[4 * hq + 2], km[4 * hq + 3]};
            *(LAS f32x4*)(Aa + tl * RL + c0 + 4 * hq) = (f32x4){av_[4 * hq], av_[4 * hq + 1], av_[4 * hq + 2], av_[4 * hq + 3]};
            *(LAS f32x4*)(Bb + tl * RL + c0 + 4 * hq) = (f32x4){bv_[4 * hq], bv_[4 * hq + 1], bv_[4 * hq + 2], bv_[4 * hq + 3]};
            *(LAS f32x4*)(Vv + tl * 64 + c0 + 4 * hq) = (f32x4){xv[4 * hq], xv[4 * hq + 1], xv[4 * hq + 2], xv[4 * hq + 3]};
        }
    }
    __syncthreads();
    if (tg < 64) {
        const int k = tg; float g = 1.f;
#pragma unroll
        for (int t = 0; t < 16; ++t) {
            const float gp = g; g *= Ww[t * 64 + k]; const float inv = 1.0f / g;
            Aa[t * RL + k] *= gp; Bb[t * RL + k] *= inv; Kk[t * RL + k] *= inv; Rr[t * RL + k] *= g;
        }
        GC[k] = g; ((float*)(rec + REC_GC))[k] = g;
    }
    __syncthreads();
    const int ij = lane & 15, kq = lane >> 4;
    {
        f32x4 cm[2];
#pragma unroll
        for (int mm = 0; mm < 2; ++mm) {
            const int m = 2 * wl + mm;
            const LAS float* X = ((m & 1) ? Kk : Bb) + ij * RL; const LAS float* Y = ((m & 2) ? Rr : Aa) + ij * RL;
            f32x4 cacc = (f32x4){0.f, 0.f, 0.f, 0.f};
#pragma unroll
            for (int s_ = 0; s_ < 16; ++s_) cacc = __builtin_amdgcn_mfma_f32_16x16x4f32(X[4 * s_ + kq], Y[4 * s_ + kq], cacc, 0, 0, 0);
            cm[mm] = cacc;
        }
#pragma unroll
        for (int mm = 0; mm < 2; ++mm) { const int m = 2 * wl + mm;
#pragma unroll
            for (int r = 0; r < 4; ++r) { const int i = 4 * kq + r, t = ij; const bool keep = (m & 2) ? (i <= t) : (i < t); MAT[m * 256 + i * 16 + t] = keep ? cm[mm][r] : 0.f; } }
    }
    __syncthreads();
    if (tg < 16) {
        const int i = tg; float x[16];
#pragma unroll
        for (int t = 0; t < 16; ++t) {
            float acc = (i == t) ? 1.f : 0.f;
#pragma unroll
            for (int j = 0; j < 16; ++j) if (j < t) acc += x[j] * MAT[j * 16 + t];
            x[t] = acc;
        }
#pragma unroll
        for (int t = 0; t < 16; ++t) TT[i * 16 + t] = x[t];
    }
    __syncthreads();
    {
#pragma unroll
        for (int q = 0; q < 2; ++q) {
            const int k0 = 16 * (2 * wl + q); f32x4 cacc = (f32x4){0.f, 0.f, 0.f, 0.f};
#pragma unroll
            for (int s_ = 0; s_ < 4; ++s_) { const int j = 4 * s_ + kq; cacc = __builtin_amdgcn_mfma_f32_16x16x4f32(Aa[j * RL + k0 + ij], TT[j * 16 + ij], cacc, 0, 0, 0); }
#pragma unroll
            for (int r = 0; r < 4; ++r) P1[(k0 + 4 * kq + r) * 17 + ij] = cacc[r];
        }
        if (wl == 0) {
            f32x4 cacc = (f32x4){0.f, 0.f, 0.f, 0.f};
#pragma unroll
            for (int s_ = 0; s_ < 4; ++s_) { const int j = 4 * s_ + kq; cacc = __builtin_amdgcn_mfma_f32_16x16x4f32(MAT[256 + ij * 16 + j], TT[j * 16 + ij], cacc, 0, 0, 0); }
#pragma unroll
            for (int r = 0; r < 4; ++r) P2[(4 * kq + r) * 16 + ij] = cacc[r];
        }
    }
    __syncthreads();
    {
#pragma unroll
        for (int q = 0; q < 2; ++q) {
            const int k0 = 16 * (2 * wl + q);
            f32x4 cacc; { const f32x4 r4 = *(const LAS f32x4*)(Rr + ij * RL + k0 + 4 * kq); cacc = r4; }
#pragma unroll
            for (int s_ = 0; s_ < 4; ++s_) { const int j = 4 * s_ + kq; cacc = __builtin_amdgcn_mfma_f32_16x16x4f32(P1[(k0 + ij) * 17 + j], MAT[512 + j * 16 + ij], cacc, 0, 0, 0); }
            u32x2v w; w.x = pk2(cacc[0], cacc[1]); w.y = pk2(cacc[2], cacc[3]);
            *(u32x2v*)(q1t + ij * 68 + k0 + 4 * kq) = w;
        }
        if (wl == 1) {
            f32x4 cacc;
#pragma unroll
            for (int r = 0; r < 4; ++r) cacc[r] = MAT[768 + (4 * kq + r) * 16 + ij];
#pragma unroll
            for (int s_ = 0; s_ < 4; ++s_) { const int j = 4 * s_ + kq; cacc = __builtin_amdgcn_mfma_f32_16x16x4f32(P2[ij * 16 + j], MAT[512 + j * 16 + ij], cacc, 0, 0, 0); }
            u32x2v w; w.x = pk2(cacc[0], cacc[1]); w.y = pk2(cacc[2], cacc[3]);
            *(u32x2v*)(q2t + ij * 24 + 4 * kq) = w;
        }
#pragma unroll
        for (int q = 0; q < 2; ++q) {
            const int k0 = 16 * (2 * wl + q); f32x4 cacc;
#pragma unroll
            for (int r = 0; r < 4; ++r) cacc[r] = Kk[(4 * kq + r) * RL + k0 + ij];
#pragma unroll
            for (int s_ = 0; s_ < 4; ++s_) { const int j = 4 * s_ + kq; cacc = __builtin_amdgcn_mfma_f32_16x16x4f32(P2[ij * 16 + j], Bb[j * RL + k0 + ij], cacc, 0, 0, 0); }
            const float gcv = GC[k0 + ij];
            u32x2v w; w.x = pk2(cacc[0] * gcv, cacc[1] * gcv); w.y = pk2(cacc[2] * gcv, cacc[3] * gcv);
            *(u32x2v*)(ht + (k0 + ij) * 24 + 4 * kq) = w;
        }
        { const int v = tg >> 1, hf = tg & 1; u32x4v o; o.x = pk2(Vv[(8 * hf + 0) * 64 + v], Vv[(8 * hf + 1) * 64 + v]); o.y = pk2(Vv[(8 * hf + 2) * 64 + v], Vv[(8 * hf + 3) * 64 + v]);
          o.z = pk2(Vv[(8 * hf + 4) * 64 + v], Vv[(8 * hf + 5) * 64 + v]); o.w = pk2(Vv[(8 * hf + 6) * 64 + v], Vv[(8 * hf + 7) * 64 + v]); *(u32x4v*)(vt + v * 24 + 8 * hf) = o; }
#pragma unroll
        for (int q = 0; q < 2; ++q) {
            const int kk0 = 16 * (2 * wl + q);
            float pa[4];
#pragma unroll
            for (int s_ = 0; s_ < 4; ++s_) pa[s_] = P1[(kk0 + ij) * 17 + 4 * s_ + kq];
#pragma unroll
            for (int kt = 0; kt < 4; ++kt) {
                const int k0 = 16 * kt; f32x4 cacc = (f32x4){0.f, 0.f, 0.f, 0.f};
#pragma unroll
                for (int s_ = 0; s_ < 4; ++s_) { const int j = 4 * s_ + kq; cacc = __builtin_amdgcn_mfma_f32_16x16x4f32(pa[s_], Bb[j * RL + k0 + ij], cacc, 0, 0, 0); }
                const float gcv = GC[k0 + ij];
                u32x2v w; w.x = pk2(cacc[0] * gcv, cacc[1] * gcv); w.y = pk2(cacc[2] * gcv, cacc[3] * gcv);
                *(u32x2v*)(gt + (k0 + ij) * 68 + kk0 + 4 * kq) = w;
            }
        }
    }
    __syncthreads();
}
struct R2Frags { bf16x8 q1[2][2], q2, g[2][2][2], hq[2], v; };
__device__ __forceinline__ void rwkv_r2_load(R2Frags& F, const LAS unsigned char* rec, int vt, int r32, int hh) {
    F.v = *(const LAS bf16x8*)(rec + REC_VT + (32 * vt + r32) * 48 + 16 * hh);
    const int cr = r32 & 15;
#pragma unroll
    for (int kt = 0; kt < 2; ++kt)
#pragma unroll
        for (int sp = 0; sp < 2; ++sp) {
            const LAS unsigned char* p = rec + REC_Q1T + cr * 136 + (32 * kt + 16 * sp + 4 * hh) * 2;
            const s16x4 lo = *(const LAS s16x4*)p, hi = *(const LAS s16x4*)(p + 16);
            F.q1[kt][sp] = (bf16x8){lo[0], lo[1], lo[2], lo[3], hi[0], hi[1], hi[2], hi[3]};
        }
    F.q2 = *(const LAS bf16x8*)(rec + REC_Q2T + cr * 48 + 16 * hh);
#pragma unroll
    for (int kp = 0; kp < 2; ++kp) {
#pragma unroll
        for (int kt = 0; kt < 2; ++kt)
#pragma unroll
            for (int sp = 0; sp < 2; ++sp) {
                const LAS unsigned char* p = rec + REC_GT + (32 * kp + r32) * 136 + (32 * kt + 16 * sp + 4 * hh) * 2;
                const s16x4 lo = *(const LAS s16x4*)p, hi = *(const LAS s16x4*)(p + 16);
                F.g[kp][kt][sp] = (bf16x8){lo[0], lo[1], lo[2], lo[3], hi[0], hi[1], hi[2], hi[3]};
            }
        F.hq[kp] = *(const LAS bf16x8*)(rec + REC_HT + (32 * kp + r32) * 48 + 16 * hh);
    }
}
__device__ __forceinline__ void rwkv_r2_issue(const R2Frags& F, const LAS unsigned char* rec, int hh, f32x16 (&Sacc)[2], f32x16& O) {
    const LAS float* gcp = (const LAS float*)(rec + REC_GC);
    bf16x8 Sb[2][2];
#pragma unroll
    for (int kt = 0; kt < 2; ++kt)
#pragma unroll
        for (int sp = 0; sp < 2; ++sp) {
            u32x4v pw; pw.x = pg8::cvt_pk_bf16(Sacc[kt][8 * sp + 0], Sacc[kt][8 * sp + 1]); pw.y = pg8::cvt_pk_bf16(Sacc[kt][8 * sp + 2], Sacc[kt][8 * sp + 3]);
            pw.z = pg8::cvt_pk_bf16(Sacc[kt][8 * sp + 4], Sacc[kt][8 * sp + 5]); pw.w = pg8::cvt_pk_bf16(Sacc[kt][8 * sp + 6], Sacc[kt][8 * sp + 7]);
            Sb[kt][sp] = __builtin_bit_cast(bf16x8, pw);
        }
#pragma unroll
    for (int kt = 0; kt < 2; ++kt)
#pragma unroll
        for (int g = 0; g < 4; ++g) { const f32x4 g4 = *(const LAS f32x4*)(gcp + 32 * kt + 8 * g + 4 * hh); Sacc[kt][4 * g + 0] *= g4.x; Sacc[kt][4 * g + 1] *= g4.y; Sacc[kt][4 * g + 2] *= g4.z; Sacc[kt][4 * g + 3] *= g4.w; }
#pragma unroll
    for (int r = 0; r < 16; ++r) O[r] = 0.f;
#pragma unroll
    for (int kt = 0; kt < 2; ++kt)
#pragma unroll
        for (int sp = 0; sp < 2; ++sp) {
            O = __builtin_amdgcn_mfma_f32_32x32x16_bf16(F.q1[kt][sp], Sb[kt][sp], O, 0, 0, 0);
            Sacc[0] = __builtin_amdgcn_mfma_f32_32x32x16_bf16(F.g[0][kt][sp], Sb[kt][sp], Sacc[0], 0, 0, 0);
            Sacc[1] = __builtin_amdgcn_mfma_f32_32x32x16_bf16(F.g[1][kt][sp], Sb[kt][sp], Sacc[1], 0, 0, 0);
        }
    O = __builtin_amdgcn_mfma_f32_32x32x16_bf16(F.q2, F.v, O, 0, 0, 0);
    Sacc[0] = __builtin_amdgcn_mfma_f32_32x32x16_bf16(F.hq[0], F.v, Sacc[0], 0, 0, 0);
    Sacc[1] = __builtin_amdgcn_mfma_f32_32x32x16_bf16(F.hq[1], F.v, Sacc[1], 0, 0, 0);
}
__device__ __forceinline__ void rwkv_r2_store(const f32x16& O, LAS float* ob, int vt, int r32, int hh) {
#pragma unroll
    for (int r = 0; r < 8; ++r) ob[((r & 3) + 8 * (r >> 2) + 4 * hh) * 64 + 32 * vt + r32] = O[r];
}
__device__ __forceinline__ void rwkv_r2_step(const LAS unsigned char* rec, f32x16 (&Sacc)[2], LAS float* ob, int vt, int r32, int hh) {
    R2Frags F; f32x16 O; rwkv_r2_load(F, rec, vt, r32, hh); rwkv_r2_issue(F, rec, hh, Sacc, O); rwkv_r2_store(O, ob, vt, r32, hh);
}
__device__ __forceinline__ void rwkv_r2_post(const LAS float* ob, const float* gbp, const RwkvPar& pr, bf16* YM, int row, int hc, int lane) {
    const unsigned gbw = ((const unsigned*)gbp)[lane]; const float gt = __uint_as_float(gbw << 16), bon = __uint_as_float(gbw & 0xffff0000u);
    const float o = ob[lane];
    const float mean = wave_sum(o) * (1.0f / 64.0f); const float dlt = o - mean;
    const float var = wave_sum(dlt * dlt) * (1.0f / 64.0f);
    const float on = dlt * __builtin_amdgcn_rsqf(var + 64e-5f) * pr.lng + pr.lnb;
    YM[(size_t)row * D + 512 + hc] = (bf16)f2bf((on + bon) * gt);
}
__device__ __forceinline__ float xchg32(float send, bool hi) { unsigned a_ = __float_as_uint(send), b_ = a_; asm volatile("" : "+v"(b_)); auto rr = __builtin_amdgcn_permlane32_swap(a_, b_, false, false); return __uint_as_float(hi ? rr[0] : rr[1]); }
__device__ __forceinline__ float xchg16(float send, bool hi) { unsigned a_ = __float_as_uint(send), b_ = a_; asm volatile("" : "+v"(b_)); auto rr = __builtin_amdgcn_permlane16_swap(a_, b_, false, false); return __uint_as_float(hi ? rr[0] : rr[1]); }
__device__ __forceinline__ float reduce8(const float (&v)[8], int lane) {
    float v4[4], v2[2];
    const bool h32 = lane & 32, h16 = lane & 16, h8 = lane & 8;
#pragma unroll
    for (int i = 0; i < 4; ++i) { const float send = h32 ? v[i] : v[i + 4], keep = h32 ? v[i + 4] : v[i]; v4[i] = keep + xchg32(send, h32); }
#pragma unroll
    for (int i = 0; i < 2; ++i) { const float send = h16 ? v4[i] : v4[i + 2], keep = h16 ? v4[i + 2] : v4[i]; v2[i] = keep + xchg16(send, h16); }
    const float send = h8 ? v2[0] : v2[1], keep = h8 ? v2[1] : v2[0];
    float r = keep + dpp_f<0x128>(send);
    r += dpp_f<0xB1>(r); r += dpp_f<0x4E>(r); r += dpp_f<0x141>(r);
    return r;
}
#define R2_BAR() asm volatile("s_waitcnt lgkmcnt(0)\n\ts_barrier" ::: "memory")
constexpr int R1_SPLIT4 = 24, R1_PUBLISHERS = 192;
template <bool DO_POST = true> __device__ __forceinline__ void rwkv_r2_prompt(int b, int h, ArgsP a, const unsigned char* RREC, const float* RGB, bf16* YM, LAS unsigned char* lds, int tid, unsigned* r1flag) {
    const int lane = tid & 63, wave = __builtin_amdgcn_readfirstlane(tid >> 6), r32 = lane & 31, hh = lane >> 5;
    const int cu0 = (b * 8 + h) * 128, hc = h * 64 + lane;
    LAS unsigned char* recb = lds;
    LAS float* obuf = (LAS float*)(lds + 7 * REC_BYTES);
    const RwkvPar pr = rwkv_params(a, hc);
    f32x16 Sacc[2];
#pragma unroll
    for (int kt = 0; kt < 2; ++kt)
#pragma unroll
        for (int r = 0; r < 16; ++r) Sacc[kt][r] = 0.f;
    for (int i = tid; i < 6 * REC_BYTES / 16; i += NTHR) *(LAS u32x4v*)(recb + i * 16) = *(const u32x4v*)(RREC + (size_t)cu0 * REC_BYTES + i * 16);
    LAS unsigned* gbuf = (LAS unsigned*)(lds + PRM_OFF);
    for (int i = tid; i < 3 * 4096 / 16; i += NTHR) *(LAS u32x4v*)((LAS unsigned char*)gbuf + i * 16) = *(const u32x4v*)((const unsigned char*)RGB + (size_t)cu0 * 4096 + i * 16);
    __syncthreads();
    if (wave < 2) {
        R2Frags F0, F1;
        rwkv_r2_load(F0, recb, wave, r32, hh);
#define R2_SCAN(c, FC, FN) do { \
            f32x16 O_; rwkv_r2_issue(FC, recb + ((c) % 7) * REC_BYTES, hh, Sacc, O_); \
            asm volatile("" ::: "memory");        \
            if ((c) + 1 < 128) rwkv_r2_load(FN, recb + (((c) + 1) % 7) * REC_BYTES, wave, r32, hh);         \
            rwkv_r2_store(O_, obuf + ((c) & 1) * 1024, wave, r32, hh); \
            R2_BAR(); \
        } while (0)
#pragma unroll 1
        for (int c = 0; c < 128; c += 2) { R2_SCAN(c, F0, F1); R2_SCAN(c + 1, F1, F0); }
#undef R2_SCAN
    } else if (wave < 6) {
        R2_BAR();
#pragma unroll 1
        for (int c = 1; c < 128; ++c) {
            if (DO_POST) {
                const LAS float* ob = obuf + ((c & 1) ^ 1) * 1024; const LAS unsigned* gb = gbuf + ((c - 1) % 5) * 1024;
                float o[4]; unsigned gw[4]; float part[8];
#pragma unroll
                for (int tt = 0; tt < 4; ++tt) { const int tl = (wave - 2) * 4 + tt; o[tt] = ob[tl * 64 + lane]; gw[tt] = gb[tl * 64 + lane]; part[2 * tt] = o[tt]; part[2 * tt + 1] = o[tt] * o[tt]; }
                const int red = __builtin_bit_cast(int, reduce8(part, lane));
#pragma unroll
                for (int tt = 0; tt < 4; ++tt) {
                    const int tl = (wave - 2) * 4 + tt;
                    const int i1 = 2 * tt, i2 = 2 * tt + 1;
                    const float s1 = __builtin_bit_cast(float, __builtin_amdgcn_readlane(red, ((i1 & 4) ? 32 : 0) + ((i1 & 2) ? 16 : 0) + ((i1 & 1) ? 8 : 0)));
                    const float s2 = __builtin_bit_cast(float, __builtin_amdgcn_readlane(red, ((i2 & 4) ? 32 : 0) + ((i2 & 2) ? 16 : 0) + ((i2 & 1) ? 8 : 0)));
                    const float mean = s1 * (1.0f / 64.0f), var = fmaxf(s2 * (1.0f / 64.0f) - mean * mean, 0.f);
                    const float on = (o[tt] - mean) * __builtin_amdgcn_rsqf(var + 64e-5f) * pr.lng + pr.lnb;
                    YM[(size_t)(b * 2048 + (c - 1) * 16 + tl) * D + 512 + hc] = (bf16)f2bf((on + __uint_as_float(gw[tt] & 0xffff0000u)) * __uint_as_float(gw[tt] << 16));
                }
            }
            R2_BAR();
        }
    } else {
        const int lw = wave - 6;
#pragma unroll 1
        for (int c = 0; c < 128; ++c) {
            if (c + 6 == 4 * R1_SPLIT4) {
                unsigned sp_ = 0u;
                while (__hip_atomic_load(r1flag, __ATOMIC_RELAXED, __HIP_MEMORY_SCOPE_AGENT) < (unsigned)R1_PUBLISHERS) { __builtin_amdgcn_s_sleep(2); if (++sp_ > (1u << 20)) break; }
                __builtin_amdgcn_fence(__ATOMIC_ACQUIRE, "agent");
                asm volatile("s_waitcnt vmcnt(0)" ::: "memory");
            }
            if (c + 3 < 128) {
                const unsigned char* src = (const unsigned char*)RGB + (size_t)(cu0 + c + 3) * 4096 + lw * 2048 + lane * 16;
                LAS unsigned char* dst = (LAS unsigned char*)gbuf + ((c + 3) % 5) * 4096 + lw * 2048;
#pragma unroll
                for (int q = 0; q < 2; ++q) __builtin_amdgcn_global_load_lds((const unsigned*)(src + q * 1024), (LAS unsigned*)(dst + q * 1024), 16, 0, 0);
            }
            if (c + 6 < 128) {
                const unsigned char* src = RREC + (size_t)(cu0 + c + 6) * REC_BYTES + lw * 9216 + lane * 16;
                LAS unsigned char* dst = recb + ((c + 6) % 7) * REC_BYTES + lw * 9216;
#pragma unroll
                for (int q = 0; q < 9; ++q) __builtin_amdgcn_global_load_lds((const unsigned*)(src + q * 1024), (LAS unsigned*)(dst + q * 1024), 16, 0, 0);
                asm volatile("s_waitcnt vmcnt(42)" ::: "memory");
            } else asm volatile("s_waitcnt vmcnt(0)" ::: "memory");
            R2_BAR();
        }
    }
    __syncthreads();
#pragma unroll
    for (int tt = 0; tt < 2; ++tt) { const int tl = wave * 2 + tt; if (DO_POST) rwkv_r2_post(obuf + 1024 + tl * 64, RGB + ((size_t)(cu0 + 127) * 16 + tl) * 64, pr, YM, b * 2048 + 127 * 16 + tl, hc, lane); }
    if (wave < 2) {
        float* sp = a->out + O_RWKVP + (((size_t)b * 8 + h) * 64 + 32 * wave + r32) * 64;
#pragma unroll
        for (int kt = 0; kt < 2; ++kt)
#pragma unroll
            for (int g = 0; g < 4; ++g) *(f32x4*)(sp + 32 * kt + 8 * g + 4 * hh) = (f32x4){Sacc[kt][4 * g], Sacc[kt][4 * g + 1], Sacc[kt][4 * g + 2], Sacc[kt][4 * g + 3]};
    }
    __syncthreads();
}
__device__ __forceinline__ void rwkv_r2_sample(int b, int h, ArgsP a, const unsigned char* RREC, const float* RGB, bf16* YM, LAS unsigned char* lds, int tid) {
    const int lane = tid & 63, wave = __builtin_amdgcn_readfirstlane(tid >> 6), r32 = lane & 31, hh = lane >> 5;
    const int cu = NRCP + b * 8 + h, hc = h * 64 + lane;
    LAS unsigned char* recb = lds; LAS float* obuf = (LAS float*)(lds + REC_BYTES);
    for (int i = tid; i < REC_BYTES / 16; i += NTHR) *(LAS u32x4v*)(recb + i * 16) = *(const u32x4v*)(RREC + (size_t)cu * REC_BYTES + i * 16);
    f32x16 Sacc[2];
    if (wave < 2) {
        const float* sp = a->in[I_SRWKV] + (((size_t)b * 8 + h) * 64 + 32 * wave + r32) * 64;
#pragma unroll
        for (int kt = 0; kt < 2; ++kt)
#pragma unroll
            for (int g = 0; g < 4; ++g) { const f32x4 x = *(const f32x4*)(sp + 32 * kt + 8 * g + 4 * hh); Sacc[kt][4 * g] = x.x; Sacc[kt][4 * g + 1] = x.y; Sacc[kt][4 * g + 2] = x.z; Sacc[kt][4 * g + 3] = x.w; }
    }
    __syncthreads();
    if (wave < 2) {
        rwkv_r2_step(recb, Sacc, obuf, wave, r32, hh);
        float* sp = a->out + O_RWKVS + (((size_t)b * 8 + h) * 64 + 32 * wave + r32) * 64;
#pragma unroll
        for (int kt = 0; kt < 2; ++kt)
#pragma unroll
            for (int g = 0; g < 4; ++g) *(f32x4*)(sp + 32 * kt + 8 * g + 4 * hh) = (f32x4){Sacc[kt][4 * g], Sacc[kt][4 * g + 1], Sacc[kt][4 * g + 2], Sacc[kt][4 * g + 3]};
    }
    __syncthreads();
    { const RwkvPar pr = rwkv_params(a, hc); rwkv_r2_post(obuf + wave * 64, RGB + ((size_t)cu * 16 + wave) * 64, pr, YM, MP + b * 8 + wave, hc, lane); }
    __syncthreads();
}

template <int S> __device__ __forceinline__ void tail_combine(int mode, const bf16* slab, bf16* xb, pg8::ssq_t* ssq_out, float scale, bf16* O, int ldc, const pg8::ssq_t* ssq_in,
                                             int bxl, int Gl, int tid) {
    const int lane = tid & 63, w = tid >> 6, ai = w >> 2, m = w & 3, fr = lane & 15, fq = lane >> 4;
    for (int task = bxl; task < 128; task += Gl) {
        const int tile = task >> 3, wid = task & 7, pm = tile >> 2, pn = tile & 3, wr = wid >> 2, wc = wid & 3;
        f32x4 v[2][2];
#pragma unroll
        for (int bj = 0; bj < 2; ++bj)
#pragma unroll
            for (int n = 0; n < 2; ++n) v[bj][n] = (f32x4){0.f, 0.f, 0.f, 0.f};
        u32x2v ld[S][2][2];
#pragma unroll
        for (int ks = 0; ks < S; ++ks) {
            const bf16* sp = slab + ((size_t)(tile * S + ks) * 8 + wid) * (32 * 64 * 4) + lane * 4;
#pragma unroll
            for (int bj = 0; bj < 2; ++bj)
#pragma unroll
                for (int n = 0; n < 2; ++n) ld[ks][bj][n] = *(const u32x2v*)(sp + (((ai * 2 + bj) * 4 + m) * 2 + n) * 256);
        }
#pragma unroll
        for (int ks = 0; ks < S; ++ks)
#pragma unroll
            for (int bj = 0; bj < 2; ++bj)
#pragma unroll
                for (int n = 0; n < 2; ++n) { const u32x2v q = ld[ks][bj][n];
                    v[bj][n] += (f32x4){__uint_as_float(q.x << 16), __uint_as_float(q.x & 0xffff0000u), __uint_as_float(q.y << 16), __uint_as_float(q.y & 0xffff0000u)}; }
        const int rl = pm * 256 + ai * 128 + wr * 64 + m * 16 + fr, row = MP + rl;
        const int col0 = pn * 256 + wc * 32 + 4 * fq;
        if (mode == pg8::EM_RESID) {
            float s = 0.f; u32x2v xiv[2][2];
#pragma unroll
            for (int bj = 0; bj < 2; ++bj)
#pragma unroll
                for (int n = 0; n < 2; ++n) xiv[bj][n] = *(const u32x2v*)(xb + (size_t)row * D + col0 + bj * 128 + n * 16);
#pragma unroll
            for (int bj = 0; bj < 2; ++bj)
#pragma unroll
                for (int n = 0; n < 2; ++n) {
                    const int c = col0 + bj * 128 + n * 16;
                    const u32x2v q = xiv[bj][n];
                    const f32x4 xi = {__uint_as_float(q.x << 16), __uint_as_float(q.x & 0xffff0000u), __uint_as_float(q.y << 16), __uint_as_float(q.y & 0xffff0000u)};
                    const f32x4 y = xi + v[bj][n] * scale;
                    s += (y[0] * y[0] + y[1] * y[1]) + (y[2] * y[2] + y[3] * y[3]);
                    u32x2v wv; wv.x = pg8::cvt_pk_bf16(y[0], y[1]); wv.y = pg8::cvt_pk_bf16(y[2], y[3]);
                    *(u32x2v*)(xb + (size_t)row * D + c) = wv;
                }
            s += __shfl_xor(s, 16); s += __shfl_xor(s, 32);
            if (fq == 0) __hip_atomic_fetch_add(ssq_out + row, pg8::ssq_fix(s), __ATOMIC_RELAXED, __HIP_MEMORY_SCOPE_AGENT);
        } else {
            const float rs = __builtin_amdgcn_rsqf(pg8::ssq_val(ssq_in[row]) * (1.0f / 1024.0f) + 1e-6f);
#pragma unroll
            for (int bj = 0; bj < 2; ++bj)
#pragma unroll
                for (int n = 0; n < 2; ++n) {
                    const int c = col0 + bj * 128 + n * 16; const f32x4 y = v[bj][n] * rs;
                    u32x2v wv; wv.x = pg8::cvt_pk_bf16(y[0], y[1]); wv.y = pg8::cvt_pk_bf16(y[2], y[3]);
                    *(u32x2v*)(O + (size_t)row * ldc + c) = wv;
                }
        }
    }
}

template <int NB> __device__ __forceinline__ void attn_stage_tile(const bf16* src, int src_pitch, LAS unsigned char* lds, int tid) {
#pragma unroll 1
    for (int i0 = 0; i0 < 16; i0 += NB) {
        u32x4v v[NB];
#pragma unroll
        for (int i = 0; i < NB; ++i) { const int p = tid + 512 * (i0 + i), row = p >> 5, c16 = p & 31; v[i] = *(const u32x4v*)(src + (size_t)row * src_pitch + c16 * 8); }
#pragma unroll
        for (int i = 0; i < NB; ++i) { const int p = tid + 512 * (i0 + i), row = p >> 5, c16 = p & 31; *(LAS u32x4v*)(lds + row * 528 + c16 * 16) = v[i]; }
    }
}
__device__ __forceinline__ void attn_prompt_unit(int l, int b, int h, int qt, const bf16* Q, const bf16* KBp, const bf16* VTp, bf16* O, LAS unsigned char* lds, int tid) {
    const int lane = tid & 63, w = tid >> 6, r32 = lane & 31, hh = lane >> 5;
    const int row0 = b * 2048 + qt * 256 + w * 32;
    const bf16* qp = Q + (size_t)(row0 + r32) * D + h * 256 + 8 * hh;
    bf16x8 qa = *(const bf16x8*)(qp), qb = *(const bf16x8*)(qp + 16), qc = *(const bf16x8*)(qp + 32), qd = *(const bf16x8*)(qp + 48);
    attn_stage_tile<16>(KBp + ((size_t)l * 2048 + b * 256) * D + h * 256, D, lds, tid);
    __syncthreads();
    f32x16 S[8];
#pragma unroll
    for (int mt = 0; mt < 8; ++mt)
#pragma unroll
        for (int r = 0; r < 16; ++r) S[mt][r] = 0.f;
    const LAS unsigned char* kl0 = lds + r32 * 528 + 16 * hh; const LAS unsigned char* kl1 = kl0 + 4 * 32 * 528;
#pragma unroll 1
    for (int s2 = 0; s2 < 8; ++s2) {
        const int sn = (s2 < 6) ? s2 + 2 : 7;
        const bf16x8 qna = *(const bf16x8*)(qp + 32 * sn), qnb = *(const bf16x8*)(qp + 32 * sn + 16);
#pragma unroll
        for (int mt = 0; mt < 4; ++mt) {
            const bf16x8 kf0 = *(const LAS bf16x8*)(kl0 + mt * 32 * 528 + 64 * s2), kf1 = *(const LAS bf16x8*)(kl1 + mt * 32 * 528 + 64 * s2);
            S[mt] = __builtin_amdgcn_mfma_f32_32x32x16_bf16(kf0, qa, S[mt], 0, 0, 0);
            S[mt + 4] = __builtin_amdgcn_mfma_f32_32x32x16_bf16(kf1, qa, S[mt + 4], 0, 0, 0);
        }
#pragma unroll
        for (int mt = 0; mt < 4; ++mt) {
            const bf16x8 kf0 = *(const LAS bf16x8*)(kl0 + mt * 32 * 528 + 64 * s2 + 32), kf1 = *(const LAS bf16x8*)(kl1 + mt * 32 * 528 + 64 * s2 + 32);
            S[mt] = __builtin_amdgcn_mfma_f32_32x32x16_bf16(kf0, qb, S[mt], 0, 0, 0);
            S[mt + 4] = __builtin_amdgcn_mfma_f32_32x32x16_bf16(kf1, qb, S[mt + 4], 0, 0, 0);
        }
        qa = qc; qb = qd; qc = qna; qd = qnb;
    }
    __syncthreads();
    float mx = -3.0e38f;
#pragma unroll
    for (int mt = 0; mt < 8; ++mt)
#pragma unroll
        for (int r = 0; r < 16; ++r) mx = fmaxf(mx, S[mt][r]);
    mx = fmaxf(mx, __shfl_xor(mx, 32));
    const float c2 = 0.0625f * 1.4426950408889634f;
    float lsum = 0.f;
    bf16x8 pf[8][2];
#pragma unroll
    for (int mt = 0; mt < 8; ++mt) {
#pragma unroll
        for (int r = 0; r < 16; ++r) { const float p = __builtin_amdgcn_exp2f((S[mt][r] - mx) * c2); S[mt][r] = p; lsum += p; }
#pragma unroll
        for (int sp = 0; sp < 2; ++sp) {
            u32x4v pw; pw.x = pg8::cvt_pk_bf16(S[mt][8 * sp + 0], S[mt][8 * sp + 1]); pw.y = pg8::cvt_pk_bf16(S[mt][8 * sp + 2], S[mt][8 * sp + 3]);
            pw.z = pg8::cvt_pk_bf16(S[mt][8 * sp + 4], S[mt][8 * sp + 5]); pw.w = pg8::cvt_pk_bf16(S[mt][8 * sp + 6], S[mt][8 * sp + 7]);
            pf[mt][sp] = __builtin_bit_cast(bf16x8, pw);
        }
    }
    lsum += __shfl_xor(lsum, 32);
    const float il = 1.0f / lsum;
    attn_stage_tile<8>(VTp + (((size_t)l * 8 + b) * 4 + h) * 65536, 256, lds, tid);
    __syncthreads();
    const LAS unsigned char* vl = lds + r32 * 528 + 8 * hh;
    bf16* op = O + (size_t)(row0 + r32) * D + h * 256 + 4 * hh;
#pragma unroll 1
    for (int dg = 0; dg < 2; ++dg) {
        f32x16 acc[4];
#pragma unroll
        for (int q = 0; q < 4; ++q)
#pragma unroll
            for (int r = 0; r < 16; ++r) acc[q][r] = 0.f;
        const LAS unsigned char* vb = vl + dg * 4 * 32 * 528;
#pragma unroll
        for (int mt = 0; mt < 8; ++mt) {
#pragma unroll
            for (int sp = 0; sp < 2; ++sp) {
                const int m0 = mt * 32 + 16 * sp;
#pragma unroll
                for (int q = 0; q < 4; ++q) {
                    const LAS unsigned char* vq = vb + q * 32 * 528 + m0 * 2;
                    const s16x4 lo = *(const LAS s16x4*)vq, hi = *(const LAS s16x4*)(vq + 16);
                    const bf16x8 vf = (bf16x8){lo[0], lo[1], lo[2], lo[3], hi[0], hi[1], hi[2], hi[3]};
                    acc[q] = __builtin_amdgcn_mfma_f32_32x32x16_bf16(vf, pf[mt][sp], acc[q], 0, 0, 0);
                }
            }
            asm volatile("" ::: "memory");
        }
#pragma unroll
        for (int q = 0; q < 4; ++q)
#pragma unroll
            for (int g = 0; g < 4; ++g) {
                u32x2v wv; wv.x = pg8::cvt_pk_bf16(acc[q][4 * g] * il, acc[q][4 * g + 1] * il); wv.y = pg8::cvt_pk_bf16(acc[q][4 * g + 2] * il, acc[q][4 * g + 3] * il);
                *(u32x2v*)(op + (dg * 4 + q) * 32 + 8 * g) = wv;
            }
    }
    __syncthreads();
}
__device__ __forceinline__ void attn_sample_unit(int l, int b, int h, const bf16* Q, const float* CK, const float* CV, bf16* O, LAS unsigned char* lds, int tid) {
    const int lane = tid & 63, w = tid >> 6;
    LAS float* red = (LAS float*)lds;
    LAS float* ml = red + 16384;
    float qv[8][4];
#pragma unroll
    for (int t = 0; t < 8; ++t) { const u32x2v qq = *(const u32x2v*)(Q + (size_t)(MP + b * 8 + t) * D + h * 256 + 4 * lane);
        qv[t][0] = __uint_as_float(qq.x << 16); qv[t][1] = __uint_as_float(qq.x & 0xffff0000u); qv[t][2] = __uint_as_float(qq.y << 16); qv[t][3] = __uint_as_float(qq.y & 0xffff0000u); }
    const size_t base = (((size_t)l * 128 + b) * 256 + w * 32) * D + h * 256 + 4 * lane;
    const float* kbase = CK + base; const float* vbase = CV + base;
    float sc[32];
    f32x4 vr[16];
#pragma unroll
    for (int bt = 0; bt < 4; ++bt) {
        f32x4 kr[8];
#pragma unroll
        for (int i = 0; i < 8; ++i) kr[i] = *(const f32x4*)(kbase + (size_t)(bt * 8 + i) * D);
        if (bt < 2) {
#pragma unroll
            for (int i = 0; i < 8; ++i) vr[bt * 8 + i] = *(const f32x4*)(vbase + (size_t)(bt * 8 + i) * D);
        }
#pragma unroll
        for (int i = 0; i < 8; ++i) {
            float part[8];
#pragma unroll
            for (int t = 0; t < 8; ++t) part[t] = (qv[t][0] * kr[i].x + qv[t][1] * kr[i].y) + (qv[t][2] * kr[i].z + qv[t][3] * kr[i].w);
            sc[bt * 8 + i] = reduce8(part, lane) * 0.0625f;
        }
    }
    f32x4 vr2[16];
#pragma unroll
    for (int i = 0; i < 16; ++i) vr2[i] = *(const f32x4*)(vbase + (size_t)(16 + i) * D);
    float mx = sc[0];
#pragma unroll
    for (int i = 1; i < 32; ++i) mx = fmaxf(mx, sc[i]);
    float lsum = 0.f;
#pragma unroll
    for (int i = 0; i < 32; ++i) { sc[i] = fexp(sc[i] - mx); lsum += sc[i]; }
    f32x4 acc[8];
#pragma unroll
    for (int t = 0; t < 8; ++t) acc[t] = (f32x4){0.f, 0.f, 0.f, 0.f};
#pragma unroll
    for (int i = 0; i < 32; ++i) {
        const f32x4 vrow = (i < 16) ? vr[i & 15] : vr2[i & 15];
#pragma unroll
        for (int t = 0; t < 8; ++t) {
            const int src = ((t & 4) ? 32 : 0) + ((t & 2) ? 16 : 0) + ((t & 1) ? 8 : 0);
            const float p = __builtin_bit_cast(float, __builtin_amdgcn_readlane(__builtin_bit_cast(int, sc[i]), src));
            acc[t] += vrow * p;
        }
    }
#pragma unroll
    for (int t = 0; t < 8; ++t) *(LAS f32x4*)(red + (w * 8 + t) * 256 + 4 * lane) = acc[t];
    if ((lane & 7) == 0) { const int t = ((lane >> 5) & 1) * 4 + ((lane >> 4) & 1) * 2 + ((lane >> 3) & 1); ml[w * 16 + t] = mx; ml[w * 16 + 8 + t] = lsum; }
    __syncthreads();
    {
        const int t = w; float M = -3.0e38f;
#pragma unroll
        for (int ww = 0; ww < 8; ++ww) M = fmaxf(M, ml[ww * 16 + t]);
        float L = 0.f; f32x4 s = (f32x4){0.f, 0.f, 0.f, 0.f};
#pragma unroll
        for (int ww = 0; ww < 8; ++ww) { const float f = fexp(ml[ww * 16 + t] - M); L += ml[ww * 16 + 8 + t] * f; s += *(const LAS f32x4*)(red + (ww * 8 + t) * 256 + 4 * lane) * f; }
        const float il = 1.0f / L;
        u32x2v o; o.x = pk2(s.x * il, s.y * il); o.y = pk2(s.z * il, s.w * il);
        *(u32x2v*)(O + (size_t)(MP + b * 8 + t) * D + h * 256 + 4 * lane) = o;
    }
    __syncthreads();
}


constexpr int REP_R2B = 0, REP_CONV = 1, REP_O1 = 1, REP_BAR = 0, REP_RESID_K = -1, REP_ATTS = 1, REP_R1 = 1, REP_R2 = 1, REP_O3A = 1, REP_O3B = 1, REP_O3 = 1, REP_EVEN = 1, REP_ATT = 1, REP_PRO = 1, REP_GEMM_K = -1  ;
__global__ void __launch_bounds__(NTHR, 2) hybrid_fwd(Args a_unused) {
#define KA (kargs())
    extern __shared__ __attribute__((aligned(16))) unsigned char lds_raw[];
    LAS unsigned char* lds = (LAS unsigned char*)lds_raw;
    volatile LAS unsigned* MISC = (volatile LAS unsigned*)(lds + MISC_OFF);
    LAS float* prm = (LAS float*)(lds + PRM_OFF);
    const int wave0 = __builtin_amdgcn_readfirstlane((int)threadIdx.x >> 6);
#define tid0 (wave0 * 64 + lane_id_v())
    const int G = gridDim.x, bx = blockIdx.x;
    const int vcu = (G % 8 == 0) ? (bx % 8) * (G / 8) + bx / 8 : bx;

#define WSP (KA->ws)
#define SSQ ((pg8::ssq_t*)(KA->ws + WS_CTL + CTL_SSQ_OFF))
#define SSQM ((const float*)(KA->ws + WS_CTL + CTL_SSQM_OFF))
    unsigned* ctl = (unsigned*)(KA->ws + WS_CTL);
#define B_XB ((bf16*)(KA->ws + WS_XB))
#define B_HB ((bf16*)(KA->ws + WS_HB))
#define B_PB ((bf16*)(KA->ws + WS_PB))
#define B_YM ((bf16*)(KA->ws + WS_YM))
#define B_QB ((bf16*)(KA->ws + WS_QB))
#define B_OB ((bf16*)(KA->ws + WS_OB))
#define B_DS ((bf16*)(KA->ws + WS_DS))
#define B_SB ((bf16*)(KA->ws + WS_DS + 32 * MiB))
#define B_DEC ((float*)(KA->ws + WS_DEC))
#define B_LB ((bf16*)(KA->ws + WS_LB))
#define B_AP ((bf16*)(KA->ws + WS_AP))
#define B_KB ((bf16*)(KA->ws + WS_KB))
#define B_VT ((bf16*)(KA->ws + WS_VT))

    for (int u = tid0; u < (LDS_BYTES - LDSCTL_OFF) / 4; u += NTHR) ((LAS unsigned*)(lds + LDSCTL_OFF))[u] = 0u;
    __syncthreads();
    XcdBarrier bar = xcd_barrier_post(ctl + CW_BAR, MISC + 8); bar.w0 = wave0;
#define GRID_BAR() xcd_barrier(bar)

    for (int rep = 0; rep < REP_PRO; ++rep) { p0_prologue(KA, lds, vcu, G, tid0); __syncthreads(); }
    __syncthreads();
    GRID_BAR();
    for (int r9 = 0; r9 < REP_BAR; ++r9) GRID_BAR();

#define NEW_E() pg8::EpiAny E; E.p0 = nullptr; E.p1 = nullptr; E.p2 = nullptr; E.p3 = nullptr; E.ldc = 0; E.scale = 0.f; E.mode = 0
#define RUN_GEMM(Aptr, Btptr, Mv, Nv, Kv, LDv, Sv, Gv, Cv) do { pg8::Gemm g_{(const pg8::bf16_t*)(Aptr), (const pg8::bf16_t*)(Btptr), (Mv), (Nv), (Kv), (LDv)}; pg8::StaticOrder S_; S_.init((Mv), (Nv), (Gv), (Cv), (Sv)); \
        pg8::gemm_phase<pg8::EpiAny, pg8::StaticOrder, true, true>(lds, g_, S_, E, wave0); } while (0)

#pragma unroll 1
    for (int step = 1; step < 19; ++step) {
        const int l = (step - 1) / 9, k = (step == 0) ? -1 : (step - 1) % 9;
        pg8::ssq_t* ssq_l = SSQ + (size_t)(4 * l) * MT;
        int bxl = bx, Gl = G; asm volatile("" : "+s"(bxl), "+s"(Gl));
#define tid tid0
#define gtid (bxl * NTHR + tid0)
        if (k == 3) {
            if (l == 0) {
                if (tid < 512) { const float* hl = KA->in[I_HLB]; prm[tid] = 1.0f / (1.0f + fexp(hl[512 + tid] - hl[tid])); }
                __syncthreads();
                for (int rep = 0; rep < REP_EVEN; ++rep)
                for (int cid = bxl; cid < NCHP; cid += Gl) hgrn_a64(cid, B_PB, B_DS, B_DEC, prm, lds, tid);
                for (int j = bxl; j < NCHS; j += Gl) hgrn_sample_unit(j, B_PB, KA->in[I_SHGRN], KA->out + O_HGRNS, KA->in[I_HGN], B_YM, prm, lds, tid);
                for (int r4 = 0; r4 < REP_CONV; ++r4) conv_phase(B_PB, KA->in[I_CONVW], KA->in[I_SCONV], B_YM, KA->out + O_CONVP, KA->out + O_CONVS, gtid, (Gl * NTHR));
                GRID_BAR();
                chunk_scan<true>(B_DS, B_SB, B_DEC, KA->out + O_HGRNP, gtid, (Gl * NTHR));
                GRID_BAR();
                for (int rep = 0; rep < REP_EVEN; ++rep)
                for (int cid = bxl; cid < NCHP; cid += Gl) hgrn_c64(cid, B_PB, B_SB, KA->in[I_HGN], B_YM, prm, lds, tid);
                GRID_BAR();
                continue;
            } else {
                if (tid < 64) prm[tid] = __builtin_amdgcn_exp2f(-(float)tid * (13.287712379549449f / 64.0f));
                __syncthreads();
                for (int r4 = 0; r4 < REP_O1; ++r4) {
                for (int cid = bxl; cid < NCHP; cid += Gl) ret_a64(cid, B_PB, B_DS, prm, lds, tid);
                for (int j = bxl; j < NCHS; j += Gl) ret_sample_unit(j, B_PB, KA->in[I_SRET], KA->out + O_RETS, KA->in[I_RGN], B_YM, prm, lds, tid);
                lora_prep_phase(B_PB, KA->in[I_MU], KA->in[I_SSHIFT], B_AP, KA->out + O_SHIFTP, KA->out + O_SHIFTS, gtid, (Gl * NTHR));
                }
                GRID_BAR();
                chunk_scan<false>(B_DS, B_SB, B_DEC, KA->out + O_RETP, gtid, (Gl * NTHR));
            }
        }
        if (k == 4 && l == 1) {
            for (int j = bxl; j < 64 * R1_SPLIT4 + 256; j += Gl) {
                const int cu4 = (j < 64 * R1_SPLIT4) ? (j / R1_SPLIT4) * 32 + (j % R1_SPLIT4) : 2048 + (j - 64 * R1_SPLIT4);
                rwkv_r1_unit4(cu4, KA, B_PB, B_LB, WSP + WS_RREC, (float*)(WSP + WS_RGB), lds, tid);
            }
            GRID_BAR();
            unsigned* r1flag = ctl + 256;
            if (bxl < 64) rwkv_r2_prompt(bxl >> 3, bxl & 7, KA, WSP + WS_RREC, (const float*)(WSP + WS_RGB), B_YM, lds, tid, r1flag);
            else {
                for (int j = bxl - 64; j < 64 * (32 - R1_SPLIT4); j += Gl - 64) {
                    const int cu4 = (j / (32 - R1_SPLIT4)) * 32 + R1_SPLIT4 + (j % (32 - R1_SPLIT4));
                    rwkv_r1_unit4(cu4, KA, B_PB, B_LB, WSP + WS_RREC, (float*)(WSP + WS_RGB), lds, tid);
                }
                asm volatile("s_waitcnt vmcnt(0)" ::: "memory"); __syncthreads();
                if (tid == 0) { __builtin_amdgcn_fence(__ATOMIC_RELEASE, "agent"); asm volatile("s_waitcnt vmcnt(0)" ::: "memory");
                    __hip_atomic_fetch_add(r1flag, 1u, __ATOMIC_RELAXED, __HIP_MEMORY_SCOPE_AGENT); }
                for (int u = bxl - 64; u < 1024; u += Gl - 64) rwkv_r2_sample(u >> 3, u & 7, KA, WSP + WS_RREC, (const float*)(WSP + WS_RGB), B_YM, lds, tid);
                for (int i = bxl - 64; i < NCHP; i += Gl - 64) ret_c64(i, B_PB, B_SB, KA->in[I_RGN], B_YM, prm, lds, tid);
            }
            GRID_BAR();
            if (REP_R2B) { if (bxl < 64) rwkv_r2_prompt<true>(bxl >> 3, bxl & 7, KA, WSP + WS_RREC, (const float*)(WSP + WS_RGB), B_YM, lds, tid, ctl + 256); GRID_BAR(); }
        }
        if (k == 6) {
            const int ll = l;
#pragma unroll 1
            for (int ph = 0; ph < 2; ++ph) {
                if (((ph ^ (bxl >> 3)) & 1) == 0) attn_prompt_unit(ll, bxl >> 5, (bxl >> 3) & 3, bxl & 7, B_QB, B_KB, B_VT, B_OB, lds, tid);
                else for (int i = bxl; i < 512; i += Gl) attn_sample_unit(ll, i >> 2, i & 3, B_QB, KA->in[I_CMK], KA->in[I_CMV], B_OB, lds, tid);
            }
            GRID_BAR();
        }
        NEW_E();
        const void* gA; const void* gB; int gM = MT, gN = D, gK = D;
        switch (k) {
        case -1: E.mode = pg8::EM_MEMKV; E.p1 = SSQM; E.p0 = KA->out + O_MKP; E.p3 = B_KB;
            gA = WSP + WS_MEMB; gB = WSP + WS_WKV; gM = 2048; gN = 4096; break;
        case 0: case 7: E.mode = pg8::EM_SWIGLU; E.p0 = B_HB; E.ldc = FF; E.p1 = (const float*)(ssq_l + (k == 0 ? 0 : 3) * (size_t)MT);
            gA = B_XB; gB = WSP + (k == 0 ? WS_GU1 : WS_GU2) + l * SZ_GU; gN = NGU; break;
        case 1: case 8: E.mode = pg8::EM_RESID; E.scale = 0.5f; E.p0 = B_XB; E.p3 = ssq_l + (k == 1 ? 1 : 4) * (size_t)MT;
            gA = B_HB; gB = WSP + (k == 1 ? WS_DN1 : WS_DN2) + l * SZ_DN; gK = FF; break;
        case 2: E.mode = pg8::EM_SCALE; E.p0 = B_PB; E.ldc = PLD; E.p1 = (const float*)(ssq_l + 1 * (size_t)MT);
            gA = B_XB; gB = WSP + WS_WIN + l * SZ_WIN; gN = (l == 0 ? EIN : OIN); break;
        case 3: E.mode = pg8::EM_SCALE; E.p0 = B_LB; E.ldc = 1536; E.p1 = nullptr;
            gA = B_AP; gB = WSP + WS_LORA; gN = 1536; gK = 256; break;
        case 4: E.mode = pg8::EM_RESID; E.scale = 1.0f; E.p0 = B_XB; E.p3 = ssq_l + 2 * (size_t)MT;
            gA = B_YM; gB = WSP + WS_WOUT + l * SZ_SQ; break;
        case 5: E.mode = pg8::EM_SCALE; E.p0 = B_QB; E.ldc = D; E.p1 = (const float*)(ssq_l + 2 * (size_t)MT);
            gA = B_XB; gB = WSP + WS_WQ + l * SZ_SQ; break;
        default:   E.mode = pg8::EM_RESID; E.scale = 1.0f; E.p0 = B_XB; E.p3 = ssq_l + 3 * (size_t)MT;
            gA = B_OB; gB = WSP + WS_WO + l * SZ_SQ; break;
        }
#ifndef X_NO_GEMM
        const bool tail = (k == 1 || k == 8);
        const bool ride = (l == 0 && k == 4 && G == 256);
#pragma unroll 1
        for (int pass = 0; pass < ((tail || ride) ? 2 : 1); ++pass) {
            int gG = G, gC = bx, gS = 1, gLD = gK;
            if (tail && pass == 0) gM = MP;
            if (tail && pass == 1) {
                gS = 11; pg8::EpiAny E2 = E; E2.mode = pg8::EM_PARTIAL; E2.p0 = WSP + WS_SLAB; E2.ldc = gS; E = E2;
                gA = (const bf16*)gA + (size_t)MP * gK; gM = MS; gLD = gK; gK = gK / gS;
            }
            if (ride && pass == 1) {
                pg8::EpiAny E2 = E; E2.mode = pg8::EM_MEMKV; E2.p1 = SSQM; E2.p0 = KA->out + O_MKP; E2.p3 = B_KB; E = E2;
                gA = WSP + WS_MEMB; gB = WSP + WS_WKV; gM = 2048; gN = 4096; gK = D; gLD = D; gG = 128; gC = (bx >= 16 && bx < 144) ? bx - 16 : 128;
            }
            RUN_GEMM(gA, gB, gM, gN, gK, gLD, gS, gG, gC);
        }
        if (REP_GEMM_K >= 0 && k == REP_GEMM_K) { RUN_GEMM(gA, gB, gM, gN, gK, gK, 1, G, bx); }
        if (l == 0 && G == 256) {
            unsigned wm = 0u; int wb0 = 256;
            if (k == 0) { wm = WMASK_T0; wb0 = 216; } else if (k == 2) { wm = WMASK_T2; wb0 = 184; } else if (k == 4) { wm = WMASK_T4; wb0 = 144; }
            else if (k == 5) { wm = WMASK_T5; wb0 = 16; } else if (k == 6) { wm = WMASK_T6; wb0 = 16; }
            if (wm != 0u && bx >= wb0) convert_weights(KA, lds, wm, (bx - wb0) * NWAVES + (tid >> 6), (256 - wb0) * NWAVES, tid);
        }
        if (tail) {
            GRID_BAR();
            pg8::ssq_t* so = SSQ + (size_t)(4 * l) * MT + (size_t)(k == 1 ? 1 : 4) * MT;
            tail_combine<11>(pg8::EM_RESID, (const bf16*)(WSP + WS_SLAB), B_XB, so, 0.5f, nullptr, 0, nullptr, bxl, Gl, tid);
        }
#endif
        if (step == 0) continue;
        GRID_BAR();
    }
#undef tid
#undef gtid
    {
        const pg8::ssq_t* fs = SSQ + (size_t)8 * MT; const float* fg = KA->in[I_FN];
        const int tidf = tid0; const int lane = tidf & 63, wave = tidf >> 6;
        const int gw = vcu * NWAVES + wave, NGW = G * NWAVES;
        for (int m0 = gw; m0 < MT; m0 += 2 * NGW) {
            u32x2v xv[2][4]; float rs[2]; bool ok[2];
#pragma unroll
            for (int q = 0; q < 2; ++q) { const int m = m0 + q * NGW; ok[q] = m < MT; const int mm = ok[q] ? m : m0; rs[q] = pg8::ssq_val(fs[mm]);
                const u32x2v* xr = (const u32x2v*)(B_XB + (size_t)mm * D) + lane;
#pragma unroll
                for (int j = 0; j < 4; ++j) xv[q][j] = xr[64 * j]; }
            f32x4 gv[4]; const f32x4* gg = (const f32x4*)fg + lane;
#pragma unroll
            for (int j = 0; j < 4; ++j) gv[j] = gg[64 * j];
#pragma unroll
            for (int q = 0; q < 2; ++q) if (ok[q]) { const int m = m0 + q * NGW; const float r = __builtin_amdgcn_rsqf(rs[q] * (1.0f / 1024.0f) + 1e-6f);
                f32x4* yo = (f32x4*)(KA->out + O_Y + (size_t)m * D) + lane;
#pragma unroll
                for (int j = 0; j < 4; ++j) { const u32x2v qq = xv[q][j];
                    const f32x4 xi = {__uint_as_float(qq.x << 16), __uint_as_float(qq.x & 0xffff0000u), __uint_as_float(qq.y << 16), __uint_as_float(qq.y & 0xffff0000u)};
                    yo[64 * j] = xi * r * gv[j]; } }
        }
    }
}

extern "C" void kernel_launch(void* const* d_in, const int* in_sizes, int n_in, void* d_out, int out_size, void* d_ws, size_t ws_size, hipStream_t stream) {
    static int grid = 0;
    if (grid == 0) {
        if (n_in != N_IN || (size_t)out_size != O_END || ws_size < WS_END) { fprintf(stderr, "kernel_launch: unexpected shapes: n_in %d out %d ws %zu (need %zu)\n", n_in, out_size, ws_size, (size_t)WS_END); grid = -1; return; }
        int dev = 0, cus = 0, per_cu = 0;
        if (hipGetDevice(&dev) != hipSuccess || hipDeviceGetAttribute(&cus, hipDeviceAttributeMultiprocessorCount, dev) != hipSuccess) { grid = -1; return; }
        if (hipFuncSetAttribute((const void*)hybrid_fwd, hipFuncAttributeMaxDynamicSharedMemorySize, LDS_BYTES) != hipSuccess) { fprintf(stderr, "kernel_launch: hipFuncSetAttribute failed\n"); grid = -1; return; }
        if (hipOccupancyMaxActiveBlocksPerMultiprocessor(&per_cu, (const void*)hybrid_fwd, NTHR, LDS_BYTES) != hipSuccess || per_cu < 1) { fprintf(stderr, "kernel_launch: occupancy query says %d\n", per_cu); }
        (void)hipGetLastError();
        if (per_cu < 1 || cus != 256) { fprintf(stderr, "kernel_launch: %d CUs, %d workgroups per CU by the occupancy query; this kernel is built for 256 CUs x 1 resident workgroup: nothing launched\n", cus, per_cu); grid = -1; return; }
        grid = cus;
    }
    if (grid < 0) return;
    (void)hipMemsetAsync((char*)d_ws + WS_CTL, 0, CTL_ZERO_BYTES, stream);
    Args a{};
    for (int i = 0; i < N_IN; ++i) a.in[i] = (const float*)d_in[i];
    a.out = (float*)d_out; a.ws = (unsigned char*)d_ws;
    void* args[] = {&a};
    hipError_t e = hipLaunchCooperativeKernel((const void*)hybrid_fwd, dim3(grid), dim3(NTHR), args, LDS_BYTES, stream);
    if (e != hipSuccess) fprintf(stderr, "kernel_launch: cooperative launch failed: %s (grid %d)\n", hipGetErrorString(e), grid);
}
```

```cpp
#include <hip/hip_runtime.h>
#include <hip/hip_cooperative_groups.h>
#include <cstdio>
#include <cstdint>
namespace pg8 {
#define PG8_LAS __attribute__((address_space(3)))
typedef unsigned short bf16_t;
typedef short bf16x8 __attribute__((ext_vector_type(8)));
typedef float f32x4 __attribute__((ext_vector_type(4)));
typedef unsigned u32x4 __attribute__((ext_vector_type(4)));
constexpr int BM = 256, BK = 64, HALF = 128, HTB = HALF * BK * 2  , STAGE_BYTES = 8 * HTB, NXCD = 8, WGM = 8;

__host__ __device__ __forceinline__ int lds_byte(int r, int c) { const int st = (r >> 4) * 2 + (c >> 5), rr = r & 15, cc = c & 31, ob = rr * 64 + cc * 2; return st * 1024 + (ob ^ (((ob >> 9) & 1) << 5)); }
__host__ __device__ __forceinline__ void stage_rc(int b, int& R, int& C) { const int st = b / 1024, sb = b % 1024, swz = sb ^ (((sb >> 9) & 1) << 5); R = (st >> 1) * 16 + swz / 64; C = (st & 1) * 32 + (swz % 64) / 2; }
__host__ __device__ __forceinline__ int perm32(int rho) { const int n = rho >> 4, i = rho & 15; return 8 * (i >> 2) + 4 * n + (i & 3); }

struct Unit { int pm, pn, ks; };
struct Gemm { const bf16_t* A; const bf16_t* Bt; int M, N, K, ld; };

struct StaticOrder {
    int nM, nN, nwg, G, c, S;
    __host__ __device__ void init(int M, int N, int G_, int c_, int S_ = 1) { nM = M / BM; nN = N / BM; nwg = nM * nN; G = G_; c = c_; S = S_; }
    __host__ __device__ bool next(int i, Unit& u) const {
        const long L = (long)i * G + c;
        if (S > 1) { if (L >= (long)nwg * S) return false; const int r = (int)(L % nwg); u.ks = (int)(L / nwg); u.pm = r / nN; u.pn = r % nN; return true; }
        u.ks = 0;
        if (L >= nwg) return false;
        int wgid = (int)L; { const int q = nwg / NXCD, r = nwg % NXCD, xcd = wgid % NXCD, off = wgid / NXCD; wgid = (xcd < r ? xcd * (q + 1) : r * (q + 1) + (xcd - r) * q) + off; }
        const int nig = WGM * nN, gid = wgid / nig, fm = gid * WGM, gsz = (nM - fm) < WGM ? (nM - fm) : WGM;
        u.pm = fm + ((wgid % nig) % gsz); u.pn = (wgid % nig) / gsz; return true;
    }
    __device__ __forceinline__ void a_ready(const Unit&) const {}
    __device__ __forceinline__ void done(const Unit&) const {}
};

__device__ __forceinline__ unsigned cvt_pk_bf16(float lo, float hi) { unsigned r; asm volatile("v_cvt_pk_bf16_f32 %0, %1, %2" : "=v"(r) : "v"(lo), "v"(hi)); return r; }
typedef unsigned u32x2 __attribute__((ext_vector_type(2)));
__device__ __forceinline__ float fsigmoid(float x) { return __builtin_amdgcn_rcpf(1.f + __builtin_amdgcn_exp2f(-1.4426950408889634f * x)); }
__device__ __forceinline__ float fsilu(float x) { return x * fsigmoid(x); }
typedef unsigned long long ssq_t;
__device__ __forceinline__ ssq_t ssq_fix(float s) { return (ssq_t)(s * 16777216.0f); }
__device__ __forceinline__ float ssq_val(ssq_t v) { return (float)(unsigned)(v >> 32) * 256.0f + (float)(unsigned)v * (1.0f / 16777216.0f); }
enum EpiMode { EM_SWIGLU = 0, EM_SCALE = 1, EM_RESID = 2, EM_MEMKV = 3, EM_PARTIAL = 4 };
struct EpiAny {
    static constexpr bool AFTER_DRAIN = false;
    static constexpr int RED_OFF = 139264 + 1024 + 8192;
    int mode;
    __device__ __forceinline__ bool perm() const { return mode <= EM_SCALE; }
    void* p0; const float* p1; const float* p2; void* p3; int ldc; float scale;
    __device__ __forceinline__ void operator()(const f32x4 (&acc)[2][2][4][2], const Unit& u, int wr, int wc, int fr_, int fq_) const {
        int fr = fr_, fq = fq_; asm volatile("" : "+v"(fr), "+v"(fq));
        bf16_t* const O = (bf16_t*)p0; const ssq_t* const ssq = (const ssq_t*)p1;
        bf16_t* const xb = (bf16_t*)p0; ssq_t* const ssq_out = (ssq_t*)p3;
        float* const outk = (float*)p0; float* const outv = outk + 4194304; bf16_t* const kb = (bf16_t*)p3; bf16_t* const vt = kb + 4194304;
        const int rl0 = wr * 64 + fr;
        if (mode == EM_SWIGLU) {
            typedef float f32x2e __attribute__((ext_vector_type(2)));
            const int col0 = u.pn * HALF + wc * 32 + 8 * fq;
            float rsv[8];
#pragma unroll
            for (int q = 0; q < 8; ++q) rsv[q] = ssq_val(ssq[u.pm * BM + rl0 + (q >> 2) * HALF + (q & 3) * 16]);
#pragma unroll
            for (int ai = 0; ai < 2; ++ai)
#pragma unroll
                for (int m = 0; m < 4; ++m) {
                    const int row = u.pm * BM + rl0 + ai * HALF + m * 16;
                    const float rs = __builtin_amdgcn_rsqf(rsv[ai * 4 + m] * (1.0f / 1024.0f) + 1e-6f);
                    const float c1 = -1.4426950408889634f * rs, c2 = rs * rs;
                    unsigned wq[4];
#pragma unroll
                    for (int n = 0; n < 2; ++n)
#pragma unroll
                        for (int hp = 0; hp < 2; ++hp) {
                            const f32x2e g = {acc[ai][0][m][n][2 * hp], acc[ai][0][m][n][2 * hp + 1]}, uu = {acc[ai][1][m][n][2 * hp], acc[ai][1][m][n][2 * hp + 1]};
                            const f32x2e t = g * c1; f32x2e ex; ex.x = __builtin_amdgcn_exp2f(t.x); ex.y = __builtin_amdgcn_exp2f(t.y);
                            const f32x2e d = ex + 1.0f; f32x2e r; r.x = __builtin_amdgcn_rcpf(d.x); r.y = __builtin_amdgcn_rcpf(d.y);
                            const f32x2e y = (g * uu) * (r * c2);
                            wq[2 * n + hp] = cvt_pk_bf16(y.x, y.y);
                        }
                    u32x4 w; w.x = wq[0]; w.y = wq[1]; w.z = wq[2]; w.w = wq[3];
                    *(u32x4*)(O + (size_t)row * ldc + col0) = w;
                }
        } else if (mode == EM_SCALE) {
            const int col0 = u.pn * BM + wc * 32 + 8 * fq;
            float rsv[8];
#pragma unroll
            for (int q = 0; q < 8; ++q) rsv[q] = ssq ? ssq_val(ssq[u.pm * BM + rl0 + (q >> 2) * HALF + (q & 3) * 16]) : 0.f;
#pragma unroll
            for (int ai = 0; ai < 2; ++ai)
#pragma unroll
                for (int m = 0; m < 4; ++m) {
                    const int row = u.pm * BM + rl0 + ai * HALF + m * 16;
                    const float rs = ssq ? __builtin_amdgcn_rsqf(rsv[ai * 4 + m] * (1.0f / 1024.0f) + 1e-6f) : 1.0f;
#pragma unroll
                    for (int bj = 0; bj < 2; ++bj) {
                        const f32x4 v0 = acc[ai][bj][m][0] * rs, v1 = acc[ai][bj][m][1] * rs;
                        u32x4 w; w.x = cvt_pk_bf16(v0[0], v0[1]); w.y = cvt_pk_bf16(v0[2], v0[3]); w.z = cvt_pk_bf16(v1[0], v1[1]); w.w = cvt_pk_bf16(v1[2], v1[3]);
                        *(u32x4*)(O + (size_t)row * ldc + col0 + bj * HALF) = w;
                    }
                }
        } else if (mode == EM_RESID) {
            const int col0 = u.pn * BM + wc * 32 + 4 * fq;
            bf16_t* const xrow = xb + (size_t)(u.pm * BM) * 1024;
#pragma unroll
            for (int ai = 0; ai < 2; ++ai) {
                u32x2 xr[4][2][2];
#pragma unroll
                for (int m = 0; m < 4; ++m)
#pragma unroll
                    for (int bj = 0; bj < 2; ++bj)
#pragma unroll
                        for (int n = 0; n < 2; ++n) xr[m][bj][n] = *(const u32x2*)(xrow + (size_t)(rl0 + ai * HALF + m * 16) * 1024 + col0 + bj * HALF + n * 16);
#pragma unroll
                for (int m = 0; m < 4; ++m) {
                    const int rl = rl0 + ai * HALF + m * 16; const int row = u.pm * BM + rl;
                    float s = 0.f;
#pragma unroll
                    for (int bj = 0; bj < 2; ++bj)
#pragma unroll
                        for (int n = 0; n < 2; ++n) {
                            const int c = col0 + bj * HALF + n * 16;
                            const u32x2 q = xr[m][bj][n];
                            const f32x4 xi = {__uint_as_float(q.x << 16), __uint_as_float(q.x & 0xffff0000u), __uint_as_float(q.y << 16), __uint_as_float(q.y & 0xffff0000u)};
                            const f32x4 v = xi + acc[ai][bj][m][n] * scale;
                            s += (v[0] * v[0] + v[1] * v[1]) + (v[2] * v[2] + v[3] * v[3]);
                            u32x2 w; w.x = cvt_pk_bf16(v[0], v[1]); w.y = cvt_pk_bf16(v[2], v[3]);
                            *(u32x2*)(xrow + (size_t)rl * 1024 + c) = w;
                        }
                    s += __shfl_xor(s, 16); s += __shfl_xor(s, 32);
                    if (fq == 0) __hip_atomic_fetch_add(ssq_out + row, ssq_fix(s), __ATOMIC_RELAXED, __HIP_MEMORY_SCOPE_AGENT);
                }
            }
        } else if (mode == EM_PARTIAL) {
            bf16_t* slab = (bf16_t*)p0 + ((size_t)((u.pm * 4 + u.pn) * ldc + u.ks) * 8 + (wr * 4 + wc)) * (32 * 64 * 4) + (fq * 16 + fr) * 4;
            float one = 1.0f; asm volatile("" : "+v"(one));
#pragma unroll
            for (int ai = 0; ai < 2; ++ai)
#pragma unroll
                for (int bj = 0; bj < 2; ++bj)
#pragma unroll
                    for (int m = 0; m < 4; ++m)
#pragma unroll
                        for (int n = 0; n < 2; ++n) { const f32x4 v = acc[ai][bj][m][n] * one; u32x2 w; w.x = cvt_pk_bf16(v[0], v[1]); w.y = cvt_pk_bf16(v[2], v[3]);
                            *(u32x2*)(slab + (((ai * 2 + bj) * 4 + m) * 2 + n) * 256) = w; }
        } else {
            const int col0 = u.pn * BM + wc * 32 + 4 * fq;
            float rsv[8];
#pragma unroll
            for (int q = 0; q < 8; ++q) rsv[q] = ssq_val(ssq[u.pm * BM + rl0 + (q >> 2) * HALF + (q & 3) * 16]);
            const bool isv = ((u.pn * BM) & 2047) >= 1024;
            PG8_LAS bf16_t* const patch = (PG8_LAS bf16_t*)(size_t)(RED_OFF + (wr * 4 + wc) * 640);
#pragma unroll
            for (int ai = 0; ai < 2; ++ai)
#pragma unroll
                for (int m = 0; m < 4; ++m) {
                    const int row = u.pm * BM + rl0 + ai * HALF + m * 16;
                    const float rs = __builtin_amdgcn_rsqf(rsv[ai * 4 + m] * (1.0f / 1024.0f) + 1e-6f);
#pragma unroll
                    for (int bj = 0; bj < 2; ++bj)
#pragma unroll
                        for (int n = 0; n < 2; ++n) {
                            const int cg = col0 + bj * HALF + n * 16; const int l = cg >> 11, c = cg & 1023;
                            const f32x4 v = acc[ai][bj][m][n] * rs;
                            float* dst = (isv ? outv : outk) + ((size_t)l * 2048 + row) * 1024 + c;
                            *(f32x4*)dst = v;
                            const unsigned q0 = cvt_pk_bf16(v[0], v[1]), q1 = cvt_pk_bf16(v[2], v[3]);
                            if (!isv) { u32x2 w; w.x = q0; w.y = q1; *(u32x2*)(kb + ((size_t)l * 2048 + row) * 1024 + c) = w; }
                            else {
                                PG8_LAS bf16_t* pw = patch + (4 * fq) * 20 + fr;
                                pw[0] = (bf16_t)(q0 & 0xffffu); pw[20] = (bf16_t)(q0 >> 16); pw[40] = (bf16_t)(q1 & 0xffffu); pw[60] = (bf16_t)(q1 >> 16);
                                asm volatile("s_waitcnt lgkmcnt(0)" ::: "memory");
                                const u32x2 tv = *(const PG8_LAS u32x2*)(patch + fr * 20 + 4 * fq);
                                asm volatile("s_waitcnt lgkmcnt(0)" ::: "memory");
                                const int R0 = u.pm * BM + wr * 64 + ai * HALF + m * 16, C0 = (u.pn * BM + wc * 32 + bj * HALF + n * 16) & 1023;
                                const int rr = R0 + 4 * fq, b = rr >> 8, mm = rr & 255, cc = C0 + fr, h = cc >> 8, d = cc & 255;
                                *(u32x2*)(vt + ((((size_t)l * 8 + b) * 4 + h) * 256 + d) * 256 + mm) = tv;
                            }
                        }
                }
        }
    }
    template <class... T> __device__ __forceinline__ void fused(T&&...) const {}
};

template <class Epi, class Sched, bool ALIGN_EPI = false, bool SP2 = false>
__device__ __forceinline__ void gemm_phase(PG8_LAS unsigned char* lds, const Gemm g, const Sched& S, const Epi& E, int wave0) {
    int tid_l = wave0 * 64 + (int)__builtin_amdgcn_mbcnt_hi(~0u, __builtin_amdgcn_mbcnt_lo(~0u, 0u)); asm volatile("" : "+v"(tid_l));
    const int tid = tid_l, wid = __builtin_amdgcn_readfirstlane(tid >> 6), lane = tid & 63, wr = wid >> 2, wc = wid & 3, fr = lane & 15, fq = lane >> 4;
    const int K = g.K, LD = g.ld, nt = K / BK;
    unsigned voffA[2], voffB[2];
#pragma unroll
    for (int i = 0; i < 2; ++i) { int R, C; stage_rc(tid * 16 + i * 8192, R, C); const int Rb = E.perm() ? ((R & ~31) + perm32(R & 31)) : R;
        voffA[i] = (unsigned)(R * LD + C) * 2u; voffB[i] = (unsigned)(Rb * LD + C) * 2u; }
    const size_t kstep = (size_t)(BK * 2);
    const size_t hstep = (size_t)HALF * LD * 2;
    const size_t tstep = 2 * hstep;
    const unsigned ldsw = (unsigned)wid * 1024u;
    const int aoff = lds_byte(wr * 64 + fr, fq * 8), boff = lds_byte(wc * 32 + fr, fq * 8);
#define PG8_SA(b, h) (((b) * 2 + (h)) * HTB)
#define PG8_SB(b, h) ((4 + (b) * 2 + (h)) * HTB)
#define PG8_STAGE(bufoff, gbase, voff) do { _Pragma("unroll") for (int _i = 0; _i < 2; ++_i) \
        __builtin_amdgcn_global_load_lds((const unsigned*)((const char*)(gbase) + (voff)[_i]), (PG8_LAS unsigned*)(lds + (bufoff) + ldsw + _i * 8192), 16, 0, 0); } while (0)
#define PG8_LDA(dst, b, h) do { _Pragma("unroll") for (int m = 0; m < 4; ++m) _Pragma("unroll") for (int k = 0; k < 2; ++k) dst[m][k] = *(const PG8_LAS bf16x8*)(lds + PG8_SA(b, h) + aoff + m * 2048 + k * 1024); } while (0)
#define PG8_LDB(dst, b, h) do { _Pragma("unroll") for (int n = 0; n < 2; ++n) _Pragma("unroll") for (int k = 0; k < 2; ++k) dst[n][k] = *(const PG8_LAS bf16x8*)(lds + PG8_SB(b, h) + boff + n * 2048 + k * 1024); } while (0)
#define PG8_MMA(ai, bj, At, Bt) do { __builtin_amdgcn_s_setprio(1); _Pragma("unroll") for (int m = 0; m < 4; ++m) _Pragma("unroll") for (int n = 0; n < 2; ++n) _Pragma("unroll") for (int k = 0; k < 2; ++k) \
        acc[ai][bj][m][n] = __builtin_amdgcn_mfma_f32_16x16x32_bf16(Bt[n][k], At[m][k], acc[ai][bj][m][n], 0, 0, 0); __builtin_amdgcn_s_setprio(0); } while (0)
#define PG8_WAIT_V(n) asm volatile("s_waitcnt vmcnt(" #n ")" ::: "memory")
#define PG8_WAIT_L(n) asm volatile("s_waitcnt lgkmcnt(" #n ")" ::: "memory")
#define PG8_BAR __builtin_amdgcn_s_barrier()
#define PG8_SCHED __builtin_amdgcn_sched_barrier(0)
    Unit cur, nxt; int ui = 0;
    if (!S.next(0, cur)) return;
    f32x4 acc[2][2][4][2];
#pragma unroll
    for (int a = 0; a < 2; ++a)
#pragma unroll
        for (int b = 0; b < 2; ++b)
#pragma unroll
            for (int m = 0; m < 4; ++m)
#pragma unroll
                for (int n = 0; n < 2; ++n) acc[a][b][m][n] = (f32x4){0.f, 0.f, 0.f, 0.f};
    bf16x8 At[4][2], B0[2][2], B1[2][2];
    const char* cA = (const char*)g.A + (size_t)cur.pm * tstep + (size_t)cur.ks * K * 2; const char* cB = (const char*)g.Bt + (size_t)cur.pn * tstep + (size_t)cur.ks * K * 2;
    S.a_ready(cur);
    if constexpr (SP2) {
        PG8_STAGE(PG8_SB(0, 0), cB, voffB); PG8_STAGE(PG8_SB(0, 1), cB + hstep, voffB); PG8_STAGE(PG8_SA(0, 0), cA, voffA); PG8_STAGE(PG8_SA(0, 1), cA + hstep, voffA);
        if (wr == 1) PG8_BAR;
        PG8_WAIT_V(2); PG8_BAR;
        PG8_STAGE(PG8_SB(1, 0), cB + kstep, voffB); PG8_STAGE(PG8_SA(1, 0), cA + kstep, voffA); PG8_STAGE(PG8_SB(1, 1), cB + hstep + kstep, voffB);
        PG8_WAIT_V(6); PG8_BAR;
    } else {
        PG8_STAGE(PG8_SB(0, 0), cB, voffB); PG8_STAGE(PG8_SA(0, 0), cA, voffA); PG8_STAGE(PG8_SB(0, 1), cB + hstep, voffB); PG8_STAGE(PG8_SA(0, 1), cA + hstep, voffA);
        if (wr == 1) PG8_BAR;
        PG8_WAIT_V(4); PG8_BAR;
        PG8_STAGE(PG8_SB(1, 0), cB + kstep, voffB); PG8_STAGE(PG8_SA(1, 0), cA + kstep, voffA); PG8_STAGE(PG8_SB(1, 1), cB + hstep + kstep, voffB);
        PG8_WAIT_V(6); PG8_BAR;
    }
    for (;;) {
        const bool has_next = S.next(ui + 1, nxt);
        const char* nA = has_next ? (const char*)g.A + (size_t)nxt.pm * tstep + (size_t)nxt.ks * K * 2 : cA; const char* nB = has_next ? (const char*)g.Bt + (size_t)nxt.pn * tstep + (size_t)nxt.ks * K * 2 : cB;
        for (int t = 0; t < nt; t += 2) {
            const bool last = (t == nt - 2);
            const char* a1 = cA + (size_t)(t + 1) * kstep;
            const char* a2 = last ? nA : cA + (size_t)(t + 2) * kstep; const char* b2 = last ? nB : cB + (size_t)(t + 2) * kstep;
            const char* a3 = a2 + kstep; const char* b3 = b2 + kstep;
            if (last && has_next) S.a_ready(nxt);
            if constexpr (SP2) {
            PG8_LDB(B0, 0, 0); PG8_LDB(B1, 0, 1); PG8_SCHED; PG8_LDA(At, 0, 0); PG8_STAGE(PG8_SA(1, 1), a1 + hstep, voffA);
            PG8_WAIT_V(8); PG8_WAIT_L(0); PG8_BAR; PG8_MMA(0, 0, At, B0); PG8_MMA(0, 1, At, B1); PG8_BAR; PG8_SCHED;
            PG8_LDA(At, 0, 1); PG8_STAGE(PG8_SB(0, 0), b2, voffB); PG8_STAGE(PG8_SB(0, 1), b2 + hstep, voffB); PG8_STAGE(PG8_SA(0, 0), a2, voffA);
            PG8_WAIT_V(8); PG8_WAIT_L(0); PG8_BAR; PG8_MMA(1, 0, At, B0); PG8_MMA(1, 1, At, B1); PG8_BAR; PG8_SCHED;
            PG8_LDB(B0, 1, 0); PG8_LDB(B1, 1, 1); PG8_SCHED; PG8_LDA(At, 1, 0); PG8_STAGE(PG8_SA(0, 1), a2 + hstep, voffA);
            PG8_WAIT_V(8); PG8_WAIT_L(0); PG8_BAR; PG8_MMA(0, 0, At, B0); PG8_MMA(0, 1, At, B1); PG8_BAR; PG8_SCHED;
            PG8_LDA(At, 1, 1); PG8_STAGE(PG8_SB(1, 0), b3, voffB); PG8_STAGE(PG8_SB(1, 1), b3 + hstep, voffB); PG8_STAGE(PG8_SA(1, 0), a3, voffA);
            PG8_WAIT_V(8); PG8_WAIT_L(0); PG8_BAR; PG8_MMA(1, 0, At, B0); PG8_MMA(1, 1, At, B1); PG8_BAR; PG8_SCHED;
            } else {
            PG8_LDB(B0, 0, 0); PG8_SCHED; PG8_LDA(At, 0, 0); PG8_STAGE(PG8_SA(1, 1), a1 + hstep, voffA);
            PG8_WAIT_L(8); PG8_BAR; PG8_WAIT_L(0); PG8_MMA(0, 0, At, B0); PG8_BAR; PG8_SCHED;
            PG8_LDB(B1, 0, 1); PG8_STAGE(PG8_SB(0, 0), b2, voffB);
            PG8_BAR; PG8_WAIT_L(0); PG8_MMA(0, 1, At, B1); PG8_BAR;
            PG8_LDA(At, 0, 1); PG8_STAGE(PG8_SA(0, 0), a2, voffA);
            PG8_BAR; PG8_WAIT_L(0); PG8_MMA(1, 0, At, B0); PG8_BAR; PG8_SCHED;
            PG8_STAGE(PG8_SB(0, 1), b2 + hstep, voffB);
            PG8_WAIT_V(6); PG8_BAR; PG8_MMA(1, 1, At, B1); PG8_BAR;
            PG8_LDB(B0, 1, 0); PG8_SCHED; PG8_LDA(At, 1, 0); PG8_STAGE(PG8_SA(0, 1), a2 + hstep, voffA);
            PG8_WAIT_L(8); PG8_BAR; PG8_WAIT_L(0); PG8_MMA(0, 0, At, B0); PG8_BAR; PG8_SCHED;
            PG8_LDB(B1, 1, 1); PG8_STAGE(PG8_SB(1, 0), b3, voffB);
            PG8_BAR; PG8_WAIT_L(0); PG8_MMA(0, 1, At, B1); PG8_BAR;
            PG8_LDA(At, 1, 1); PG8_STAGE(PG8_SA(1, 0), a3, voffA);
            PG8_BAR; PG8_WAIT_L(0); PG8_MMA(1, 0, At, B0); PG8_BAR; PG8_SCHED;
            PG8_STAGE(PG8_SB(1, 1), b3 + hstep, voffB);
            PG8_WAIT_V(6); PG8_BAR; PG8_MMA(1, 1, At, B1); PG8_BAR;
            }
        }
        if constexpr (ALIGN_EPI) { if (wr == 0) PG8_BAR; }
        if constexpr (!Epi::AFTER_DRAIN) { E(acc, cur, wr, wc, fr, fq); S.done(cur); }
        if (!has_next) break;
#pragma unroll
        for (int a = 0; a < 2; ++a)
#pragma unroll
            for (int b = 0; b < 2; ++b)
#pragma unroll
                for (int m = 0; m < 4; ++m)
#pragma unroll
                    for (int n = 0; n < 2; ++n) acc[a][b][m][n] = (f32x4){0.f, 0.f, 0.f, 0.f};
        cur = nxt; cA = nA; cB = nB; ++ui;
        if constexpr (ALIGN_EPI) { if (wr == 1) PG8_BAR; }
    }
    PG8_WAIT_V(0);
    if constexpr (!ALIGN_EPI) { if (wr == 0) PG8_BAR; }
    PG8_BAR;
    if constexpr (Epi::AFTER_DRAIN) { E.fused(acc, cur, wr, wc, fr, fq, lds, wid, lane); S.done(cur); }
#undef PG8_SA
#undef PG8_SB
#undef PG8_STAGE
#undef PG8_LDA
#undef PG8_LDB
#undef PG8_MMA
#undef PG8_WAIT_V
#undef PG8_WAIT_L
#undef PG8_BAR
#undef PG8_SCHED
}
}

namespace cg = cooperative_groups;
#define LAS __attribute__((address_space(3)))
typedef unsigned short bf16;
typedef float f32x4 __attribute__((ext_vector_type(4)));
typedef unsigned u32x4v __attribute__((ext_vector_type(4)));
typedef unsigned u32x2v __attribute__((ext_vector_type(2)));
typedef short bf16x8 __attribute__((ext_vector_type(8)));
typedef short s16x4 __attribute__((ext_vector_type(4)));
typedef float f32x16 __attribute__((ext_vector_type(16)));

constexpr int D = 1024, MP = 16384, MS = 1024, MT = 17408, FF = 2816, NGU = 5632, EIN = 3584, OIN = 3840, PLD = 3840;
constexpr int NCHP = 1024, NCHS = 512, NCH = 1536;
constexpr int NWAVES = 8, NTHR = 512;
enum { I_XP = 0, I_XS, I_SCONV, I_SHGRN, I_SRET, I_SRWKV, I_SSHIFT, I_CMK, I_CMV, I_MEM, I_F1N, I_F1GU, I_F1DN, I_MIXN, I_EWIN, I_EWOUT, I_CONVW, I_HLB, I_HGN,
       I_OWIN, I_OWOUT, I_RGN, I_MU, I_W0, I_W2, I_A0, I_A2, I_G2, I_KK, I_KA, I_RK, I_LNG, I_LNB, I_XN, I_MEMN, I_WQ, I_WKV, I_WO, I_F2N, I_F2GU, I_F2DN, I_FN, N_IN };
constexpr size_t O_Y = 0, O_CONVP = O_Y + (size_t)MT * D, O_HGRNP = O_CONVP + 8192, O_RETP = O_HGRNP + 524288, O_RWKVP = O_RETP + 524288, O_SHIFTP = O_RWKVP + 262144,
                 O_MKP = O_SHIFTP + 14336, O_MVP = O_MKP + 4194304, O_CONVS = O_MVP + 4194304, O_HGRNS = O_CONVS + 131072, O_RETS = O_HGRNS + 8388608, O_RWKVS = O_RETS + 8388608,
                 O_SHIFTS = O_RWKVS + 4194304, O_END = O_SHIFTS + 229376;
static_assert(O_END == 48879616, "output size");

constexpr size_t MiB = 1u << 20;
constexpr size_t al(size_t x) { return (x + MiB - 1) / MiB * MiB; }
constexpr size_t WS_CTL = 0, CTL_ZERO_BYTES = 2 * MiB;
constexpr size_t CTL_SSQ_OFF = 65536;
constexpr size_t CTL_SSQM_OFF = 65536 + (size_t)9 * 17408 * 8;
static_assert(CTL_SSQM_OFF + 2048 * 8 <= CTL_ZERO_BYTES, "control block");
constexpr size_t WS_GU1 = CTL_ZERO_BYTES, SZ_GU = al((size_t)NGU * D * 2);
constexpr size_t WS_DN1 = WS_GU1 + 2 * SZ_GU, SZ_DN = al((size_t)D * FF * 2);
constexpr size_t WS_WIN = WS_DN1 + 2 * SZ_DN, SZ_WIN = al((size_t)OIN * D * 2);
constexpr size_t WS_WOUT = WS_WIN + 2 * SZ_WIN, SZ_SQ = al((size_t)D * D * 2);
constexpr size_t WS_WQ = WS_WOUT + 2 * SZ_SQ;
constexpr size_t WS_WO = WS_WQ + 2 * SZ_SQ;
constexpr size_t WS_WKV = WS_WO + 2 * SZ_SQ;
constexpr size_t WS_GU2 = WS_WKV + al((size_t)4096 * D * 2);
constexpr size_t WS_DN2 = WS_GU2 + 2 * SZ_GU;
constexpr size_t WS_LORA = WS_DN2 + 2 * SZ_DN;
constexpr size_t WS_X = WS_LORA + al((size_t)1536 * 256 * 2);
constexpr size_t WS_XB = WS_X + al((size_t)MT * D * 4);
constexpr size_t WS_HB = WS_XB + al((size_t)MT * D * 2);
constexpr size_t WS_PB = WS_HB + al((size_t)MT * FF * 2);
constexpr size_t WS_YM = WS_PB + al((size_t)MT * PLD * 2);
constexpr size_t WS_QB = WS_YM + al((size_t)MT * D * 2);
constexpr size_t WS_OB = WS_QB + al((size_t)MT * D * 2);
constexpr size_t WS_DS = WS_OB + al((size_t)MT * D * 2);
constexpr size_t WS_DEC = WS_DS + al((size_t)NCHP * 16384 * 4);
constexpr size_t WS_LB = WS_DEC + al((size_t)NCHP * 128 * 4);
constexpr size_t WS_AP = WS_LB + al((size_t)MT * 1536 * 2);
constexpr size_t WS_MEMB = WS_AP + al((size_t)MT * 256 * 2);
constexpr size_t WS_KB = WS_MEMB + al((size_t)2048 * D * 2);
constexpr size_t WS_VT = WS_KB + al((size_t)2 * 2048 * D * 2);
constexpr size_t WS_RREC = WS_VT + al((size_t)2 * 2048 * D * 2);
constexpr size_t WS_RGB = WS_RREC + al((size_t)9216 * 18432);
constexpr size_t WS_SLAB = WS_RGB + al((size_t)9216 * 16 * 64 * 4);
constexpr size_t WS_END = WS_SLAB + al((size_t)16 * 11 * 262144);
static_assert(WS_VT - WS_KB == 4194304 * 2 && O_MVP - O_MKP == 4194304, "epilogue layout assumptions");
constexpr int CW_BAR = 4096;

constexpr int MAIN_BYTES = 139264;
constexpr int LDSCTL_OFF = MAIN_BYTES, MISC_OFF = LDSCTL_OFF + 320;
constexpr int PRM_OFF = MAIN_BYTES + 1024;
constexpr int LDS_BYTES = 160 * 1024;
static_assert(LDS_BYTES <= 160 * 1024 && pg8::EpiAny::RED_OFF == PRM_OFF + 8192 && pg8::EpiAny::RED_OFF + 8 * 640 <= LDS_BYTES, "LDS");

#define RLX_AGENT __ATOMIC_RELAXED, __HIP_MEMORY_SCOPE_AGENT
__device__ __forceinline__ int lane_id_v() { int x; asm volatile("v_mbcnt_lo_u32_b32 %0, -1, 0\n\tv_mbcnt_hi_u32_b32 %0, -1, %0" : "=v"(x)); return x; }
__device__ __forceinline__ float bf2f(bf16 u) { return __uint_as_float((unsigned)u << 16); }
__device__ __forceinline__ void unpack8(const u32x4v w, float (&f)[8]) {
    f[0] = __uint_as_float(w.x << 16); f[1] = __uint_as_float(w.x & 0xffff0000u); f[2] = __uint_as_float(w.y << 16); f[3] = __uint_as_float(w.y & 0xffff0000u);
    f[4] = __uint_as_float(w.z << 16); f[5] = __uint_as_float(w.z & 0xffff0000u); f[6] = __uint_as_float(w.w << 16); f[7] = __uint_as_float(w.w & 0xffff0000u);
}
__device__ __forceinline__ unsigned f2bf(float f) { unsigned u = __builtin_bit_cast(unsigned, f); return (u + 0x7fffu + ((u >> 16) & 1u)) >> 16; }
__device__ __forceinline__ unsigned pk2(float lo, float hi) { return f2bf(lo) | (f2bf(hi) << 16); }
template <int CTRL> __device__ __forceinline__ float dpp_f(float x) { return __builtin_bit_cast(float, __builtin_amdgcn_update_dpp(0, __builtin_bit_cast(int, x), CTRL, 0xF, 0xF, true)); }
__device__ __forceinline__ float wave_sum(float v) {
    v += dpp_f<0xB1>(v); v += dpp_f<0x4E>(v); v += dpp_f<0x141>(v); v += dpp_f<0x140>(v);
    const int iv = __builtin_bit_cast(int, v);
    return (__builtin_bit_cast(float, __builtin_amdgcn_readlane(iv, 0)) + __builtin_bit_cast(float, __builtin_amdgcn_readlane(iv, 16))) +
           (__builtin_bit_cast(float, __builtin_amdgcn_readlane(iv, 32)) + __builtin_bit_cast(float, __builtin_amdgcn_readlane(iv, 48)));
}
__device__ __forceinline__ float wave_max(float v) {
    v = fmaxf(v, dpp_f<0xB1>(v)); v = fmaxf(v, dpp_f<0x4E>(v)); v = fmaxf(v, dpp_f<0x141>(v)); v = fmaxf(v, dpp_f<0x140>(v));
    const int iv = __builtin_bit_cast(int, v);
    return fmaxf(fmaxf(__builtin_bit_cast(float, __builtin_amdgcn_readlane(iv, 0)), __builtin_bit_cast(float, __builtin_amdgcn_readlane(iv, 16))),
                 fmaxf(__builtin_bit_cast(float, __builtin_amdgcn_readlane(iv, 32)), __builtin_bit_cast(float, __builtin_amdgcn_readlane(iv, 48))));
}
__device__ __forceinline__ float fexp(float x) { return __builtin_amdgcn_exp2f(1.4426950408889634f * x); }
__device__ __forceinline__ float flog(float x) { return __builtin_amdgcn_logf(x) * 0.6931471805599453f; }
__device__ __forceinline__ float fsig(float x) { return __builtin_amdgcn_rcpf(1.f + __builtin_amdgcn_exp2f(-1.4426950408889634f * x)); }
__device__ __forceinline__ float fsilu(float x) { return x * fsig(x); }

#define XB_TMO      128
#define XB_XCNT(j)  (256  + 64 * (j))
#define XB_XSUB(j)  (1280 + 64 * (j))
#define XB_XGEN(j)  (2304 + 64 * (j))
#define XB_TOP      3328
#define XB_TOPGEN   3392
#define XCD_BAR_WORDS 3456
#define XB_SPIN_CAP (1u << 18)

__device__ __forceinline__ unsigned xb_ld(unsigned* p)              { return __hip_atomic_load(p, __ATOMIC_RELAXED, __HIP_MEMORY_SCOPE_AGENT); }
__device__ __forceinline__ unsigned xb_add(unsigned* p, unsigned v) { return __hip_atomic_fetch_add(p, v, __ATOMIC_RELAXED, __HIP_MEMORY_SCOPE_AGENT); }
__device__ __forceinline__ unsigned xb_xcc_id() { return (unsigned)__builtin_amdgcn_s_getreg((3 << 11) | 20) & 0xFu; }
#define XB_SPIN(cond, bar) do { unsigned _sp = 0; while (cond) { __builtin_amdgcn_s_sleep(1); \
    if ((++_sp & 255u) == 0u) { if (xb_ld(&(bar)[XB_TMO])) break; if (_sp > XB_SPIN_CAP) { atomicAdd(&(bar)[XB_TMO], 1u); break; } } } } while (0)

struct XcdBarrier {
    unsigned* bar; unsigned x; int w0;
    volatile LAS unsigned* st;
};

__device__ __forceinline__ XcdBarrier xcd_barrier_post(unsigned* bar, volatile LAS unsigned* st) {
    XcdBarrier b; b.bar = bar; b.x = xb_xcc_id(); b.st = st;
    if (threadIdx.x == 0) (void)xb_add(&bar[XB_XCNT(b.x)], 1u);
    return b;
}
__device__ __forceinline__ void xcd_barrier_complete(unsigned* bar, unsigned x, unsigned& nloc, unsigned& nx) {
    const unsigned G = gridDim.x * gridDim.y * gridDim.z;
    unsigned sum, cnt, mine, sp = 0u;
    for (;;) {
        sum = 0u; cnt = 0u; mine = 0u;
#pragma unroll
        for (unsigned j = 0; j < 16; ++j) { const unsigned c = xb_ld(&bar[XB_XCNT(j)]); sum += c; cnt += (c > 0u) ? 1u : 0u; }
        mine = xb_ld(&bar[XB_XCNT(x)]);
        if (sum == G) break;
        __builtin_amdgcn_s_sleep(1);
        if ((++sp & 255u) == 0u) { if (xb_ld(&bar[XB_TMO])) break; if (sp > XB_SPIN_CAP) { atomicAdd(&bar[XB_TMO], 1u); break; } }
    }
    nloc = mine > 0u ? mine : 1u; nx = cnt > 0u ? cnt : 1u;
}

__device__ __forceinline__ void xcd_barrier(const XcdBarrier& b) {
    asm volatile("s_waitcnt vmcnt(0)" ::: "memory");
    __syncthreads();
    if (b.w0 == 0 && __builtin_amdgcn_mbcnt_hi(~0u, __builtin_amdgcn_mbcnt_lo(~0u, 0u)) == 0u) {
        unsigned* bar = b.bar; asm volatile("" : "+s"(bar));
        __builtin_amdgcn_s_waitcnt(0);
        unsigned nloc = b.st[0], nx = b.st[1];
        if (nloc == 0u) { xcd_barrier_complete(bar, b.x, nloc, nx); b.st[0] = nloc; b.st[1] = nx; }
        const unsigned old = xb_add(&bar[XB_XSUB(b.x)], 1u);
        const unsigned gen = old / nloc;
        if (old + 1u == (gen + 1u) * nloc) {
            __builtin_amdgcn_fence(__ATOMIC_RELEASE, "agent");
            asm volatile("s_waitcnt vmcnt(0)" ::: "memory");
            const unsigned og = xb_add(&bar[XB_TOP], 1u);
            const unsigned tg = og / nx;
            if (og + 1u == (tg + 1u) * nx) xb_add(&bar[XB_TOPGEN], 1u);
            else XB_SPIN(xb_ld(&bar[XB_TOPGEN]) == tg, bar);
            __builtin_amdgcn_fence(__ATOMIC_ACQUIRE, "agent");
            xb_add(&bar[XB_XGEN(b.x)], 1u);
            asm volatile("s_waitcnt vmcnt(0)" ::: "memory");
        } else {
            XB_SPIN(xb_ld(&bar[XB_XGEN(b.x)]) == gen, bar);
            __builtin_amdgcn_fence(__ATOMIC_ACQUIRE, "agent");
            asm volatile("s_waitcnt vmcnt(0)" ::: "memory");
        }
    }
    __syncthreads();
}
struct Args { const float* in[42]; float* out; unsigned char* ws; };
typedef const __attribute__((address_space(4))) Args* ArgsP;
__device__ __forceinline__ ArgsP kargs() { ArgsP p = (ArgsP)__builtin_amdgcn_kernarg_segment_ptr(); asm volatile("" : "+s"(p)); return p; }

#define LDS_WAIT() asm volatile("s_waitcnt lgkmcnt(0)" ::: "memory")

typedef float f32x2p __attribute__((ext_vector_type(2)));
__device__ __forceinline__ void transpose_item(const float* W, int K, int N, const float* g, bf16* WT, int dest_row0, int k0, int n0, LAS float* scr, int lane) {
    f32x2p wv[32];
    const int cl = (lane & 31) * 2, rh = lane >> 5;
#pragma unroll
    for (int i = 0; i < 32; ++i) wv[i] = *(const f32x2p*)(W + (size_t)(k0 + 2 * i + rh) * N + n0 + cl);
    if (g) {
#pragma unroll
        for (int i = 0; i < 32; ++i) wv[i] *= g[k0 + 2 * i + rh];
    }
#pragma unroll
    for (int i = 0; i < 32; ++i) { const int kk = 2 * i + rh; scr[kk * 65 + cl] = wv[i].x; scr[kk * 65 + cl + 1] = wv[i].y; }
    LDS_WAIT(); asm volatile("" ::: "memory");
    const int c = lane & 7;
#pragma unroll
    for (int j = 0; j < 8; ++j) { const int n = (lane >> 3) + 8 * j; const LAS float* s = scr + (8 * c) * 65 + n;
        u32x4v o; o.x = pk2(s[0 * 65], s[1 * 65]); o.y = pk2(s[2 * 65], s[3 * 65]); o.z = pk2(s[4 * 65], s[5 * 65]); o.w = pk2(s[6 * 65], s[7 * 65]);
        *(u32x4v*)(WT + (size_t)(dest_row0 + n) * K + k0 + 8 * c) = o; }
    LDS_WAIT(); asm volatile("" ::: "memory");
}
struct WSeg { const float* W; const float* g; bf16* WT; int K, N, mode; };
__device__ __forceinline__ WSeg get_seg(ArgsP a, int s) {
    unsigned char* ws = a->ws; WSeg r; r.g = nullptr; r.mode = 0; r.K = D; r.N = D;
    const int l = s & 1;
    switch (s >> 1) {
    case 0: r.W = a->in[I_F1GU] + (size_t)l * D * NGU; r.g = a->in[I_F1N] + l * D; r.WT = (bf16*)(ws + WS_GU1 + l * SZ_GU); r.N = NGU; r.mode = 1; break;
    case 1: r.W = a->in[I_F1DN] + (size_t)l * FF * D; r.WT = (bf16*)(ws + WS_DN1 + l * SZ_DN); r.K = FF; break;
    case 2: if (l == 0) { r.W = a->in[I_EWIN]; r.g = a->in[I_MIXN]; r.WT = (bf16*)(ws + WS_WIN); r.N = EIN; } else { r.W = a->in[I_OWIN]; r.g = a->in[I_MIXN] + D; r.WT = (bf16*)(ws + WS_WIN + SZ_WIN); r.N = OIN; } break;
    case 3: r.W = l == 0 ? a->in[I_EWOUT] : a->in[I_OWOUT]; r.WT = (bf16*)(ws + WS_WOUT + l * SZ_SQ); break;
    case 4: r.W = a->in[I_WQ] + (size_t)l * D * D; r.g = a->in[I_XN] + l * D; r.WT = (bf16*)(ws + WS_WQ + l * SZ_SQ); break;
    case 5: r.W = a->in[I_WKV] + (size_t)l * D * 2048; r.g = a->in[I_MEMN] + l * D; r.WT = (bf16*)(ws + WS_WKV) + (size_t)l * 2048 * D; r.N = 2048; break;
    case 6: r.W = a->in[I_WO] + (size_t)l * D * D; r.WT = (bf16*)(ws + WS_WO + l * SZ_SQ); break;
    case 7: r.W = a->in[I_F2GU] + (size_t)l * D * NGU; r.g = a->in[I_F2N] + l * D; r.WT = (bf16*)(ws + WS_GU2 + l * SZ_GU); r.N = NGU; r.mode = 1; break;
    default: r.W = a->in[I_F2DN] + (size_t)l * FF * D; r.WT = (bf16*)(ws + WS_DN2 + l * SZ_DN); r.K = FF; break;
    }
    return r;
}
__device__ __forceinline__ void convert_weights(ArgsP a, LAS unsigned char* lds, unsigned mask, int gw, int NGW, int tid) {
    const int lane = tid & 63, wave = tid >> 6;
    LAS float* scr = (LAS float*)(lds + wave * 16640);
    int base = 0;
    for (int s = 0; s < 18; ++s) {
        if (!((mask >> s) & 1u)) continue;
        const WSeg sg = get_seg(a, s);
        const int nblk = sg.N / 64, cnt = (sg.K / 64) * nblk;
        int it = base + ((gw - base) % NGW + NGW) % NGW;
        for (; it < base + cnt; it += NGW) {
            const int r = it - base, kb = r / nblk, nb = r % nblk, n0 = 64 * nb;
            int dr = n0;
            if (sg.mode == 1) { const int hh = n0 < FF ? n0 : n0 - FF; dr = 256 * (hh >> 7) + (hh & 127) + (n0 < FF ? 0 : 128); }
            transpose_item(sg.W, sg.K, sg.N, sg.g, sg.WT, dr, 64 * kb, n0, scr, lane);
        }
        base += cnt;
    }
}
constexpr unsigned WMASK_PRO = (1u << 0),
                   WMASK_T0 = (1u << 2) | (1u << 4),
                   WMASK_T2 = (1u << 6) | (1u << 10) | (1u << 11) | (1u << 8) | (1u << 12),
                   WMASK_T4 = (1u << 14) | (1u << 16),
                   WMASK_T5 = (1u << 1) | (1u << 3) | (1u << 5),
                   WMASK_T6 = (1u << 7) | (1u << 9) | (1u << 13) | (1u << 15) | (1u << 17);
static_assert((WMASK_PRO | WMASK_T0 | WMASK_T2 | WMASK_T4 | WMASK_T5 | WMASK_T6) == 0x3ffffu &&
              (WMASK_PRO + WMASK_T0 + WMASK_T2 + WMASK_T4 + WMASK_T5 + WMASK_T6) == 0x3ffffu, "every segment exactly once");
__device__ __forceinline__ void p0_prologue(ArgsP a, LAS unsigned char* lds, int vcu, int G, int tid) {
    const int lane = tid & 63, wave = tid >> 6;
    const int gw = vcu * NWAVES + wave, NGW = G * NWAVES;
    unsigned char* ws = a->ws;
    convert_weights(a, lds, WMASK_PRO, gw, NGW, tid);
    {
        bf16* LW = (bf16*)(ws + WS_LORA);
        const float* w2 = a->in[I_W2]; const float* a2 = a->in[I_A2]; const float* g2 = a->in[I_G2];
        for (int e = (vcu * NTHR + tid); e < 1536 * 256; e += G * NTHR) {
            const int n = e >> 8, k = e & 255; float v = 0.f;
            if (n < 512) { if (k < 64) v = w2[k * 512 + n]; }
            else if (n < 1024) { if (k >= 64 && k < 128) v = a2[(k - 64) * 512 + (n - 512)]; }
            else { if (k >= 128) v = g2[(k - 128) * 512 + (n - 1024)]; }
            LW[e] = (bf16)f2bf(v);
        }
    }
    {
        pg8::ssq_t* ssq0 = (pg8::ssq_t*)(ws + WS_CTL + CTL_SSQ_OFF);
        pg8::ssq_t* ssqm = (pg8::ssq_t*)(ws + WS_CTL + CTL_SSQM_OFF);
        bf16* XB = (bf16*)(ws + WS_XB); bf16* MB = (bf16*)(ws + WS_MEMB);
        for (int m0 = gw; m0 < MT + 2048; m0 += 2 * NGW) {
            f32x4 v[2][4]; bf16* dst[2]; pg8::ssq_t* sq[2]; bool ok[2];
#pragma unroll
            for (int q = 0; q < 2; ++q) {
                const int m = m0 + q * NGW; ok[q] = m < MT + 2048; const int mm = ok[q] ? m : m0;
                const float* src;
                if (mm < MP) { src = a->in[I_XP] + (size_t)mm * D; dst[q] = XB + (size_t)mm * D; sq[q] = ssq0 + mm; }
                else if (mm < MT) { src = a->in[I_XS] + (size_t)(mm - MP) * D; dst[q] = XB + (size_t)mm * D; sq[q] = ssq0 + mm; }
                else { src = a->in[I_MEM] + (size_t)(mm - MT) * D; dst[q] = MB + (size_t)(mm - MT) * D; sq[q] = ssqm + (mm - MT); }
                const f32x4* xr = (const f32x4*)src + lane;
#pragma unroll
                for (int j = 0; j < 4; ++j) v[q][j] = xr[64 * j];
            }
#pragma unroll
            for (int q = 0; q < 2; ++q) {
                float s = 0.f;
#pragma unroll
                for (int j = 0; j < 4; ++j) s += (v[q][j].x * v[q][j].x + v[q][j].y * v[q][j].y) + (v[q][j].z * v[q][j].z + v[q][j].w * v[q][j].w);
                s = wave_sum(s);
                if (ok[q]) {
                    u32x2v* o8 = (u32x2v*)dst[q] + lane;
#pragma unroll
                    for (int j = 0; j < 4; ++j) { u32x2v w; w.x = pk2(v[q][j].x, v[q][j].y); w.y = pk2(v[q][j].z, v[q][j].w); o8[64 * j] = w; }
                    if (lane == 0) *sq[q] = pg8::ssq_fix(s);
                }
            }
        }
    }
}

struct ChunkInfo { int row0, h, b, pos0; bool sample; };
__device__ __forceinline__ ChunkInfo chunk_info(int cid) {
    ChunkInfo c;
    if (cid < NCHP) { c.b = cid >> 7; c.h = (cid >> 5) & 3; const int ch = cid & 31; c.row0 = c.b * 2048 + ch * 64; c.pos0 = ch * 64; c.sample = false; }
    else { const int j = cid - NCHP; c.b = j >> 2; c.h = j & 3; c.row0 = MP + c.b * 8; c.pos0 = 16384; c.sample = true; }
    return c;
}


__device__ __forceinline__ void rope_cs(int pos, float inv, float& c, float& s) {
    const float ang = (float)pos * inv;
    const double rev = (double)ang * 0.15915494309189535;
    const float fr = (float)(rev - __builtin_rint(rev));
    s = __builtin_amdgcn_sinf(fr); c = __builtin_amdgcn_cosf(fr);
}
__device__ __forceinline__ float ret_lg2(int h) { return __log2f(1.0f - __builtin_amdgcn_exp2f(-5.0f - (float)h)); }

constexpr int CB_QM = 0, CB_KM = 17408, CB_ATT = 34816, CB_VVT = 44032, CB_ST = 62464, CB_BC = 97280, CB_SK = 130048, CB_PART = 130560;
constexpr int CB_GI = CB_BC;
__device__ __forceinline__ bf16x8 ldsfrag(const LAS unsigned char* p) { return *(const LAS bf16x8*)p; }
__device__ __forceinline__ int tsw(int r, int t) { return r * 72 + ((((t >> 3) ^ (r >> 3)) & 7) << 3) + (t & 7); }
__device__ __forceinline__ int tsf(int r, int chunk) { return r * 144 + (((chunk ^ (r >> 3)) & 7) << 4); }
__device__ __forceinline__ void cumsum64(LAS float* bc, LAS float* tot, int tid) {
    const int k = tid & 127, seg = tid >> 7; float v[16]; float s = 0.f;
#pragma unroll
    for (int i = 0; i < 16; ++i) { s += bc[(16 * seg + i) * 128 + k]; v[i] = s; }
    tot[seg * 128 + k] = s;
    __syncthreads();
    float off = 0.f;
#pragma unroll
    for (int q = 0; q < 3; ++q) if (q < seg) off += tot[q * 128 + k];
#pragma unroll
    for (int i = 0; i < 16; ++i) bc[(16 * seg + i) * 128 + k] = v[i] + off;
    __syncthreads();
}
__device__ __forceinline__ void chunk_a_core64_bf16(const LAS unsigned char* lds, bf16* dS, int tid) {
    const int lane = tid & 63, wave = __builtin_amdgcn_readfirstlane(tid >> 6), ij = lane & 15, kq = lane >> 4;
    f32x4 acc[8];
#pragma unroll
    for (int q = 0; q < 8; ++q) acc[q] = (f32x4){0.f, 0.f, 0.f, 0.f};
#pragma unroll
    for (int s = 0; s < 2; ++s) {
        const bf16x8 kf = ldsfrag(lds + tsf(16 * wave + ij, 4 * s + kq));
#pragma unroll
        for (int q = 0; q < 8; ++q) acc[q] = __builtin_amdgcn_mfma_f32_16x16x32_bf16(ldsfrag(lds + CB_VVT + tsf(16 * q + ij, 4 * s + kq)), kf, acc[q], 0, 0, 0);
    }
    bf16* dst = dS + (size_t)(16 * wave + ij) * 128 + 32 * kq;
    float one = 1.0f; asm volatile("" : "+v"(one));
#pragma unroll
    for (int q2 = 0; q2 < 4; ++q2) {
        const f32x4 a0 = acc[2 * q2] * one, a1 = acc[2 * q2 + 1] * one;
        u32x4v w; w.x = pg8::cvt_pk_bf16(a0[0], a0[1]); w.y = pg8::cvt_pk_bf16(a0[2], a0[3]); w.z = pg8::cvt_pk_bf16(a1[0], a1[1]); w.w = pg8::cvt_pk_bf16(a1[2], a1[3]);
        *(u32x4v*)(dst + 8 * q2) = w;
    }
}
__device__ __forceinline__ void chunk_c_core64_bf16(LAS unsigned char* lds, const bf16* S, const float* gn, const bf16* gate, bf16* yout, int tid) {
    const int lane = tid & 63, wave = __builtin_amdgcn_readfirstlane(tid >> 6), ij = lane & 15, kq = lane >> 4;
    const LAS float* sk = (const LAS float*)(lds + CB_SK); LAS float* part = (LAS float*)(lds + CB_PART);
    {
        u32x4v sv[2][2], gv[2];
#pragma unroll
        for (int q = 0; q < 2; ++q) { const int p = tid + 512 * q, kp = p >> 4, c = p & 15;
            sv[q][0] = *(const u32x4v*)(S + (size_t)(2 * kp) * 128 + 8 * c); sv[q][1] = *(const u32x4v*)(S + (size_t)(2 * kp + 1) * 128 + 8 * c);
            gv[q] = *(const u32x4v*)(gate + (size_t)(p >> 4) * PLD + 8 * (p & 15)); }
#pragma unroll
        for (int q = 0; q < 2; ++q) { const int p = tid + 512 * q; *(LAS u32x4v*)(lds + CB_GI + (p >> 4) * 272 + 16 * (p & 15)) = gv[q]; }
#pragma unroll
        for (int q = 0; q < 2; ++q) { const int p = tid + 512 * q, k = 2 * (p >> 4), c = p & 15, vq = 4 * (c >> 2), q0 = (c & 3) * 2; const float sc0 = sk[k], sc1 = sk[k + 1];
            const unsigned wa[4] = {sv[q][0].x, sv[q][0].y, sv[q][0].z, sv[q][0].w}, wb[4] = {sv[q][1].x, sv[q][1].y, sv[q][1].z, sv[q][1].w};
#pragma unroll
            for (int j = 0; j < 8; ++j) { const int v = 16 * (q0 + (j >> 2)) + vq + (j & 3);
                const float fa = (j & 1) ? __uint_as_float(wa[j >> 1] & 0xffff0000u) : __uint_as_float(wa[j >> 1] << 16);
                const float fb = (j & 1) ? __uint_as_float(wb[j >> 1] & 0xffff0000u) : __uint_as_float(wb[j >> 1] << 16);
                LAS unsigned* dst = (LAS unsigned*)((LAS bf16*)(lds + CB_ST) + v * 136 + (((k >> 3) ^ ((v >> 3) & 7)) << 3) + (k & 7));
                dst[0] = pk2(fa * sc0, fb * sc1); }
        }
    }
    {
        const int t0 = 16 * (wave >> 1), j0 = 32 * (wave & 1);
        f32x4 c0 = (f32x4){0.f, 0.f, 0.f, 0.f}, c1 = c0;
#pragma unroll
        for (int s = 0; s < 4; ++s) { const bf16x8 af = ldsfrag(lds + CB_QM + (t0 + ij) * 272 + 64 * s + 16 * kq);
            c0 = __builtin_amdgcn_mfma_f32_16x16x32_bf16(af, ldsfrag(lds + CB_KM + (j0 + ij) * 272 + 64 * s + 16 * kq), c0, 0, 0, 0);
            c1 = __builtin_amdgcn_mfma_f32_16x16x32_bf16(af, ldsfrag(lds + CB_KM + (j0 + 16 + ij) * 272 + 64 * s + 16 * kq), c1, 0, 0, 0); }
        LAS bf16* ab = (LAS bf16*)(lds + CB_ATT);
#pragma unroll
        for (int r = 0; r < 4; ++r) { const int t = t0 + 4 * kq + r; int j = j0 + ij; ab[t * 72 + j] = (bf16)f2bf((j <= t) ? c0[r] : 0.f); j += 16; ab[t * 72 + j] = (bf16)f2bf((j <= t) ? c1[r] : 0.f); }
    }
    __syncthreads();
    const int t0 = 16 * (wave >> 1), vb = 64 * (wave & 1);
    f32x4 o[4];
#pragma unroll
    for (int q = 0; q < 4; ++q) o[q] = (f32x4){0.f, 0.f, 0.f, 0.f};
#pragma unroll
    for (int s = 0; s < 4; ++s) { const bf16x8 af = ldsfrag(lds + CB_QM + (t0 + ij) * 272 + 64 * s + 16 * kq);
#pragma unroll
        for (int q = 0; q < 4; ++q) { const int v = vb + 16 * q + ij; o[q] = __builtin_amdgcn_mfma_f32_16x16x32_bf16(af, ldsfrag(lds + CB_ST + v * 272 + 16 * ((4 * s + kq) ^ ((v >> 3) & 7))), o[q], 0, 0, 0); } }
#pragma unroll
    for (int s = 0; s < 2; ++s) { const bf16x8 af = ldsfrag(lds + CB_ATT + (t0 + ij) * 144 + 64 * s + 16 * kq);
#pragma unroll
        for (int q = 0; q < 4; ++q) o[q] = __builtin_amdgcn_mfma_f32_16x16x32_bf16(af, ldsfrag(lds + CB_VVT + tsf(vb + 16 * q + ij, 4 * s + kq)), o[q], 0, 0, 0); }
    float ss[4];
#pragma unroll
    for (int r = 0; r < 4; ++r) { float s = (o[0][r] * o[0][r] + o[1][r] * o[1][r]) + (o[2][r] * o[2][r] + o[3][r] * o[3][r]);
        s += dpp_f<0xB1>(s); s += dpp_f<0x4E>(s); s += dpp_f<0x141>(s); s += dpp_f<0x140>(s); ss[r] = s; }
    if (ij == 0) {
#pragma unroll
        for (int r = 0; r < 4; ++r) part[(wave & 1) * 64 + t0 + 4 * kq + r] = ss[r];
    }
    __syncthreads();
    float gnv[4];
#pragma unroll
    for (int q = 0; q < 4; ++q) gnv[q] = gn[vb + 16 * q + ij];
    LAS bf16* yo = (LAS bf16*)(lds + CB_QM);
    const LAS bf16* gi = (const LAS bf16*)(lds + CB_GI);
#pragma unroll
    for (int r = 0; r < 4; ++r) {
        const int t = t0 + 4 * kq + r;
        const float rs = __builtin_amdgcn_rsqf((part[t] + part[64 + t]) * (1.0f / 128.0f) + 1e-6f);
#pragma unroll
        for (int q = 0; q < 4; ++q) { const int v = vb + 16 * q + ij; yo[t * 136 + v] = (bf16)f2bf(o[q][r] * rs * gnv[q] * fsilu(bf2f(gi[t * 136 + v]))); }
    }
    __syncthreads();
#pragma unroll
    for (int q = 0; q < 2; ++q) { const int p = tid + 512 * q; *(u32x4v*)(yout + (size_t)(p >> 4) * D + 8 * (p & 15)) = *(const LAS u32x4v*)(lds + CB_QM + (p >> 4) * 272 + 16 * (p & 15)); }
    __syncthreads();
}
__device__ __forceinline__ void hgrn_a64(int cid, const bf16* P, bf16* DS, float* DEC, const LAS float* lbv, LAS unsigned char* lds, int tid) {
    const ChunkInfo ci = chunk_info(cid);
    LAS float* bc = (LAS float*)(lds + CB_BC); LAS float* tot = (LAS float*)(lds + CB_SK);
    LAS bf16* kdT = (LAS bf16*)lds; LAS bf16* vvT = (LAS bf16*)(lds + CB_VVT);
    u32x4v fw[2], iw[2];
#pragma unroll
    for (int j = 0; j < 2; ++j) { const int p = tid + 512 * j, t = p >> 4, k0 = 8 * (p & 15); const bf16* pr = P + (size_t)(ci.row0 + t) * PLD + ci.h * 128 + k0;
        fw[j] = *(const u32x4v*)(pr + 2048); iw[j] = *(const u32x4v*)(pr + 2560); }
    float omf[2][8];
#pragma unroll
    for (int j = 0; j < 2; ++j) {
        const int p = tid + 512 * j, t = p >> 4, k0 = 8 * (p & 15);
        float fb[8]; unpack8(fw[j], fb);
        const f32x4 l0 = *(const LAS f32x4*)(lbv + ci.h * 128 + k0), l1 = *(const LAS f32x4*)(lbv + ci.h * 128 + k0 + 4);
        f32x4 lg[2];
#pragma unroll
        for (int i = 0; i < 8; ++i) { const float lb = (i < 4) ? l0[i & 3] : l1[i & 3]; const float f = lb + (1.f - lb) * fsig(fb[i]); lg[i >> 2][i & 3] = flog(f); omf[j][i] = 1.f - f; }
        *(LAS f32x4*)(bc + t * 128 + k0) = lg[0]; *(LAS f32x4*)(bc + t * 128 + k0 + 4) = lg[1];
        const unsigned iv[4] = {iw[j].x, iw[j].y, iw[j].z, iw[j].w};
#pragma unroll
        for (int i = 0; i < 8; ++i) vvT[tsw(k0 + i, t)] = (bf16)((i & 1) ? (iv[i >> 1] >> 16) : (iv[i >> 1] & 0xffffu));
    }
    __syncthreads();
    cumsum64(bc, tot, tid);
#pragma unroll
    for (int j = 0; j < 2; ++j) {
        const int p = tid + 512 * j, t = p >> 4, k0 = 8 * (p & 15);
        const f32x4 e0 = *(const LAS f32x4*)(bc + 63 * 128 + k0), e1 = *(const LAS f32x4*)(bc + 63 * 128 + k0 + 4), c0 = *(const LAS f32x4*)(bc + t * 128 + k0), c1 = *(const LAS f32x4*)(bc + t * 128 + k0 + 4);
#pragma unroll
        for (int i = 0; i < 8; ++i) { const float d = ((i < 4) ? e0[i & 3] : e1[i & 3]) - ((i < 4) ? c0[i & 3] : c1[i & 3]); kdT[tsw(k0 + i, t)] = (bf16)f2bf(omf[j][i] * fexp(d)); }
    }
    if (tid < 128) DEC[cid * 128 + tid] = fexp(bc[63 * 128 + tid]);
    __syncthreads();
    chunk_a_core64_bf16(lds, DS + (size_t)cid * 16384, tid);
    __syncthreads();
}
__device__ __forceinline__ void hgrn_c64(int cid, const bf16* P, const bf16* DS, const float* gnorm, bf16* YM, const LAS float* lbv, LAS unsigned char* lds, int tid) {
    const ChunkInfo ci = chunk_info(cid);
    LAS float* bc = (LAS float*)(lds + CB_BC);
    LAS bf16* qmB = (LAS bf16*)(lds + CB_QM); LAS bf16* kmB = (LAS bf16*)(lds + CB_KM); LAS bf16* vvT = (LAS bf16*)(lds + CB_VVT); LAS float* sk = (LAS float*)(lds + CB_SK);
    u32x4v qw[2], fw[2], iw[2];
#pragma unroll
    for (int j = 0; j < 2; ++j) { const int p = tid + 512 * j, t = p >> 4, k0 = 8 * (p & 15); const bf16* pr = P + (size_t)(ci.row0 + t) * PLD + ci.h * 128 + k0;
        qw[j] = *(const u32x4v*)(pr + 1536); fw[j] = *(const u32x4v*)(pr + 2048); iw[j] = *(const u32x4v*)(pr + 2560); }
    float omf[2][8], sq[2][8];
#pragma unroll
    for (int j = 0; j < 2; ++j) {
        const int p = tid + 512 * j, t = p >> 4, k0 = 8 * (p & 15);
        float fb[8], qb[8]; unpack8(fw[j], fb); unpack8(qw[j], qb);
        const f32x4 l0 = *(const LAS f32x4*)(lbv + ci.h * 128 + k0), l1 = *(const LAS f32x4*)(lbv + ci.h * 128 + k0 + 4);
        f32x4 lg[2];
#pragma unroll
        for (int i = 0; i < 8; ++i) { const float lb = (i < 4) ? l0[i & 3] : l1[i & 3]; const float f = lb + (1.f - lb) * fsig(fb[i]); lg[i >> 2][i & 3] = flog(f); omf[j][i] = 1.f - f; sq[j][i] = fsilu(qb[i]); }
        *(LAS f32x4*)(bc + t * 128 + k0) = lg[0]; *(LAS f32x4*)(bc + t * 128 + k0 + 4) = lg[1];
        const unsigned iv[4] = {iw[j].x, iw[j].y, iw[j].z, iw[j].w};
#pragma unroll
        for (int i = 0; i < 8; ++i) vvT[tsw(k0 + i, t)] = (bf16)((i & 1) ? (iv[i >> 1] >> 16) : (iv[i >> 1] & 0xffffu));
    }
    __syncthreads();
    cumsum64(bc, (LAS float*)(lds + CB_ST), tid);
    if (tid < 128) sk[tid] = fexp(bc[32 * 128 + tid]);
#pragma unroll
    for (int j = 0; j < 2; ++j) {
        const int p = tid + 512 * j, t = p >> 4, k0 = 8 * (p & 15);
        const f32x4 m0 = *(const LAS f32x4*)(bc + 32 * 128 + k0), m1 = *(const LAS f32x4*)(bc + 32 * 128 + k0 + 4), c0 = *(const LAS f32x4*)(bc + t * 128 + k0), c1 = *(const LAS f32x4*)(bc + t * 128 + k0 + 4);
        float qv[8], kv[8];
#pragma unroll
        for (int i = 0; i < 8; ++i) { const float d = ((i < 4) ? c0[i & 3] : c1[i & 3]) - ((i < 4) ? m0[i & 3] : m1[i & 3]); qv[i] = sq[j][i] * fexp(d); kv[i] = omf[j][i] * fexp(-d); }
        u32x4v qo, ko; qo.x = pk2(qv[0], qv[1]); qo.y = pk2(qv[2], qv[3]); qo.z = pk2(qv[4], qv[5]); qo.w = pk2(qv[6], qv[7]); ko.x = pk2(kv[0], kv[1]); ko.y = pk2(kv[2], kv[3]); ko.z = pk2(kv[4], kv[5]); ko.w = pk2(kv[6], kv[7]);
        *(LAS u32x4v*)(qmB + t * 136 + k0) = qo; *(LAS u32x4v*)(kmB + t * 136 + k0) = ko;
    }
    __syncthreads();
    chunk_c_core64_bf16(lds, DS + (size_t)cid * 16384, gnorm + ci.h * 128, P + (size_t)ci.row0 * PLD + 3072 + ci.h * 128, YM + (size_t)ci.row0 * D + 512 + ci.h * 128, tid);
}
__device__ __forceinline__ void ret_a64(int cid, const bf16* P, bf16* DS, const LAS float* invf, LAS unsigned char* lds, int tid) {
    const ChunkInfo ci = chunk_info(cid);
    LAS bf16* kdT = (LAS bf16*)lds; LAS bf16* vvT = (LAS bf16*)(lds + CB_VVT);
    const float lg2 = ret_lg2(ci.h);
    const int t = tid >> 3, i0 = 8 * (tid & 7);
    const bf16* pr = P + (size_t)(ci.row0 + t) * PLD + ci.h * 128 + i0;
    const u32x4v k1w = *(const u32x4v*)(pr + 512), k2w = *(const u32x4v*)(pr + 512 + 64), v1w = *(const u32x4v*)(pr + 1024), v2w = *(const u32x4v*)(pr + 1024 + 64);
    float k1[8], k2[8]; unpack8(k1w, k1); unpack8(k2w, k2);
    const unsigned v1v[4] = {v1w.x, v1w.y, v1w.z, v1w.w}, v2v[4] = {v2w.x, v2w.y, v2w.z, v2w.w};
    const f32x4 f0 = *(const LAS f32x4*)(invf + i0), f1 = *(const LAS f32x4*)(invf + i0 + 4);
    const float sc = 0.08838834764831845f * __builtin_amdgcn_exp2f(lg2 * (float)(63 - t));
#pragma unroll
    for (int j = 0; j < 8; ++j) {
        const int i = i0 + j;
        float c, s; rope_cs(ci.pos0 + t, (j < 4) ? f0[j & 3] : f1[j & 3], c, s);
        kdT[tsw(i, t)] = (bf16)f2bf((k1[j] * c - k2[j] * s) * sc); kdT[tsw(64 + i, t)] = (bf16)f2bf((k1[j] * s + k2[j] * c) * sc);
        vvT[tsw(i, t)] = (bf16)((j & 1) ? (v1v[j >> 1] >> 16) : (v1v[j >> 1] & 0xffffu)); vvT[tsw(64 + i, t)] = (bf16)((j & 1) ? (v2v[j >> 1] >> 16) : (v2v[j >> 1] & 0xffffu));
    }
    __syncthreads();
    chunk_a_core64_bf16(lds, DS + (size_t)cid * 16384, tid);
    __syncthreads();
}
__device__ __forceinline__ void ret_c64(int cid, const bf16* P, const bf16* DS, const float* gnorm, bf16* YM, const LAS float* invf, LAS unsigned char* lds, int tid) {
    const ChunkInfo ci = chunk_info(cid);
    LAS bf16* qmB = (LAS bf16*)(lds + CB_QM); LAS bf16* kmB = (LAS bf16*)(lds + CB_KM); LAS bf16* vvT = (LAS bf16*)(lds + CB_VVT); LAS float* sk = (LAS float*)(lds + CB_SK);
    const float lg2 = ret_lg2(ci.h);
    const int t = tid >> 3, i0 = 8 * (tid & 7);
    const bf16* pr = P + (size_t)(ci.row0 + t) * PLD + ci.h * 128 + i0;
    const u32x4v q1w = *(const u32x4v*)(pr), q2w = *(const u32x4v*)(pr + 64), k1w = *(const u32x4v*)(pr + 512), k2w = *(const u32x4v*)(pr + 512 + 64), v1w = *(const u32x4v*)(pr + 1024), v2w = *(const u32x4v*)(pr + 1024 + 64);
    float q1[8], q2[8], k1[8], k2[8]; unpack8(q1w, q1); unpack8(q2w, q2); unpack8(k1w, k1); unpack8(k2w, k2);
    const unsigned v1v[4] = {v1w.x, v1w.y, v1w.z, v1w.w}, v2v[4] = {v2w.x, v2w.y, v2w.z, v2w.w};
    const f32x4 f0 = *(const LAS f32x4*)(invf + i0), f1 = *(const LAS f32x4*)(invf + i0 + 4);
    const float dq = __builtin_amdgcn_exp2f(lg2 * (float)(t - 32)), dk = 0.08838834764831845f * __builtin_amdgcn_exp2f(lg2 * (float)(32 - t));
    float qa[8], qb[8], ka[8], kb[8];
#pragma unroll
    for (int j = 0; j < 8; ++j) {
        const int i = i0 + j;
        float c, s; rope_cs(ci.pos0 + t, (j < 4) ? f0[j & 3] : f1[j & 3], c, s);
        qa[j] = (q1[j] * c - q2[j] * s) * dq; qb[j] = (q1[j] * s + q2[j] * c) * dq; ka[j] = (k1[j] * c - k2[j] * s) * dk; kb[j] = (k1[j] * s + k2[j] * c) * dk;
        vvT[tsw(i, t)] = (bf16)((j & 1) ? (v1v[j >> 1] >> 16) : (v1v[j >> 1] & 0xffffu)); vvT[tsw(64 + i, t)] = (bf16)((j & 1) ? (v2v[j >> 1] >> 16) : (v2v[j >> 1] & 0xffffu));
    }
    { u32x4v w; w.x = pk2(qa[0], qa[1]); w.y = pk2(qa[2], qa[3]); w.z = pk2(qa[4], qa[5]); w.w = pk2(qa[6], qa[7]); *(LAS u32x4v*)(qmB + t * 136 + i0) = w;
      w.x = pk2(qb[0], qb[1]); w.y = pk2(qb[2], qb[3]); w.z = pk2(qb[4], qb[5]); w.w = pk2(qb[6], qb[7]); *(LAS u32x4v*)(qmB + t * 136 + 64 + i0) = w;
      w.x = pk2(ka[0], ka[1]); w.y = pk2(ka[2], ka[3]); w.z = pk2(ka[4], ka[5]); w.w = pk2(ka[6], ka[7]); *(LAS u32x4v*)(kmB + t * 136 + i0) = w;
      w.x = pk2(kb[0], kb[1]); w.y = pk2(kb[2], kb[3]); w.z = pk2(kb[4], kb[5]); w.w = pk2(kb[6], kb[7]); *(LAS u32x4v*)(kmB + t * 136 + 64 + i0) = w; }
    if (tid < 128) sk[tid] = __builtin_amdgcn_exp2f(lg2 * 33.0f);
    __syncthreads();
    chunk_c_core64_bf16(lds, DS + (size_t)cid * 16384, gnorm + ci.h * 128, P + (size_t)ci.row0 * PLD + 1536 + ci.h * 128, YM + (size_t)ci.row0 * D + ci.h * 128, tid);
}

__device__ __forceinline__ void sample_state_load(const float* S0, float (&S)[32], int tid) {
    const int v = tid & 127, kq = tid >> 7;
#pragma unroll
    for (int i = 0; i < 32; ++i) S[i] = S0[(size_t)(kq * 32 + i) * 128 + v];
}
__device__ __forceinline__ void sample_rec_core(float (&S)[32], float* Sout, const float* gn, bf16* yout  , LAS unsigned char* lds, int tid) {
    const LAS float* dk = (const LAS float*)lds; const LAS float* kk = dk + 1024; const LAS float* qq = kk + 1024; const LAS float* vv = qq + 1024; const LAS float* gg = vv + 1024; LAS float* op = (LAS float*)(lds + 20480);
    const int v = tid & 127, kq = tid >> 7, lane = tid & 63, w = tid >> 6;
#pragma unroll 1
    for (int t = 0; t < 8; ++t) {
        const float x = vv[t * 128 + v]; float o = 0.f;
        const LAS f32x4* d4 = (const LAS f32x4*)(dk + t * 128 + kq * 32); const LAS f32x4* k4 = (const LAS f32x4*)(kk + t * 128 + kq * 32); const LAS f32x4* q4 = (const LAS f32x4*)(qq + t * 128 + kq * 32);
#pragma unroll
        for (int i = 0; i < 8; ++i) {
            const f32x4 d = d4[i], k = k4[i], q = q4[i];
            S[4 * i + 0] = d.x * S[4 * i + 0] + k.x * x; o += q.x * S[4 * i + 0];
            S[4 * i + 1] = d.y * S[4 * i + 1] + k.y * x; o += q.y * S[4 * i + 1];
            S[4 * i + 2] = d.z * S[4 * i + 2] + k.z * x; o += q.z * S[4 * i + 2];
            S[4 * i + 3] = d.w * S[4 * i + 3] + k.w * x; o += q.w * S[4 * i + 3];
        }
        op[(t * 4 + kq) * 128 + v] = o;
    }
#pragma unroll
    for (int i = 0; i < 32; ++i) Sout[(size_t)(kq * 32 + i) * 128 + v] = S[i];
    __syncthreads();
    {
        float o0 = 0.f, o1 = 0.f;
#pragma unroll
        for (int q = 0; q < 4; ++q) { o0 += op[(w * 4 + q) * 128 + lane]; o1 += op[(w * 4 + q) * 128 + 64 + lane]; }
        const float rs = __builtin_amdgcn_rsqf(wave_sum(o0 * o0 + o1 * o1) * (1.0f / 128.0f) + 1e-6f);
        yout[(size_t)w * D + lane] = (bf16)f2bf(o0 * rs * gn[lane] * fsilu(gg[w * 128 + lane]));
        yout[(size_t)w * D + 64 + lane] = (bf16)f2bf(o1 * rs * gn[64 + lane] * fsilu(gg[w * 128 + 64 + lane]));
    }
    __syncthreads();
}
__device__ __forceinline__ void hgrn_sample_unit(int j  , const bf16* P, const float* state_s, float* out_s, const float* gnorm, bf16* YM, const LAS float* lbv, LAS unsigned char* lds, int tid) {
    const int b = j >> 2, h = j & 3, row0 = MP + b * 8;
    LAS float* dk = (LAS float*)lds; LAS float* kk = dk + 1024; LAS float* qq = kk + 1024; LAS float* vv = qq + 1024; LAS float* gg = vv + 1024;
    float S[32]; sample_state_load(state_s + (size_t)j * 16384, S, tid);
#pragma unroll
    for (int q = 0; q < 2; ++q) {
        const int e = tid + 512 * q, t = e >> 7, k = e & 127; const size_t ro = (size_t)(row0 + t) * PLD + h * 128 + k;
        const float fb = bf2f(P[ro + 2048]), ib = bf2f(P[ro + 2560]), qb = bf2f(P[ro + 1536]), gb = bf2f(P[ro + 3072]); const float lb = lbv[h * 128 + k];
        const float f = lb + (1.f - lb) * fsig(fb);
        dk[e] = f; kk[e] = 1.f - f; qq[e] = fsilu(qb); vv[e] = ib; gg[e] = gb;
    }
    __syncthreads();
    sample_rec_core(S, out_s + (size_t)j * 16384, gnorm + h * 128, YM + (size_t)row0 * D + 512 + h * 128, lds, tid);
}
__device__ __forceinline__ void ret_sample_unit(int j, const bf16* P, const float* state_s, float* out_s, const float* gnorm, bf16* YM, const LAS float* invf, LAS unsigned char* lds, int tid) {
    const int b = j >> 2, h = j & 3, row0 = MP + b * 8;
    LAS float* dk = (LAS float*)lds; LAS float* kk = dk + 1024; LAS float* qq = kk + 1024; LAS float* vv = qq + 1024; LAS float* gg = vv + 1024;
    const float gam = 1.0f - __builtin_amdgcn_exp2f(-5.0f - (float)h);
    float S[32]; sample_state_load(state_s + (size_t)j * 16384, S, tid);
    {
        const int t = tid >> 6, i = tid & 63; const size_t ro = (size_t)(row0 + t) * PLD + h * 128 + i;
        float c, s; rope_cs(16384 + t, invf[i], c, s);
        const float q1 = bf2f(P[ro]), q2 = bf2f(P[ro + 64]), k1 = bf2f(P[ro + 512]), k2 = bf2f(P[ro + 512 + 64]);
        qq[t * 128 + i] = q1 * c - q2 * s; qq[t * 128 + 64 + i] = q1 * s + q2 * c;
        kk[t * 128 + i] = (k1 * c - k2 * s) * 0.08838834764831845f; kk[t * 128 + 64 + i] = (k1 * s + k2 * c) * 0.08838834764831845f;
        dk[t * 128 + i] = gam; dk[t * 128 + 64 + i] = gam;
        vv[t * 128 + i] = bf2f(P[ro + 1024]); vv[t * 128 + 64 + i] = bf2f(P[ro + 1024 + 64]);
        gg[t * 128 + i] = bf2f(P[ro + 1536]); gg[t * 128 + 64 + i] = bf2f(P[ro + 1536 + 64]);
    }
    __syncthreads();
    sample_rec_core(S, out_s + (size_t)j * 16384, gnorm + h * 128, YM + (size_t)row0 * D + h * 128, lds, tid);
}

template <bool HGRN> __device__ __forceinline__ void chunk_scan(const bf16* DS, bf16* SB, const float* DEC, float* out_p, int gtid, int gthreads) {
    for (int e4 = gtid; e4 < 32 * 4096; e4 += gthreads) {
        const int bh = e4 >> 12, kv4 = e4 & 4095, k = kv4 >> 5, vp = (kv4 & 31) * 4;
        float gC = 0.f; if (!HGRN) gC = __builtin_amdgcn_exp2f(ret_lg2(bh & 3) * 64.0f);
        const bf16* p0 = DS + (size_t)(bh * 32) * 16384 + kv4 * 4; bf16* p1 = SB + (size_t)(bh * 32) * 16384 + kv4 * 4;
        f32x4 S = (f32x4){0.f, 0.f, 0.f, 0.f};
#pragma unroll 1
        for (int c0 = 0; c0 < 32; c0 += 16) {
            u32x2v tv[16]; float dv[16];
#pragma unroll
            for (int c = 0; c < 16; ++c) { tv[c] = *(const u32x2v*)(p0 + (size_t)(c0 + c) * 16384); dv[c] = HGRN ? DEC[(bh * 32 + c0 + c) * 128 + k] : gC; }
#pragma unroll
            for (int c = 0; c < 16; ++c) {
                u32x2v o; o.x = pg8::cvt_pk_bf16(S[0], S[1]); o.y = pg8::cvt_pk_bf16(S[2], S[3]);
                *(u32x2v*)(p1 + (size_t)(c0 + c) * 16384) = o;
                const f32x4 t = {__uint_as_float(tv[c].x << 16), __uint_as_float(tv[c].x & 0xffff0000u), __uint_as_float(tv[c].y << 16), __uint_as_float(tv[c].y & 0xffff0000u)};
                S = S * dv[c] + t;
            }
        }
        *(f32x4*)(out_p + (size_t)bh * 16384 + k * 128 + 16 * ((vp >> 2) & 7) + 4 * (vp >> 5)) = S;
    }
}

__device__ __forceinline__ void conv_phase(const bf16* P, const float* cw, const float* sconv, bf16* YM, float* conv_p, float* conv_s, int gtid, int gthreads) {
    for (int it = gtid; it < (MT / 4) * 64; it += gthreads) {
        const int row0 = (it >> 6) * 4, c = (it & 63) * 8;
        int t0, T, b; if (row0 < MP) { b = row0 >> 11; t0 = row0 & 2047; T = 2048; } else { const int r2 = row0 - MP; b = r2 >> 3; t0 = r2 & 7; T = 8; }
        const bool first = (t0 == 0);
        const bf16* pr = P + (size_t)row0 * PLD + c;
        u32x4v va[6], ca[6], ba[4];
#pragma unroll
        for (int q = 0; q < 6; ++q) { const int dq = (first && q < 2) ? 2 : q;
            va[q] = *(const u32x4v*)(pr + (long)(dq - 2) * PLD); ca[q] = *(const u32x4v*)(pr + (long)(dq - 2) * PLD + 1024); }
#pragma unroll
        for (int r = 0; r < 4; ++r) ba[r] = *(const u32x4v*)(pr + (long)r * PLD + 512);
        f32x4 w0[2], w1[2], w2[2];
#pragma unroll
        for (int h = 0; h < 2; ++h) { w0[h] = *(const f32x4*)(cw + c + 4 * h); w1[h] = *(const f32x4*)(cw + 512 + c + 4 * h); w2[h] = *(const f32x4*)(cw + 1024 + c + 4 * h); }
        f32x4 s0[2], s1[2];
#pragma unroll
        for (int h = 0; h < 2; ++h) { s0[h] = (f32x4){0.f, 0.f, 0.f, 0.f}; s1[h] = s0[h]; }
        if (first && row0 >= MP) {
#pragma unroll
            for (int h = 0; h < 2; ++h) { s0[h] = *(const f32x4*)(sconv + (b * 2 + 0) * 512 + c + 4 * h); s1[h] = *(const f32x4*)(sconv + (b * 2 + 1) * 512 + c + 4 * h); } }
        float u[6][8];
#pragma unroll
        for (int q = 0; q < 6; ++q) { float fa[8], fc[8]; unpack8(va[q], fa); unpack8(ca[q], fc);
#pragma unroll
            for (int j = 0; j < 8; ++j) u[q][j] = fc[j] * fa[j]; }
        if (first) {
#pragma unroll
            for (int j = 0; j < 8; ++j) { u[0][j] = s0[j >> 2][j & 3]; u[1][j] = s1[j >> 2][j & 3]; } }
#pragma unroll
        for (int r = 0; r < 4; ++r) {
            float fb[8], y[8]; unpack8(ba[r], fb);
#pragma unroll
            for (int j = 0; j < 8; ++j) y[j] = fb[j] * (w0[j >> 2][j & 3] * u[r][j] + w1[j >> 2][j & 3] * u[r + 1][j] + w2[j >> 2][j & 3] * u[r + 2][j]);
            u32x4v o; o.x = pk2(y[0], y[1]); o.y = pk2(y[2], y[3]); o.z = pk2(y[4], y[5]); o.w = pk2(y[6], y[7]);
            *(u32x4v*)(YM + (size_t)(row0 + r) * D + c) = o;
        }
        if (t0 + 4 == T) {
#pragma unroll
            for (int i = 0; i < 2; ++i) { float* op = ((row0 < MP) ? conv_p : conv_s) + (b * 2 + i) * 512 + c;
                *(f32x4*)op = (f32x4){u[4 + i][0], u[4 + i][1], u[4 + i][2], u[4 + i][3]}; *(f32x4*)(op + 4) = (f32x4){u[4 + i][4], u[4 + i][5], u[4 + i][6], u[4 + i][7]}; }
        }
    }
}

__device__ __forceinline__ float pd_mix(const bf16* P, int row, int t, int b, bool sample, int col  , const float* mu, const float* sshift) {
    const float cur = bf2f(P[(size_t)row * PLD + 2048 + col]);
    const float prev = (t > 0) ? bf2f(P[(size_t)(row - 1) * PLD + 2048 + col]) : (sample ? sshift[b * 1792 + col] : 0.f);
    return cur + mu[col] * (prev - cur);
}
__device__ __forceinline__ float ftanh(float x) { return 1.0f - 2.0f * __builtin_amdgcn_rcpf(1.0f + __builtin_amdgcn_exp2f(2.885390081777927f * x)); }
__device__ __forceinline__ void lora_prep_phase(const bf16* P, const float* mu, const float* sshift, bf16* AP, float* shift_p, float* shift_s, int gtid, int gthreads) {
    for (int it = gtid; it < (MT / 4) * 32; it += gthreads) {
        const int row0 = (it >> 5) * 4, j0 = (it & 31) * 8;
        int t0, b; bool sample; if (row0 < MP) { b = row0 >> 11; t0 = row0 & 2047; sample = false; } else { const int r2 = row0 - MP; b = r2 >> 3; t0 = r2 & 7; sample = true; }
        const bf16* pr = P + (size_t)row0 * PLD + 2048 + 1536 + j0;
        u32x4v rv[5];
#pragma unroll
        for (int q = 0; q < 5; ++q) { const int dq = (t0 == 0 && q == 0) ? 1 : q; rv[q] = *(const u32x4v*)(pr + (long)(dq - 1) * PLD); }
        const f32x4 m0 = *(const f32x4*)(mu + 1536 + j0), m1 = *(const f32x4*)(mu + 1536 + j0 + 4);
        f32x4 h0 = (f32x4){0.f, 0.f, 0.f, 0.f}, h1 = h0;
        if (t0 == 0 && sample) { h0 = *(const f32x4*)(sshift + b * 1792 + 1536 + j0); h1 = *(const f32x4*)(sshift + b * 1792 + 1536 + j0 + 4); }
        float prv[8];
        if (t0 == 0) {
#pragma unroll
            for (int j = 0; j < 8; ++j) prv[j] = (j < 4) ? h0[j & 3] : h1[j & 3];
        } else unpack8(rv[0], prv);
#pragma unroll
        for (int r = 0; r < 4; ++r) {
            float cur[8], y[8]; unpack8(rv[r + 1], cur);
#pragma unroll
            for (int j = 0; j < 8; ++j) { const float x = cur[j] + ((j < 4) ? m0[j & 3] : m1[j & 3]) * (prv[j] - cur[j]); y[j] = (j0 < 64) ? ftanh(x) : (j0 < 128) ? x : fsig(x); prv[j] = cur[j]; }
            u32x4v o; o.x = pk2(y[0], y[1]); o.y = pk2(y[2], y[3]); o.z = pk2(y[4], y[5]); o.w = pk2(y[6], y[7]);
            *(u32x4v*)(AP + (size_t)(row0 + r) * 256 + j0) = o;
        }
    }
    for (int e = gtid; e < (8 + 128) * 1792; e += gthreads) {
        const int bb = e / 1792, col = e % 1792;
        if (bb < 8) shift_p[e] = bf2f(P[(size_t)(bb * 2048 + 2047) * PLD + 2048 + col]);
        else shift_s[(bb - 8) * 1792 + col] = bf2f(P[(size_t)(MP + (bb - 8) * 8 + 7) * PLD + 2048 + col]);
    }
}

typedef float f32x2 __attribute__((ext_vector_type(2)));
struct RwkvPar { float w0, a0, k_k, k_a, r_k, lng, lnb; };
struct RwkvRaw { float r, kd, vd, lw, la, gt; };
__device__ __forceinline__ RwkvRaw rwkv_load_raw(const bf16* P, const bf16* LB, const float* mu, const float* sshift, int row, int t, int b, bool sample, int hc) {
    RwkvRaw x;
    x.r = pd_mix(P, row, t, b, sample, hc, mu, sshift);
    x.kd = pd_mix(P, row, t, b, sample, 512 + hc, mu, sshift);
    x.vd = pd_mix(P, row, t, b, sample, 1024 + hc, mu, sshift);
    x.lw = bf2f(LB[(size_t)row * 1536 + hc]); x.la = bf2f(LB[(size_t)row * 1536 + 512 + hc]); x.gt = bf2f(LB[(size_t)row * 1536 + 1024 + hc]);
    return x;
}
__device__ __forceinline__ RwkvPar rwkv_params(ArgsP a, int hc) {
    RwkvPar p; p.w0 = a->in[I_W0][hc]; p.a0 = a->in[I_A0][hc]; p.k_k = a->in[I_KK][hc]; p.k_a = a->in[I_KA][hc]; p.r_k = a->in[I_RK][hc]; p.lng = a->in[I_LNG][hc]; p.lnb = a->in[I_LNB][hc]; return p;
}

constexpr int NRCP = 8192, NRC = 9216;
constexpr int REC_BYTES = 18432, REC_Q1T = 0, REC_Q2T = 2176, REC_GT = 2944, REC_HT = 11648, REC_VT = 14720, REC_GC = 17792;
__device__ __forceinline__ void rwkv_r1_unit4(int cu4, ArgsP a, const bf16* P, const bf16* LB, unsigned char* RREC, float* RGB, LAS unsigned char* lds, int tid) {
    constexpr int RL = 68;
    const int lane = tid & 63, g4 = __builtin_amdgcn_readfirstlane(tid >> 7), wl = __builtin_amdgcn_readfirstlane((tid >> 6) & 1), tg = tid & 127;
    const int cu = cu4 * 4 + g4;
    const bool sample = cu >= NRCP;
    int b, h, row0, t0, ntok;
    if (!sample) { const int bh = cu >> 7, c = cu & 127; b = bh >> 3; h = bh & 7; row0 = b * 2048 + c * 16; t0 = c * 16; ntok = 16; }
    else { const int bh = cu - NRCP; b = bh >> 3; h = bh & 7; row0 = MP + b * 8; t0 = 0; ntok = 8; }
    const int hc = h * 64 + lane;
    LAS float* base = (LAS float*)(lds + g4 * 34816);
    LAS float* Rr = base; LAS float* Kk = Rr + 16 * RL; LAS float* Aa = Kk + 16 * RL; LAS float* Bb = Aa + 16 * RL;
    LAS float* Ww = Bb + 16 * RL;
    LAS float* MAT = Ww;
    LAS float* TT = MAT + 1024;
    LAS float* P2 = TT + 256;
    LAS float* P1 = P2 + 256;
    LAS float* GC = P1 + 1088;
    LAS float* Vv = GC + 64;
    unsigned char* rec = RREC + (size_t)cu * REC_BYTES;
    bf16* q1t = (bf16*)(rec + REC_Q1T); bf16* q2t = (bf16*)(rec + REC_Q2T); bf16* gt = (bf16*)(rec + REC_GT); bf16* ht = (bf16*)(rec + REC_HT); bf16* vt = (bf16*)(rec + REC_VT);
    {
        const int tt = lane >> 3, c0 = 8 * (lane & 7), hc0 = h * 64 + c0, tl = wl * 8 + tt;
        const bool live = tl < ntok;
        const int row = row0 + (live ? tl : 0), t = t0 + (live ? tl : 0);
        const bf16* pr = P + (size_t)row * PLD + 2048 + hc0; const bf16* lr = LB + (size_t)row * 1536 + hc0;
        const bool hasprev = t > 0;
        const bf16* pp = hasprev ? pr - PLD : pr;
        u32x4v cw[3], pw[3], lw_[3];
#pragma unroll
        for (int g = 0; g < 3; ++g) { cw[g] = *(const u32x4v*)(pr + 512 * g); pw[g] = *(const u32x4v*)(pp + 512 * g); lw_[g] = *(const u32x4v*)(lr + 512 * g); }
        const float* mu = a->in[I_MU];
        f32x4 mv[3][2], sh[3][2];
#pragma unroll
        for (int g = 0; g < 3; ++g)
#pragma unroll
            for (int hq = 0; hq < 2; ++hq) { mv[g][hq] = *(const f32x4*)(mu + 512 * g + hc0 + 4 * hq); sh[g][hq] = (f32x4){0.f, 0.f, 0.f, 0.f}; }
        if (!hasprev && sample) {
#pragma unroll
            for (int g = 0; g < 3; ++g)
#pragma unroll
                for (int hq = 0; hq < 2; ++hq) sh[g][hq] = *(const f32x4*)(a->in[I_SSHIFT] + (size_t)b * 1792 + 512 * g + hc0 + 4 * hq);
        }
        f32x4 pw0[2], pa0[2], pkk[2], pka[2], prk[2];
#pragma unroll
        for (int hq = 0; hq < 2; ++hq) { pw0[hq] = *(const f32x4*)(a->in[I_W0] + hc0 + 4 * hq); pa0[hq] = *(const f32x4*)(a->in[I_A0] + hc0 + 4 * hq); pkk[hq] = *(const f32x4*)(a->in[I_KK] + hc0 + 4 * hq);
            pka[hq] = *(const f32x4*)(a->in[I_KA] + hc0 + 4 * hq); prk[hq] = *(const f32x4*)(a->in[I_RK] + hc0 + 4 * hq); }
        float xr[8], xk[8], xv[8], xlw[8], xla[8], xgt[8];
        {
            float cur[8], prv[8];
#pragma unroll
            for (int g = 0; g < 3; ++g) {
                unpack8(cw[g], cur); unpack8(pw[g], prv);
#pragma unroll
                for (int j = 0; j < 8; ++j) { const float pv = hasprev ? prv[j] : sh[g][j >> 2][j & 3]; const float m = mv[g][j >> 2][j & 3]; const float y = cur[j] + m * (pv - cur[j]);
                    if (g == 0) xr[j] = y; else if (g == 1) xk[j] = y; else xv[j] = y; }
            }
            unpack8(lw_[0], xlw); unpack8(lw_[1], xla); unpack8(lw_[2], xgt);
        }
        float wd[8], km[8], av_[8], bv_[8], kkr[8], asg[8];
        float n2 = 0.f, cf = 0.f;
#pragma unroll
        for (int j = 0; j < 8; ++j) {
            const float z = -(pw0[j >> 2][j & 3] + xlw[j]);
            const float sp = (z > 20.f) ? z : flog(1.f + fexp(z));
            wd[j] = fexp(-fexp(-sp - 0.5f));
            asg[j] = fsig(pa0[j >> 2][j & 3] + xla[j]);
            kkr[j] = xk[j] * pkk[j >> 2][j & 3]; n2 += kkr[j] * kkr[j];
            km[j] = xk[j] * (1.f + (asg[j] - 1.f) * pka[j >> 2][j & 3]);
            cf += xr[j] * km[j] * prk[j >> 2][j & 3];
        }
        n2 += dpp_f<0xB1>(n2); n2 += dpp_f<0x4E>(n2); n2 += dpp_f<0x141>(n2);
        cf += dpp_f<0xB1>(cf); cf += dpp_f<0x4E>(cf); cf += dpp_f<0x141>(cf);
        const float inrm = 1.0f / fmaxf(sqrtf(n2), 1e-12f);
#pragma unroll
        for (int j = 0; j < 8; ++j) { const float kk = kkr[j] * inrm; av_[j] = -kk; bv_[j] = kk * asg[j]; }
        if (live) {
            u32x4v g0, g1;
            g0.x = pk2(xgt[0], cf * xv[0]); g0.y = pk2(xgt[1], cf * xv[1]); g0.z = pk2(xgt[2], cf * xv[2]); g0.w = pk2(xgt[3], cf * xv[3]);
            g1.x = pk2(xgt[4], cf * xv[4]); g1.y = pk2(xgt[5], cf * xv[5]); g1.z = pk2(xgt[6], cf * xv[6]); g1.w = pk2(xgt[7], cf * xv[7]);
            unsigned* gp = (unsigned*)RGB + ((size_t)cu * 16 + tl) * 64 + c0;
            *(u32x4v*)gp = g0; *(u32x4v*)(gp + 4) = g1;
        } else {
#pragma unroll
            for (int j = 0; j < 8; ++j) { xr[j] = 0.f; wd[j] = 1.f; km[j] = 0.f; xv[j] = 0.f; av_[j] = 0.f; bv_[j] = 0.f; }
        }
#pragma unroll
        for (int hq = 0; hq < 2; ++hq) {
            *(LAS f32x4*)(Rr + tl * RL + c0 + 4 * hq) = (f32x4){xr[4 * hq], xr[4 * hq + 1], xr[4 * hq + 2], xr[4 * hq + 3]};
            *(LAS f32x4*)(Ww + tl * 64 + c0 + 4 * hq) = (f32x4){wd[4 * hq], wd[4 * hq + 1], wd[4 * hq + 2], wd[4 * hq + 3]};
            *(LAS f32x4*)(Kk + tl * RL + c0 + 4 * hq) = (f32x4){km[4 * hq], km[4 * hq + 1], km[4 * hq + 2], km[4 * hq + 3]};
            *(LAS f32x4*)(Aa + tl * RL + c0 + 4 * hq) = (f32x4){av_[4 * hq], av_[4 * hq + 1], av_[4 * hq + 2], av_[4 * hq + 3]};
            *(LAS f32x4*)(Bb + tl * RL + c0 + 4 * hq) = (f32x4){bv_[4 * hq], bv_[4 * hq + 1], bv_[4 * hq + 2], bv_[4 * hq + 3]};
            *(LAS f32x4*)(Vv + tl * 64 + c0 + 4 * hq) = (f32x4){xv[4 * hq], xv[4 * hq + 1], xv[4 * hq + 2], xv[4 * hq + 3]};
        }
    }
    __syncthreads();
    if (tg < 64) {
        const int k = tg; float g = 1.f;
#pragma unroll
        for (int t = 0; t < 16; ++t) {
            const float gp = g; g *= Ww[t * 64 + k]; const float inv = 1.0f / g;
            Aa[t * RL + k] *= gp; Bb[t * RL + k] *= inv; Kk[t * RL + k] *= inv; Rr[t * RL + k] *= g;
        }
        GC[k] = g; ((float*)(rec + REC_GC))[k] = g;
    }
    __syncthreads();
    const int ij = lane & 15, kq = lane >> 4;
    {
        f32x4 cm[2];
#pragma unroll
        for (int mm = 0; mm < 2; ++mm) {
            const int m = 2 * wl + mm;
            const LAS float* X = ((m & 1) ? Kk : Bb) + ij * RL; const LAS float* Y = ((m & 2) ? Rr : Aa) + ij * RL;
            f32x4 cacc = (f32x4){0.f, 0.f, 0.f, 0.f};
#pragma unroll
            for (int s_ = 0; s_ < 16; ++s_) cacc = __builtin_amdgcn_mfma_f32_16x16x4f32(X[4 * s_ + kq], Y[4 * s_ + kq], cacc, 0, 0, 0);
            cm[mm] = cacc;
        }
#pragma unroll
        for (int mm = 0; mm < 2; ++mm) { const int m = 2 * wl + mm;
#pragma unroll
            for (int r = 0; r < 4; ++r) { const int i = 4 * kq + r, t = ij; const bool keep = (m & 2) ? (i <= t) : (i < t); MAT[m * 256 + i * 16 + t] = keep ? cm[mm][r] : 0.f; } }
    }
    __syncthreads();
    if (tg < 16) {
        const int i = tg; float x[16];
#pragma unroll
        for (int t = 0; t < 16; ++t) {
            float acc = (i == t) ? 1.f : 0.f;
#pragma unroll
            for (int j = 0; j < 16; ++j) if (j < t) acc += x[j] * MAT[j * 16 + t];
            x[t] = acc;
        }
#pragma unroll
        for (int t = 0; t < 16; ++t) TT[i * 16 + t] = x[t];
    }
    __syncthreads();
    {
#pragma unroll
        for (int q = 0; q < 2; ++q) {
            const int k0 = 16 * (2 * wl + q); f32x4 cacc = (f32x4){0.f, 0.f, 0.f, 0.f};
#pragma unroll
            for (int s_ = 0; s_ < 4; ++s_) { const int j = 4 * s_ + kq; cacc = __builtin_amdgcn_mfma_f32_16x16x4f32(Aa[j * RL + k0 + ij], TT[j * 16 + ij], cacc, 0, 0, 0); }
#pragma unroll
            for (int r = 0; r < 4; ++r) P1[(k0 + 4 * kq + r) * 17 + ij] = cacc[r];
        }
        if (wl == 0) {
            f32x4 cacc = (f32x4){0.f, 0.f, 0.f, 0.f};
#pragma unroll
            for (int s_ = 0; s_ < 4; ++s_) { const int j = 4 * s_ + kq; cacc = __builtin_amdgcn_mfma_f32_16x16x4f32(MAT[256 + ij * 16 + j], TT[j * 16 + ij], cacc, 0, 0, 0); }
#pragma unroll
            for (int r = 0; r < 4; ++r) P2[(4 * kq + r) * 16 + ij] = cacc[r];
        }
    }
    __syncthreads();
    {
#pragma unroll
        for (int q = 0; q < 2; ++q) {
            const int k0 = 16 * (2 * wl + q);
            f32x4 cacc; { const f32x4 r4 = *(const LAS f32x4*)(Rr + ij * RL + k0 + 4 * kq); cacc = r4; }
#pragma unroll
            for (int s_ = 0; s_ < 4; ++s_) { const int j = 4 * s_ + kq; cacc = __builtin_amdgcn_mfma_f32_16x16x4f32(P1[(k0 + ij) * 17 + j], MAT[512 + j * 16 + ij], cacc, 0, 0, 0); }
            u32x2v w; w.x = pk2(cacc[0], cacc[1]); w.y = pk2(cacc[2], cacc[3]);
            *(u32x2v*)(q1t + ij * 68 + k0 + 4 * kq) = w;
        }
        if (wl == 1) {
            f32x4 cacc;
#pragma unroll
            for (int r = 0; r < 4; ++r) cacc[r] = MAT[768 + (4 * kq + r) * 16 + ij];
#pragma unroll
            for (int s_ = 0; s_ < 4; ++s_) { const int j = 4 * s_ + kq; cacc = __builtin_amdgcn_mfma_f32_16x16x4f32(P2[ij * 16 + j], MAT[512 + j * 16 + ij], cacc, 0, 0, 0); }
            u32x2v w; w.x = pk2(cacc[0], cacc[1]); w.y = pk2(cacc[2], cacc[3]);
            *(u32x2v*)(q2t + ij * 24 + 4 * kq) = w;
        }
#pragma unroll
        for (int q = 0; q < 2; ++q) {
            const int k0 = 16 * (2 * wl + q); f32x4 cacc;
#pragma unroll
            for (int r = 0; r < 4; ++r) cacc[r] = Kk[(4 * kq + r) * RL + k0 + ij];
#pragma unroll
            for (int s_ = 0; s_ < 4; ++s_) { const int j = 4 * s_ + kq; cacc = __builtin_amdgcn_mfma_f32_16x16x4f32(P2[ij * 16 + j], Bb[j * RL + k0 + ij], cacc, 0, 0, 0); }
            const float gcv = GC[k0 + ij];
            u32x2v w; w.x = pk2(cacc[0] * gcv, cacc[1] * gcv); w.y = pk2(cacc[2] * gcv, cacc[3] * gcv);
            *(u32x2v*)(ht + (k0 + ij) * 24 + 4 * kq) = w;
        }
        { const int v = tg >> 1, hf = tg & 1; u32x4v o; o.x = pk2(Vv[(8 * hf + 0) * 64 + v], Vv[(8 * hf + 1) * 64 + v]); o.y = pk2(Vv[(8 * hf + 2) * 64 + v], Vv[(8 * hf + 3) * 64 + v]);
          o.z = pk2(Vv[(8 * hf + 4) * 64 + v], Vv[(8 * hf + 5) * 64 + v]); o.w = pk2(Vv[(8 * hf + 6) * 64 + v], Vv[(8 * hf + 7) * 64 + v]); *(u32x4v*)(vt + v * 24 + 8 * hf) = o; }
#pragma unroll
        for (int q = 0; q < 2; ++q) {
            const int kk0 = 16 * (2 * wl + q);
            float pa[4];
#pragma unroll
            for (int s_ = 0; s_ < 4; ++s_) pa[s_] = P1[(kk0 + ij) * 17 + 4 * s_ + kq];
#pragma unroll
            for (int kt = 0; kt < 4; ++kt) {
                const int k0 = 16 * kt; f32x4 cacc = (f32x4){0.f, 0.f, 0.f, 0.f};
#pragma unroll
                for (int s_ = 0; s_ < 4; ++s_) { const int j = 4 * s_ + kq; cacc = __builtin_amdgcn_mfma_f32_16x16x4f32(pa[s_], Bb[j * RL + k0 + ij], cacc, 0, 0, 0); }
                const float gcv = GC[k0 + ij];
                u32x2v w; w.x = pk2(cacc[0] * gcv, cacc[1] * gcv); w.y = pk2(cacc[2] * gcv, cacc[3] * gcv);
                *(u32x2v*)(gt + (k0 + ij) * 68 + kk0 + 4 * kq) = w;
            }
        }
    }
    __syncthreads();
}
struct R2Frags { bf16x8 q1[2][2], q2, g[2][2][2], hq[2], v; };
__device__ __forceinline__ void rwkv_r2_load(R2Frags& F, const LAS unsigned char* rec, int vt, int r32, int hh) {
    F.v = *(const LAS bf16x8*)(rec + REC_VT + (32 * vt + r32) * 48 + 16 * hh);
    const int cr = r32 & 15;
#pragma unroll
    for (int kt = 0; kt < 2; ++kt)
#pragma unroll
        for (int sp = 0; sp < 2; ++sp) {
            const LAS unsigned char* p = rec + REC_Q1T + cr * 136 + (32 * kt + 16 * sp + 4 * hh) * 2;
            const s16x4 lo = *(const LAS s16x4*)p, hi = *(const LAS s16x4*)(p + 16);
            F.q1[kt][sp] = (bf16x8){lo[0], lo[1], lo[2], lo[3], hi[0], hi[1], hi[2], hi[3]};
        }
    F.q2 = *(const LAS bf16x8*)(rec + REC_Q2T + cr * 48 + 16 * hh);
#pragma unroll
    for (int kp = 0; kp < 2; ++kp) {
#pragma unroll
        for (int kt = 0; kt < 2; ++kt)
#pragma unroll
            for (int sp = 0; sp < 2; ++sp) {
                const LAS unsigned char* p = rec + REC_GT + (32 * kp + r32) * 136 + (32 * kt + 16 * sp + 4 * hh) * 2;
                const s16x4 lo = *(const LAS s16x4*)p, hi = *(const LAS s16x4*)(p + 16);
                F.g[kp][kt][sp] = (bf16x8){lo[0], lo[1], lo[2], lo[3], hi[0], hi[1], hi[2], hi[3]};
            }
        F.hq[kp] = *(const LAS bf16x8*)(rec + REC_HT + (32 * kp + r32) * 48 + 16 * hh);
    }
}
__device__ __forceinline__ void rwkv_r2_issue(const R2Frags& F, const LAS unsigned char* rec, int hh, f32x16 (&Sacc)[2], f32x16& O) {
    const LAS float* gcp = (const LAS float*)(rec + REC_GC);
    bf16x8 Sb[2][2];
#pragma unroll
    for (int kt = 0; kt < 2; ++kt)
#pragma unroll
        for (int sp = 0; sp < 2; ++sp) {
            u32x4v pw; pw.x = pg8::cvt_pk_bf16(Sacc[kt][8 * sp + 0], Sacc[kt][8 * sp + 1]); pw.y = pg8::cvt_pk_bf16(Sacc[kt][8 * sp + 2], Sacc[kt][8 * sp + 3]);
            pw.z = pg8::cvt_pk_bf16(Sacc[kt][8 * sp + 4], Sacc[kt][8 * sp + 5]); pw.w = pg8::cvt_pk_bf16(Sacc[kt][8 * sp + 6], Sacc[kt][8 * sp + 7]);
            Sb[kt][sp] = __builtin_bit_cast(bf16x8, pw);
        }
#pragma unroll
    for (int kt = 0; kt < 2; ++kt)
#pragma unroll
        for (int g = 0; g < 4; ++g) { const f32x4 g4 = *(const LAS f32x4*)(gcp + 32 * kt + 8 * g + 4 * hh); Sacc[kt][4 * g + 0] *= g4.x; Sacc[kt][4 * g + 1] *= g4.y; Sacc[kt][4 * g + 2] *= g4.z; Sacc[kt][4 * g + 3] *= g4.w; }
#pragma unroll
    for (int r = 0; r < 16; ++r) O[r] = 0.f;
#pragma unroll
    for (int kt = 0; kt < 2; ++kt)
#pragma unroll
        for (int sp = 0; sp < 2; ++sp) {
            O = __builtin_amdgcn_mfma_f32_32x32x16_bf16(F.q1[kt][sp], Sb[kt][sp], O, 0, 0, 0);
            Sacc[0] = __builtin_amdgcn_mfma_f32_32x32x16_bf16(F.g[0][kt][sp], Sb[kt][sp], Sacc[0], 0, 0, 0);
            Sacc[1] = __builtin_amdgcn_mfma_f32_32x32x16_bf16(F.g[1][kt][sp], Sb[kt][sp], Sacc[1], 0, 0, 0);
        }
    O = __builtin_amdgcn_mfma_f32_32x32x16_bf16(F.q2, F.v, O, 0, 0, 0);
    Sacc[0] = __builtin_amdgcn_mfma_f32_32x32x16_bf16(F.hq[0], F.v, Sacc[0], 0, 0, 0);
    Sacc[1] = __builtin_amdgcn_mfma_f32_32x32x16_bf16(F.hq[1], F.v, Sacc[1], 0, 0, 0);
}
__device__ __forceinline__ void rwkv_r2_store(const f32x16& O, LAS float* ob, int vt, int r32, int hh) {
#pragma unroll
    for (int r = 0; r < 8; ++r) ob[((r & 3) + 8 * (r >> 2) + 4 * hh) * 64 + 32 * vt + r32] = O[r];
}
__device__ __forceinline__ void rwkv_r2_step(const LAS unsigned char* rec, f32x16 (&Sacc)[2], LAS float* ob, int vt, int r32, int hh) {
    R2Frags F; f32x16 O; rwkv_r2_load(F, rec, vt, r32, hh); rwkv_r2_issue(F, rec, hh, Sacc, O); rwkv_r2_store(O, ob, vt, r32, hh);
}
__device__ __forceinline__ void rwkv_r2_post(const LAS float* ob, const float* gbp, const RwkvPar& pr, bf16* YM, int row, int hc, int lane) {
    const unsigned gbw = ((const unsigned*)gbp)[lane]; const float gt = __uint_as_float(gbw << 16), bon = __uint_as_float(gbw & 0xffff0000u);
    const float o = ob[lane];
    const float mean = wave_sum(o) * (1.0f / 64.0f); const float dlt = o - mean;
    const float var = wave_sum(dlt * dlt) * (1.0f / 64.0f);
    const float on = dlt * __builtin_amdgcn_rsqf(var + 64e-5f) * pr.lng + pr.lnb;
    YM[(size_t)row * D + 512 + hc] = (bf16)f2bf((on + bon) * gt);
}
__device__ __forceinline__ float xchg32(float send, bool hi) { unsigned a_ = __float_as_uint(send), b_ = a_; asm volatile("" : "+v"(b_)); auto rr = __builtin_amdgcn_permlane32_swap(a_, b_, false, false); return __uint_as_float(hi ? rr[0] : rr[1]); }
__device__ __forceinline__ float xchg16(float send, bool hi) { unsigned a_ = __float_as_uint(send), b_ = a_; asm volatile("" : "+v"(b_)); auto rr = __builtin_amdgcn_permlane16_swap(a_, b_, false, false); return __uint_as_float(hi ? rr[0] : rr[1]); }
__device__ __forceinline__ float reduce8(const float (&v)[8], int lane) {
    float v4[4], v2[2];
    const bool h32 = lane & 32, h16 = lane & 16, h8 = lane & 8;
#pragma unroll
    for (int i = 0; i < 4; ++i) { const float send = h32 ? v[i] : v[i + 4], keep = h32 ? v[i + 4] : v[i]; v4[i] = keep + xchg32(send, h32); }
#pragma unroll
    for (int i = 0; i < 2; ++i) { const float send = h16 ? v4[i] : v4[i + 2], keep = h16 ? v4[i + 2] : v4[i]; v2[i] = keep + xchg16(send, h16); }
    const float send = h8 ? v2[0] : v2[1], keep = h8 ? v2[1] : v2[0];
    float r = keep + dpp_f<0x128>(send);
    r += dpp_f<0xB1>(r); r += dpp_f<0x4E>(r); r += dpp_f<0x141>(r);
    return r;
}
#define R2_BAR() asm volatile("s_waitcnt lgkmcnt(0)\n\ts_barrier" ::: "memory")
template <bool DO_POST = true> __device__ __forceinline__ void rwkv_r2_prompt(int b, int h, ArgsP a, const unsigned char* RREC, const float* RGB, bf16* YM, LAS unsigned char* lds, int tid) {
    const int lane = tid & 63, wave = __builtin_amdgcn_readfirstlane(tid >> 6), r32 = lane & 31, hh = lane >> 5;
    const int cu0 = (b * 8 + h) * 128, hc = h * 64 + lane;
    LAS unsigned char* recb = lds;
    LAS float* obuf = (LAS float*)(lds + 7 * REC_BYTES);
    const RwkvPar pr = rwkv_params(a, hc);
    f32x16 Sacc[2];
#pragma unroll
    for (int kt = 0; kt < 2; ++kt)
#pragma unroll
        for (int r = 0; r < 16; ++r) Sacc[kt][r] = 0.f;
    for (int i = tid; i < 6 * REC_BYTES / 16; i += NTHR) *(LAS u32x4v*)(recb + i * 16) = *(const u32x4v*)(RREC + (size_t)cu0 * REC_BYTES + i * 16);
    LAS unsigned* gbuf = (LAS unsigned*)(lds + PRM_OFF);
    for (int i = tid; i < 3 * 4096 / 16; i += NTHR) *(LAS u32x4v*)((LAS unsigned char*)gbuf + i * 16) = *(const u32x4v*)((const unsigned char*)RGB + (size_t)cu0 * 4096 + i * 16);
    __syncthreads();
    if (wave < 2) {
        R2Frags F0, F1;
        rwkv_r2_load(F0, recb, wave, r32, hh);
#define R2_SCAN(c, FC, FN) do { \
            f32x16 O_; rwkv_r2_issue(FC, recb + ((c) % 7) * REC_BYTES, hh, Sacc, O_); \
            asm volatile("" ::: "memory");        \
            if ((c) + 1 < 128) rwkv_r2_load(FN, recb + (((c) + 1) % 7) * REC_BYTES, wave, r32, hh);         \
            rwkv_r2_store(O_, obuf + ((c) & 1) * 1024, wave, r32, hh); \
            R2_BAR(); \
        } while (0)
#pragma unroll 1
        for (int c = 0; c < 128; c += 2) { R2_SCAN(c, F0, F1); R2_SCAN(c + 1, F1, F0); }
#undef R2_SCAN
    } else if (wave < 6) {
        R2_BAR();
#pragma unroll 1
        for (int c = 1; c < 128; ++c) {
            if (DO_POST) {
                const LAS float* ob = obuf + ((c & 1) ^ 1) * 1024; const LAS unsigned* gb = gbuf + ((c - 1) % 5) * 1024;
                float o[4]; unsigned gw[4]; float part[8];
#pragma unroll
                for (int tt = 0; tt < 4; ++tt) { const int tl = (wave - 2) * 4 + tt; o[tt] = ob[tl * 64 + lane]; gw[tt] = gb[tl * 64 + lane]; part[2 * tt] = o[tt]; part[2 * tt + 1] = o[tt] * o[tt]; }
                const int red = __builtin_bit_cast(int, reduce8(part, lane));
#pragma unroll
                for (int tt = 0; tt < 4; ++tt) {
                    const int tl = (wave - 2) * 4 + tt;
                    const int i1 = 2 * tt, i2 = 2 * tt + 1;
                    const float s1 = __builtin_bit_cast(float, __builtin_amdgcn_readlane(red, ((i1 & 4) ? 32 : 0) + ((i1 & 2) ? 16 : 0) + ((i1 & 1) ? 8 : 0)));
                    const float s2 = __builtin_bit_cast(float, __builtin_amdgcn_readlane(red, ((i2 & 4) ? 32 : 0) + ((i2 & 2) ? 16 : 0) + ((i2 & 1) ? 8 : 0)));
                    const float mean = s1 * (1.0f / 64.0f), var = fmaxf(s2 * (1.0f / 64.0f) - mean * mean, 0.f);
                    const float on = (o[tt] - mean) * __builtin_amdgcn_rsqf(var + 64e-5f) * pr.lng + pr.lnb;
                    YM[(size_t)(b * 2048 + (c - 1) * 16 + tl) * D + 512 + hc] = (bf16)f2bf((on + __uint_as_float(gw[tt] & 0xffff0000u)) * __uint_as_float(gw[tt] << 16));
                }
            }
            R2_BAR();
        }
    } else {
        const int lw = wave - 6;
#pragma unroll 1
        for (int c = 0; c < 128; ++c) {
            if (c + 3 < 128) {
                const unsigned char* src = (const unsigned char*)RGB + (size_t)(cu0 + c + 3) * 4096 + lw * 2048 + lane * 16;
                LAS unsigned char* dst = (LAS unsigned char*)gbuf + ((c + 3) % 5) * 4096 + lw * 2048;
#pragma unroll
                for (int q = 0; q < 2; ++q) __builtin_amdgcn_global_load_lds((const unsigned*)(src + q * 1024), (LAS unsigned*)(dst + q * 1024), 16, 0, 0);
            }
            if (c + 6 < 128) {
                const unsigned char* src = RREC + (size_t)(cu0 + c + 6) * REC_BYTES + lw * 9216 + lane * 16;
                LAS unsigned char* dst = recb + ((c + 6) % 7) * REC_BYTES + lw * 9216;
#pragma unroll
                for (int q = 0; q < 9; ++q) __builtin_amdgcn_global_load_lds((const unsigned*)(src + q * 1024), (LAS unsigned*)(dst + q * 1024), 16, 0, 0);
                asm volatile("s_waitcnt vmcnt(42)" ::: "memory");
            } else asm volatile("s_waitcnt vmcnt(0)" ::: "memory");
            R2_BAR();
        }
    }
    __syncthreads();
#pragma unroll
    for (int tt = 0; tt < 2; ++tt) { const int tl = wave * 2 + tt; if (DO_POST) rwkv_r2_post(obuf + 1024 + tl * 64, RGB + ((size_t)(cu0 + 127) * 16 + tl) * 64, pr, YM, b * 2048 + 127 * 16 + tl, hc, lane); }
    if (wave < 2) {
        float* sp = a->out + O_RWKVP + (((size_t)b * 8 + h) * 64 + 32 * wave + r32) * 64;
#pragma unroll
        for (int kt = 0; kt < 2; ++kt)
#pragma unroll
            for (int g = 0; g < 4; ++g) *(f32x4*)(sp + 32 * kt + 8 * g + 4 * hh) = (f32x4){Sacc[kt][4 * g], Sacc[kt][4 * g + 1], Sacc[kt][4 * g + 2], Sacc[kt][4 * g + 3]};
    }
    __syncthreads();
}
__device__ __forceinline__ void rwkv_r2_sample(int b, int h, ArgsP a, const unsigned char* RREC, const float* RGB, bf16* YM, LAS unsigned char* lds, int tid) {
    const int lane = tid & 63, wave = __builtin_amdgcn_readfirstlane(tid >> 6), r32 = lane & 31, hh = lane >> 5;
    const int cu = NRCP + b * 8 + h, hc = h * 64 + lane;
    LAS unsigned char* recb = lds; LAS float* obuf = (LAS float*)(lds + REC_BYTES);
    for (int i = tid; i < REC_BYTES / 16; i += NTHR) *(LAS u32x4v*)(recb + i * 16) = *(const u32x4v*)(RREC + (size_t)cu * REC_BYTES + i * 16);
    f32x16 Sacc[2];
    if (wave < 2) {
        const float* sp = a->in[I_SRWKV] + (((size_t)b * 8 + h) * 64 + 32 * wave + r32) * 64;
#pragma unroll
        for (int kt = 0; kt < 2; ++kt)
#pragma unroll
            for (int g = 0; g < 4; ++g) { const f32x4 x = *(const f32x4*)(sp + 32 * kt + 8 * g + 4 * hh); Sacc[kt][4 * g] = x.x; Sacc[kt][4 * g + 1] = x.y; Sacc[kt][4 * g + 2] = x.z; Sacc[kt][4 * g + 3] = x.w; }
    }
    __syncthreads();
    if (wave < 2) {
        rwkv_r2_step(recb, Sacc, obuf, wave, r32, hh);
        float* sp = a->out + O_RWKVS + (((size_t)b * 8 + h) * 64 + 32 * wave + r32) * 64;
#pragma unroll
        for (int kt = 0; kt < 2; ++kt)
#pragma unroll
            for (int g = 0; g < 4; ++g) *(f32x4*)(sp + 32 * kt + 8 * g + 4 * hh) = (f32x4){Sacc[kt][4 * g], Sacc[kt][4 * g + 1], Sacc[kt][4 * g + 2], Sacc[kt][4 * g + 3]};
    }
    __syncthreads();
    { const RwkvPar pr = rwkv_params(a, hc); rwkv_r2_post(obuf + wave * 64, RGB + ((size_t)cu * 16 + wave) * 64, pr, YM, MP + b * 8 + wave, hc, lane); }
    __syncthreads();
}

template <int S> __device__ __forceinline__ void tail_combine(int mode, const bf16* slab, bf16* xb, pg8::ssq_t* ssq_out, float scale, bf16* O, int ldc, const pg8::ssq_t* ssq_in,
                                             int bxl, int Gl, int tid) {
    const int lane = tid & 63, w = tid >> 6, ai = w >> 2, m = w & 3, fr = lane & 15, fq = lane >> 4;
    for (int task = bxl; task < 128; task += Gl) {
        const int tile = task >> 3, wid = task & 7, pm = tile >> 2, pn = tile & 3, wr = wid >> 2, wc = wid & 3;
        f32x4 v[2][2];
#pragma unroll
        for (int bj = 0; bj < 2; ++bj)
#pragma unroll
            for (int n = 0; n < 2; ++n) v[bj][n] = (f32x4){0.f, 0.f, 0.f, 0.f};
        u32x2v ld[S][2][2];
#pragma unroll
        for (int ks = 0; ks < S; ++ks) {
            const bf16* sp = slab + ((size_t)(tile * S + ks) * 8 + wid) * (32 * 64 * 4) + lane * 4;
#pragma unroll
            for (int bj = 0; bj < 2; ++bj)
#pragma unroll
                for (int n = 0; n < 2; ++n) ld[ks][bj][n] = *(const u32x2v*)(sp + (((ai * 2 + bj) * 4 + m) * 2 + n) * 256);
        }
#pragma unroll
        for (int ks = 0; ks < S; ++ks)
#pragma unroll
            for (int bj = 0; bj < 2; ++bj)
#pragma unroll
                for (int n = 0; n < 2; ++n) { const u32x2v q = ld[ks][bj][n];
                    v[bj][n] += (f32x4){__uint_as_float(q.x << 16), __uint_as_float(q.x & 0xffff0000u), __uint_as_float(q.y << 16), __uint_as_float(q.y & 0xffff0000u)}; }
        const int rl = pm * 256 + ai * 128 + wr * 64 + m * 16 + fr, row = MP + rl;
        const int col0 = pn * 256 + wc * 32 + 4 * fq;
        if (mode == pg8::EM_RESID) {
            float s = 0.f; u32x2v xiv[2][2];
#pragma unroll
            for (int bj = 0; bj < 2; ++bj)
#pragma unroll
                for (int n = 0; n < 2; ++n) xiv[bj][n] = *(const u32x2v*)(xb + (size_t)row * D + col0 + bj * 128 + n * 16);
#pragma unroll
            for (int bj = 0; bj < 2; ++bj)
#pragma unroll
                for (int n = 0; n < 2; ++n) {
                    const int c = col0 + bj * 128 + n * 16;
                    const u32x2v q = xiv[bj][n];
                    const f32x4 xi = {__uint_as_float(q.x << 16), __uint_as_float(q.x & 0xffff0000u), __uint_as_float(q.y << 16), __uint_as_float(q.y & 0xffff0000u)};
                    const f32x4 y = xi + v[bj][n] * scale;
                    s += (y[0] * y[0] + y[1] * y[1]) + (y[2] * y[2] + y[3] * y[3]);
                    u32x2v wv; wv.x = pg8::cvt_pk_bf16(y[0], y[1]); wv.y = pg8::cvt_pk_bf16(y[2], y[3]);
                    *(u32x2v*)(xb + (size_t)row * D + c) = wv;
                }
            s += __shfl_xor(s, 16); s += __shfl_xor(s, 32);
            if (fq == 0) __hip_atomic_fetch_add(ssq_out + row, pg8::ssq_fix(s), __ATOMIC_RELAXED, __HIP_MEMORY_SCOPE_AGENT);
        } else {
            const float rs = __builtin_amdgcn_rsqf(pg8::ssq_val(ssq_in[row]) * (1.0f / 1024.0f) + 1e-6f);
#pragma unroll
            for (int bj = 0; bj < 2; ++bj)
#pragma unroll
                for (int n = 0; n < 2; ++n) {
                    const int c = col0 + bj * 128 + n * 16; const f32x4 y = v[bj][n] * rs;
                    u32x2v wv; wv.x = pg8::cvt_pk_bf16(y[0], y[1]); wv.y = pg8::cvt_pk_bf16(y[2], y[3]);
                    *(u32x2v*)(O + (size_t)row * ldc + c) = wv;
                }
        }
    }
}

template <int NB> __device__ __forceinline__ void attn_stage_tile(const bf16* src, int src_pitch, LAS unsigned char* lds, int tid) {
#pragma unroll 1
    for (int i0 = 0; i0 < 16; i0 += NB) {
        u32x4v v[NB];
#pragma unroll
        for (int i = 0; i < NB; ++i) { const int p = tid + 512 * (i0 + i), row = p >> 5, c16 = p & 31; v[i] = *(const u32x4v*)(src + (size_t)row * src_pitch + c16 * 8); }
#pragma unroll
        for (int i = 0; i < NB; ++i) { const int p = tid + 512 * (i0 + i), row = p >> 5, c16 = p & 31; *(LAS u32x4v*)(lds + row * 528 + c16 * 16) = v[i]; }
    }
}
__device__ __forceinline__ void attn_prompt_unit(int l, int b, int h, int qt, const bf16* Q, const bf16* KBp, const bf16* VTp, bf16* O, LAS unsigned char* lds, int tid) {
    const int lane = tid & 63, w = tid >> 6, r32 = lane & 31, hh = lane >> 5;
    const int row0 = b * 2048 + qt * 256 + w * 32;
    const bf16* qp = Q + (size_t)(row0 + r32) * D + h * 256 + 8 * hh;
    bf16x8 qa = *(const bf16x8*)(qp), qb = *(const bf16x8*)(qp + 16), qc = *(const bf16x8*)(qp + 32), qd = *(const bf16x8*)(qp + 48);
    attn_stage_tile<16>(KBp + ((size_t)l * 2048 + b * 256) * D + h * 256, D, lds, tid);
    __syncthreads();
    f32x16 S[8];
#pragma unroll
    for (int mt = 0; mt < 8; ++mt)
#pragma unroll
        for (int r = 0; r < 16; ++r) S[mt][r] = 0.f;
    const LAS unsigned char* kl0 = lds + r32 * 528 + 16 * hh; const LAS unsigned char* kl1 = kl0 + 4 * 32 * 528;
#pragma unroll 1
    for (int s2 = 0; s2 < 8; ++s2) {
        const int sn = (s2 < 6) ? s2 + 2 : 7;
        const bf16x8 qna = *(const bf16x8*)(qp + 32 * sn), qnb = *(const bf16x8*)(qp + 32 * sn + 16);
#pragma unroll
        for (int mt = 0; mt < 4; ++mt) {
            const bf16x8 kf0 = *(const LAS bf16x8*)(kl0 + mt * 32 * 528 + 64 * s2), kf1 = *(const LAS bf16x8*)(kl1 + mt * 32 * 528 + 64 * s2);
            S[mt] = __builtin_amdgcn_mfma_f32_32x32x16_bf16(kf0, qa, S[mt], 0, 0, 0);
            S[mt + 4] = __builtin_amdgcn_mfma_f32_32x32x16_bf16(kf1, qa, S[mt + 4], 0, 0, 0);
        }
#pragma unroll
        for (int mt = 0; mt < 4; ++mt) {
            const bf16x8 kf0 = *(const LAS bf16x8*)(kl0 + mt * 32 * 528 + 64 * s2 + 32), kf1 = *(const LAS bf16x8*)(kl1 + mt * 32 * 528 + 64 * s2 + 32);
            S[mt] = __builtin_amdgcn_mfma_f32_32x32x16_bf16(kf0, qb, S[mt], 0, 0, 0);
            S[mt + 4] = __builtin_amdgcn_mfma_f32_32x32x16_bf16(kf1, qb, S[mt + 4], 0, 0, 0);
        }
        qa = qc; qb = qd; qc = qna; qd = qnb;
    }
    __syncthreads();
    float mx = -3.0e38f;
#pragma unroll
    for (int mt = 0; mt < 8; ++mt)
#pragma unroll
        for (int r = 0; r < 16; ++r) mx = fmaxf(mx, S[mt][r]);
    mx = fmaxf(mx, __shfl_xor(mx, 32));
    const float c2 = 0.0625f * 1.4426950408889634f;
    float lsum = 0.f;
    bf16x8 pf[8][2];
#pragma unroll
    for (int mt = 0; mt < 8; ++mt) {
#pragma unroll
        for (int r = 0; r < 16; ++r) { const float p = __builtin_amdgcn_exp2f((S[mt][r] - mx) * c2); S[mt][r] = p; lsum += p; }
#pragma unroll
        for (int sp = 0; sp < 2; ++sp) {
            u32x4v pw; pw.x = pg8::cvt_pk_bf16(S[mt][8 * sp + 0], S[mt][8 * sp + 1]); pw.y = pg8::cvt_pk_bf16(S[mt][8 * sp + 2], S[mt][8 * sp + 3]);
            pw.z = pg8::cvt_pk_bf16(S[mt][8 * sp + 4], S[mt][8 * sp + 5]); pw.w = pg8::cvt_pk_bf16(S[mt][8 * sp + 6], S[mt][8 * sp + 7]);
            pf[mt][sp] = __builtin_bit_cast(bf16x8, pw);
        }
    }
    lsum += __shfl_xor(lsum, 32);
    const float il = 1.0f / lsum;
    attn_stage_tile<8>(VTp + (((size_t)l * 8 + b) * 4 + h) * 65536, 256, lds, tid);
    __syncthreads();
    const LAS unsigned char* vl = lds + r32 * 528 + 8 * hh;
    bf16* op = O + (size_t)(row0 + r32) * D + h * 256 + 4 * hh;
#pragma unroll 1
    for (int dg = 0; dg < 2; ++dg) {
        f32x16 acc[4];
#pragma unroll
        for (int q = 0; q < 4; ++q)
#pragma unroll
            for (int r = 0; r < 16; ++r) acc[q][r] = 0.f;
        const LAS unsigned char* vb = vl + dg * 4 * 32 * 528;
#pragma unroll
        for (int mt = 0; mt < 8; ++mt) {
#pragma unroll
            for (int sp = 0; sp < 2; ++sp) {
                const int m0 = mt * 32 + 16 * sp;
#pragma unroll
                for (int q = 0; q < 4; ++q) {
                    const LAS unsigned char* vq = vb + q * 32 * 528 + m0 * 2;
                    const s16x4 lo = *(const LAS s16x4*)vq, hi = *(const LAS s16x4*)(vq + 16);
                    const bf16x8 vf = (bf16x8){lo[0], lo[1], lo[2], lo[3], hi[0], hi[1], hi[2], hi[3]};
                    acc[q] = __builtin_amdgcn_mfma_f32_32x32x16_bf16(vf, pf[mt][sp], acc[q], 0, 0, 0);
                }
            }
            asm volatile("" ::: "memory");
        }
#pragma unroll
        for (int q = 0; q < 4; ++q)
#pragma unroll
            for (int g = 0; g < 4; ++g) {
                u32x2v wv; wv.x = pg8::cvt_pk_bf16(acc[q][4 * g] * il, acc[q][4 * g + 1] * il); wv.y = pg8::cvt_pk_bf16(acc[q][4 * g + 2] * il, acc[q][4 * g + 3] * il);
                *(u32x2v*)(op + (dg * 4 + q) * 32 + 8 * g) = wv;
            }
    }
    __syncthreads();
}
__device__ __forceinline__ void attn_sample_unit(int l, int b, int h, const bf16* Q, const float* CK, const float* CV, bf16* O, LAS unsigned char* lds, int tid) {
    const int lane = tid & 63, w = tid >> 6;
    LAS float* red = (LAS float*)lds;
    LAS float* ml = red + 16384;
    float qv[8][4];
#pragma unroll
    for (int t = 0; t < 8; ++t) { const u32x2v qq = *(const u32x2v*)(Q + (size_t)(MP + b * 8 + t) * D + h * 256 + 4 * lane);
        qv[t][0] = __uint_as_float(qq.x << 16); qv[t][1] = __uint_as_float(qq.x & 0xffff0000u); qv[t][2] = __uint_as_float(qq.y << 16); qv[t][3] = __uint_as_float(qq.y & 0xffff0000u); }
    const size_t base = (((size_t)l * 128 + b) * 256 + w * 32) * D + h * 256 + 4 * lane;
    const float* kbase = CK + base; const float* vbase = CV + base;
    float sc[32];
    f32x4 vr[16];
#pragma unroll
    for (int bt = 0; bt < 4; ++bt) {
        f32x4 kr[8];
#pragma unroll
        for (int i = 0; i < 8; ++i) kr[i] = *(const f32x4*)(kbase + (size_t)(bt * 8 + i) * D);
        if (bt < 2) {
#pragma unroll
            for (int i = 0; i < 8; ++i) vr[bt * 8 + i] = *(const f32x4*)(vbase + (size_t)(bt * 8 + i) * D);
        }
#pragma unroll
        for (int i = 0; i < 8; ++i) {
            float part[8];
#pragma unroll
            for (int t = 0; t < 8; ++t) part[t] = (qv[t][0] * kr[i].x + qv[t][1] * kr[i].y) + (qv[t][2] * kr[i].z + qv[t][3] * kr[i].w);
            sc[bt * 8 + i] = reduce8(part, lane) * 0.0625f;
        }
    }
    f32x4 vr2[16];
#pragma unroll
    for (int i = 0; i < 16; ++i) vr2[i] = *(const f32x4*)(vbase + (size_t)(16 + i) * D);
    float mx = sc[0];
#pragma unroll
    for (int i = 1; i < 32; ++i) mx = fmaxf(mx, sc[i]);
    float lsum = 0.f;
#pragma unroll
    for (int i = 0; i < 32; ++i) { sc[i] = fexp(sc[i] - mx); lsum += sc[i]; }
    f32x4 acc[8];
#pragma unroll
    for (int t = 0; t < 8; ++t) acc[t] = (f32x4){0.f, 0.f, 0.f, 0.f};
#pragma unroll
    for (int i = 0; i < 32; ++i) {
        const f32x4 vrow = (i < 16) ? vr[i & 15] : vr2[i & 15];
#pragma unroll
        for (int t = 0; t < 8; ++t) {
            const int src = ((t & 4) ? 32 : 0) + ((t & 2) ? 16 : 0) + ((t & 1) ? 8 : 0);
            const float p = __builtin_bit_cast(float, __builtin_amdgcn_readlane(__builtin_bit_cast(int, sc[i]), src));
            acc[t] += vrow * p;
        }
    }
#pragma unroll
    for (int t = 0; t < 8; ++t) *(LAS f32x4*)(red + (w * 8 + t) * 256 + 4 * lane) = acc[t];
    if ((lane & 7) == 0) { const int t = ((lane >> 5) & 1) * 4 + ((lane >> 4) & 1) * 2 + ((lane >> 3) & 1); ml[w * 16 + t] = mx; ml[w * 16 + 8 + t] = lsum; }
    __syncthreads();
    {
        const int t = w; float M = -3.0e38f;
#pragma unroll
        for (int ww = 0; ww < 8; ++ww) M = fmaxf(M, ml[ww * 16 + t]);
        float L = 0.f; f32x4 s = (f32x4){0.f, 0.f, 0.f, 0.f};
#pragma unroll
        for (int ww = 0; ww < 8; ++ww) { const float f = fexp(ml[ww * 16 + t] - M); L += ml[ww * 16 + 8 + t] * f; s += *(const LAS f32x4*)(red + (ww * 8 + t) * 256 + 4 * lane) * f; }
        const float il = 1.0f / L;
        u32x2v o; o.x = pk2(s.x * il, s.y * il); o.y = pk2(s.z * il, s.w * il);
        *(u32x2v*)(O + (size_t)(MP + b * 8 + t) * D + h * 256 + 4 * lane) = o;
    }
    __syncthreads();
}


constexpr int REP_R2B = 0, REP_CONV = 1, REP_O1 = 1, REP_BAR = 0, REP_RESID_K = -1, REP_ATTS = 1, REP_R1 = 1, REP_R2 = 1, REP_O3A = 1, REP_O3B = 1, REP_O3 = 1, REP_EVEN = 1, REP_ATT = 1, REP_PRO = 1, REP_GEMM_K = -1  ;
__global__ void __launch_bounds__(NTHR, 2) hybrid_fwd(Args a_unused) {
#define KA (kargs())
    extern __shared__ __attribute__((aligned(16))) unsigned char lds_raw[];
    LAS unsigned char* lds = (LAS unsigned char*)lds_raw;
    volatile LAS unsigned* MISC = (volatile LAS unsigned*)(lds + MISC_OFF);
    LAS float* prm = (LAS float*)(lds + PRM_OFF);
    const int wave0 = __builtin_amdgcn_readfirstlane((int)threadIdx.x >> 6);
#define tid0 (wave0 * 64 + lane_id_v())
    const int G = gridDim.x, bx = blockIdx.x;
    const int vcu = (G % 8 == 0) ? (bx % 8) * (G / 8) + bx / 8 : bx;

#define WSP (KA->ws)
#define SSQ ((pg8::ssq_t*)(KA->ws + WS_CTL + CTL_SSQ_OFF))
#define SSQM ((const float*)(KA->ws + WS_CTL + CTL_SSQM_OFF))
    unsigned* ctl = (unsigned*)(KA->ws + WS_CTL);
#define B_XB ((bf16*)(KA->ws + WS_XB))
#define B_HB ((bf16*)(KA->ws + WS_HB))
#define B_PB ((bf16*)(KA->ws + WS_PB))
#define B_YM ((bf16*)(KA->ws + WS_YM))
#define B_QB ((bf16*)(KA->ws + WS_QB))
#define B_OB ((bf16*)(KA->ws + WS_OB))
#define B_DS ((bf16*)(KA->ws + WS_DS))
#define B_SB ((bf16*)(KA->ws + WS_DS + 32 * MiB))
#define B_DEC ((float*)(KA->ws + WS_DEC))
#define B_LB ((bf16*)(KA->ws + WS_LB))
#define B_AP ((bf16*)(KA->ws + WS_AP))
#define B_KB ((bf16*)(KA->ws + WS_KB))
#define B_VT ((bf16*)(KA->ws + WS_VT))

    for (int u = tid0; u < (LDS_BYTES - LDSCTL_OFF) / 4; u += NTHR) ((LAS unsigned*)(lds + LDSCTL_OFF))[u] = 0u;
    __syncthreads();
    XcdBarrier bar = xcd_barrier_post(ctl + CW_BAR, MISC + 8); bar.w0 = wave0;
#define GRID_BAR() xcd_barrier(bar)

    for (int rep = 0; rep < REP_PRO; ++rep) { p0_prologue(KA, lds, vcu, G, tid0); __syncthreads(); }
    __syncthreads();
    GRID_BAR();
    for (int r9 = 0; r9 < REP_BAR; ++r9) GRID_BAR();

#define NEW_E() pg8::EpiAny E; E.p0 = nullptr; E.p1 = nullptr; E.p2 = nullptr; E.p3 = nullptr; E.ldc = 0; E.scale = 0.f; E.mode = 0
#define RUN_GEMM(Aptr, Btptr, Mv, Nv, Kv, LDv, Sv, Gv, Cv) do { pg8::Gemm g_{(const pg8::bf16_t*)(Aptr), (const pg8::bf16_t*)(Btptr), (Mv), (Nv), (Kv), (LDv)}; pg8::StaticOrder S_; S_.init((Mv), (Nv), (Gv), (Cv), (Sv)); \
        pg8::gemm_phase<pg8::EpiAny, pg8::StaticOrder, true, true>(lds, g_, S_, E, wave0); } while (0)

#pragma unroll 1
    for (int step = 1; step < 19; ++step) {
        const int l = (step - 1) / 9, k = (step == 0) ? -1 : (step - 1) % 9;
        pg8::ssq_t* ssq_l = SSQ + (size_t)(4 * l) * MT;
        int bxl = bx, Gl = G; asm volatile("" : "+s"(bxl), "+s"(Gl));
#define tid tid0
#define gtid (bxl * NTHR + tid0)
        if (k == 3) {
            if (l == 0) {
                if (tid < 512) { const float* hl = KA->in[I_HLB]; prm[tid] = 1.0f / (1.0f + fexp(hl[512 + tid] - hl[tid])); }
                __syncthreads();
                for (int rep = 0; rep < REP_EVEN; ++rep)
                for (int cid = bxl; cid < NCHP; cid += Gl) hgrn_a64(cid, B_PB, B_DS, B_DEC, prm, lds, tid);
                for (int j = bxl; j < NCHS; j += Gl) hgrn_sample_unit(j, B_PB, KA->in[I_SHGRN], KA->out + O_HGRNS, KA->in[I_HGN], B_YM, prm, lds, tid);
                for (int r4 = 0; r4 < REP_CONV; ++r4) conv_phase(B_PB, KA->in[I_CONVW], KA->in[I_SCONV], B_YM, KA->out + O_CONVP, KA->out + O_CONVS, gtid, (Gl * NTHR));
                GRID_BAR();
                chunk_scan<true>(B_DS, B_SB, B_DEC, KA->out + O_HGRNP, gtid, (Gl * NTHR));
                GRID_BAR();
                for (int rep = 0; rep < REP_EVEN; ++rep)
                for (int cid = bxl; cid < NCHP; cid += Gl) hgrn_c64(cid, B_PB, B_SB, KA->in[I_HGN], B_YM, prm, lds, tid);
                GRID_BAR();
                continue;
            } else {
                if (tid < 64) prm[tid] = __builtin_amdgcn_exp2f(-(float)tid * (13.287712379549449f / 64.0f));
                __syncthreads();
                for (int r4 = 0; r4 < REP_O1; ++r4) {
                for (int cid = bxl; cid < NCHP; cid += Gl) ret_a64(cid, B_PB, B_DS, prm, lds, tid);
                for (int j = bxl; j < NCHS; j += Gl) ret_sample_unit(j, B_PB, KA->in[I_SRET], KA->out + O_RETS, KA->in[I_RGN], B_YM, prm, lds, tid);
                lora_prep_phase(B_PB, KA->in[I_MU], KA->in[I_SSHIFT], B_AP, KA->out + O_SHIFTP, KA->out + O_SHIFTS, gtid, (Gl * NTHR));
                }
                GRID_BAR();
                chunk_scan<false>(B_DS, B_SB, B_DEC, KA->out + O_RETP, gtid, (Gl * NTHR));
            }
        }
        if (k == 4 && l == 1) {
            for (int r2 = 0; r2 < REP_R1; ++r2)
            for (int cu4 = bxl; cu4 < NRC / 4; cu4 += Gl) rwkv_r1_unit4(cu4, KA, B_PB, B_LB, WSP + WS_RREC, (float*)(WSP + WS_RGB), lds, tid);
            GRID_BAR();
            for (int r2 = 0; r2 < REP_R2; ++r2)
            if (bxl < 64) rwkv_r2_prompt(bxl >> 3, bxl & 7, KA, WSP + WS_RREC, (const float*)(WSP + WS_RGB), B_YM, lds, tid);
            else {
                for (int u = bxl - 64; u < 1024; u += Gl - 64) rwkv_r2_sample(u >> 3, u & 7, KA, WSP + WS_RREC, (const float*)(WSP + WS_RGB), B_YM, lds, tid);
                for (int i = bxl - 64; i < NCHP; i += Gl - 64) ret_c64(i, B_PB, B_SB, KA->in[I_RGN], B_YM, prm, lds, tid);
            }
            GRID_BAR();
            if (REP_R2B) { if (bxl < 64) rwkv_r2_prompt<true>(bxl >> 3, bxl & 7, KA, WSP + WS_RREC, (const float*)(WSP + WS_RGB), B_YM, lds, tid); GRID_BAR(); }
        }
        if (k == 6) {
            const int ll = l;
#pragma unroll 1
            for (int ph = 0; ph < 2; ++ph) {
                if (((ph ^ (bxl >> 3)) & 1) == 0) attn_prompt_unit(ll, bxl & 7, (bxl >> 3) & 3, bxl >> 5, B_QB, B_KB, B_VT, B_OB, lds, tid);
                else for (int i = bxl; i < 512; i += Gl) attn_sample_unit(ll, i >> 2, i & 3, B_QB, KA->in[I_CMK], KA->in[I_CMV], B_OB, lds, tid);
            }
            GRID_BAR();
        }
        NEW_E();
        const void* gA; const void* gB; int gM = MT, gN = D, gK = D;
        switch (k) {
        case -1: E.mode = pg8::EM_MEMKV; E.p1 = SSQM; E.p0 = KA->out + O_MKP; E.p3 = B_KB;
            gA = WSP + WS_MEMB; gB = WSP + WS_WKV; gM = 2048; gN = 4096; break;
        case 0: case 7: E.mode = pg8::EM_SWIGLU; E.p0 = B_HB; E.ldc = FF; E.p1 = (const float*)(ssq_l + (k == 0 ? 0 : 3) * (size_t)MT);
            gA = B_XB; gB = WSP + (k == 0 ? WS_GU1 : WS_GU2) + l * SZ_GU; gN = NGU; break;
        case 1: case 8: E.mode = pg8::EM_RESID; E.scale = 0.5f; E.p0 = B_XB; E.p3 = ssq_l + (k == 1 ? 1 : 4) * (size_t)MT;
            gA = B_HB; gB = WSP + (k == 1 ? WS_DN1 : WS_DN2) + l * SZ_DN; gK = FF; break;
        case 2: E.mode = pg8::EM_SCALE; E.p0 = B_PB; E.ldc = PLD; E.p1 = (const float*)(ssq_l + 1 * (size_t)MT);
            gA = B_XB; gB = WSP + WS_WIN + l * SZ_WIN; gN = (l == 0 ? EIN : OIN); break;
        case 3: E.mode = pg8::EM_SCALE; E.p0 = B_LB; E.ldc = 1536; E.p1 = nullptr;
            gA = B_AP; gB = WSP + WS_LORA; gN = 1536; gK = 256; break;
        case 4: E.mode = pg8::EM_RESID; E.scale = 1.0f; E.p0 = B_XB; E.p3 = ssq_l + 2 * (size_t)MT;
            gA = B_YM; gB = WSP + WS_WOUT + l * SZ_SQ; break;
        case 5: E.mode = pg8::EM_SCALE; E.p0 = B_QB; E.ldc = D; E.p1 = (const float*)(ssq_l + 2 * (size_t)MT);
            gA = B_XB; gB = WSP + WS_WQ + l * SZ_SQ; break;
        default:   E.mode = pg8::EM_RESID; E.scale = 1.0f; E.p0 = B_XB; E.p3 = ssq_l + 3 * (size_t)MT;
            gA = B_OB; gB = WSP + WS_WO + l * SZ_SQ; break;
        }
#ifndef X_NO_GEMM
        const bool tail = (k == 1 || k == 8);
        const bool ride = (l == 0 && k == 4 && G == 256);
#pragma unroll 1
        for (int pass = 0; pass < ((tail || ride) ? 2 : 1); ++pass) {
            int gG = G, gC = bx, gS = 1, gLD = gK;
            if (tail && pass == 0) gM = MP;
            if (tail && pass == 1) {
                gS = 11; pg8::EpiAny E2 = E; E2.mode = pg8::EM_PARTIAL; E2.p0 = WSP + WS_SLAB; E2.ldc = gS; E = E2;
                gA = (const bf16*)gA + (size_t)MP * gK; gM = MS; gLD = gK; gK = gK / gS;
            }
            if (ride && pass == 1) {
                pg8::EpiAny E2 = E; E2.mode = pg8::EM_MEMKV; E2.p1 = SSQM; E2.p0 = KA->out + O_MKP; E2.p3 = B_KB; E = E2;
                gA = WSP + WS_MEMB; gB = WSP + WS_WKV; gM = 2048; gN = 4096; gK = D; gLD = D; gG = 128; gC = (bx >= 16 && bx < 144) ? bx - 16 : 128;
            }
            RUN_GEMM(gA, gB, gM, gN, gK, gLD, gS, gG, gC);
        }
        if (REP_GEMM_K >= 0 && k == REP_GEMM_K) { RUN_GEMM(gA, gB, gM, gN, gK, gK, 1, G, bx); }
        if (l == 0 && G == 256) {
            unsigned wm = 0u; int wb0 = 256;
            if (k == 0) { wm = WMASK_T0; wb0 = 216; } else if (k == 2) { wm = WMASK_T2; wb0 = 184; } else if (k == 4) { wm = WMASK_T4; wb0 = 144; }
            else if (k == 5) { wm = WMASK_T5; wb0 = 16; } else if (k == 6) { wm = WMASK_T6; wb0 = 16; }
            if (wm != 0u && bx >= wb0) convert_weights(KA, lds, wm, (bx - wb0) * NWAVES + (tid >> 6), (256 - wb0) * NWAVES, tid);
        }
        if (tail) {
            GRID_BAR();
            pg8::ssq_t* so = SSQ + (size_t)(4 * l) * MT + (size_t)(k == 1 ? 1 : 4) * MT;
            tail_combine<11>(pg8::EM_RESID, (const bf16*)(WSP + WS_SLAB), B_XB, so, 0.5f, nullptr, 0, nullptr, bxl, Gl, tid);
        }
#endif
        if (step == 0) continue;
        GRID_BAR();
    }
#undef tid
#undef gtid
    {
        const pg8::ssq_t* fs = SSQ + (size_t)8 * MT; const float* fg = KA->in[I_FN];
        const int tidf = tid0; const int lane = tidf & 63, wave = tidf >> 6;
        const int gw = vcu * NWAVES + wave, NGW = G * NWAVES;
        for (int m0 = gw; m0 < MT; m0 += 2 * NGW) {
            u32x2v xv[2][4]; float rs[2]; bool ok[2];
#pragma unroll
            for (int q = 0; q < 2; ++q) { const int m = m0 + q * NGW; ok[q] = m < MT; const int mm = ok[q] ? m : m0; rs[q] = pg8::ssq_val(fs[mm]);
                const u32x2v* xr = (const u32x2v*)(B_XB + (size_t)mm * D) + lane;
#pragma unroll
                for (int j = 0; j < 4; ++j) xv[q][j] = xr[64 * j]; }
            f32x4 gv[4]; const f32x4* gg = (const f32x4*)fg + lane;
#pragma unroll
            for (int j = 0; j < 4; ++j) gv[j] = gg[64 * j];
#pragma unroll
            for (int q = 0; q < 2; ++q) if (ok[q]) { const int m = m0 + q * NGW; const float r = __builtin_amdgcn_rsqf(rs[q] * (1.0f / 1024.0f) + 1e-6f);
                f32x4* yo = (f32x4*)(KA->out + O_Y + (size_t)m * D) + lane;
#pragma unroll
                for (int j = 0; j < 4; ++j) { const u32x2v qq = xv[q][j];
                    const f32x4 xi = {__uint_as_float(qq.x << 16), __uint_as_float(qq.x & 0xffff0000u), __uint_as_float(qq.y << 16), __uint_as_float(qq.y & 0xffff0000u)};
                    yo[64 * j] = xi * r * gv[j]; } }
        }
    }
}

extern "C" void kernel_launch(void* const* d_in, const int* in_sizes, int n_in, void* d_out, int out_size, void* d_ws, size_t ws_size, hipStream_t stream) {
    static int grid = 0;
    if (grid == 0) {
        if (n_in != N_IN || (size_t)out_size != O_END || ws_size < WS_END) { fprintf(stderr, "kernel_launch: unexpected shapes: n_in %d out %d ws %zu (need %zu)\n", n_in, out_size, ws_size, (size_t)WS_END); grid = -1; return; }
        int dev = 0, cus = 0, per_cu = 0;
        if (hipGetDevice(&dev) != hipSuccess || hipDeviceGetAttribute(&cus, hipDeviceAttributeMultiprocessorCount, dev) != hipSuccess) { grid = -1; return; }
        if (hipFuncSetAttribute((const void*)hybrid_fwd, hipFuncAttributeMaxDynamicSharedMemorySize, LDS_BYTES) != hipSuccess) { fprintf(stderr, "kernel_launch: hipFuncSetAttribute failed\n"); grid = -1; return; }
        if (hipOccupancyMaxActiveBlocksPerMultiprocessor(&per_cu, (const void*)hybrid_fwd, NTHR, LDS_BYTES) != hipSuccess || per_cu < 1) { fprintf(stderr, "kernel_launch: occupancy query says %d\n", per_cu); }
        (void)hipGetLastError();
        if (per_cu < 1 || cus != 256) { fprintf(stderr, "kernel_launch: %d CUs, %d workgroups per CU by the occupancy query; this kernel is built for 256 CUs x 1 resident workgroup: nothing launched\n", cus, per_cu); grid = -1; return; }
        grid = cus;
    }
    if (grid < 0) return;
    (void)hipMemsetAsync((char*)d_ws + WS_CTL, 0, CTL_ZERO_BYTES, stream);
    Args a{};
    for (int i = 0; i < N_IN; ++i) a.in[i] = (const float*)d_in[i];
    a.out = (float*)d_out; a.ws = (unsigned char*)d_ws;
    void* args[] = {&a};
    hipError_t e = hipLaunchCooperativeKernel((const void*)hybrid_fwd, dim3(grid), dim3(NTHR), args, LDS_BYTES, stream);
    if (e != hipSuccess) fprintf(stderr, "kernel_launch: cooperative launch failed: %s (grid %d)\n", hipGetErrorString(e), grid);
}
```

```cpp
#include <hip/hip_runtime.h>
#include <hip/hip_cooperative_groups.h>
#include <cstdio>
#include <cstdint>
namespace pg8 {
#define PG8_LAS __attribute__((address_space(3)))
typedef unsigned short bf16_t;
typedef short bf16x8 __attribute__((ext_vector_type(8)));
typedef float f32x4 __attribute__((ext_vector_type(4)));
typedef unsigned u32x4 __attribute__((ext_vector_type(4)));
constexpr int BM = 256, BK = 64, HALF = 128, HTB = HALF * BK * 2  , STAGE_BYTES = 8 * HTB, NXCD = 8, WGM = 8;

__host__ __device__ __forceinline__ int lds_byte(int r, int c) { const int st = (r >> 4) * 2 + (c >> 5), rr = r & 15, cc = c & 31, ob = rr * 64 + cc * 2; return st * 1024 + (ob ^ (((ob >> 9) & 1) << 5)); }
__host__ __device__ __forceinline__ void stage_rc(int b, int& R, int& C) { const int st = b / 1024, sb = b % 1024, swz = sb ^ (((sb >> 9) & 1) << 5); R = (st >> 1) * 16 + swz / 64; C = (st & 1) * 32 + (swz % 64) / 2; }
__host__ __device__ __forceinline__ int perm32(int rho) { const int n = rho >> 4, i = rho & 15; return 8 * (i >> 2) + 4 * n + (i & 3); }

struct Unit { int pm, pn, ks; };
struct Gemm { const bf16_t* A; const bf16_t* Bt; int M, N, K, ld; };

struct StaticOrder {
    int nM, nN, nwg, G, c, S;
    __host__ __device__ void init(int M, int N, int G_, int c_, int S_ = 1) { nM = M / BM; nN = N / BM; nwg = nM * nN; G = G_; c = c_; S = S_; }
    __host__ __device__ bool next(int i, Unit& u) const {
        const long L = (long)i * G + c;
        if (S > 1) { if (L >= (long)nwg * S) return false; const int r = (int)(L % nwg); u.ks = (int)(L / nwg); u.pm = r / nN; u.pn = r % nN; return true; }
        u.ks = 0;
        if (L >= nwg) return false;
        int wgid = (int)L; { const int q = nwg / NXCD, r = nwg % NXCD, xcd = wgid % NXCD, off = wgid / NXCD; wgid = (xcd < r ? xcd * (q + 1) : r * (q + 1) + (xcd - r) * q) + off; }
        const int nig = WGM * nN, gid = wgid / nig, fm = gid * WGM, gsz = (nM - fm) < WGM ? (nM - fm) : WGM;
        u.pm = fm + ((wgid % nig) % gsz); u.pn = (wgid % nig) / gsz; return true;
    }
    __device__ __forceinline__ void a_ready(const Unit&) const {}
    __device__ __forceinline__ void done(const Unit&) const {}
};

__device__ __forceinline__ unsigned cvt_pk_bf16(float lo, float hi) { unsigned r; asm volatile("v_cvt_pk_bf16_f32 %0, %1, %2" : "=v"(r) : "v"(lo), "v"(hi)); return r; }
typedef unsigned u32x2 __attribute__((ext_vector_type(2)));
__device__ __forceinline__ float fsigmoid(float x) { return __builtin_amdgcn_rcpf(1.f + __builtin_amdgcn_exp2f(-1.4426950408889634f * x)); }
__device__ __forceinline__ float fsilu(float x) { return x * fsigmoid(x); }
typedef unsigned long long ssq_t;
__device__ __forceinline__ ssq_t ssq_fix(float s) { return (ssq_t)(s * 16777216.0f); }
__device__ __forceinline__ float ssq_val(ssq_t v) { return (float)(unsigned)(v >> 32) * 256.0f + (float)(unsigned)v * (1.0f / 16777216.0f); }
enum EpiMode { EM_SWIGLU = 0, EM_SCALE = 1, EM_RESID = 2, EM_MEMKV = 3, EM_PARTIAL = 4 };
struct EpiAny {
    static constexpr bool AFTER_DRAIN = false;
    static constexpr int RED_OFF = 139264 + 1024 + 8192;
    int mode;
    __device__ __forceinline__ bool perm() const { return mode != EM_PARTIAL; }
    void* p0; const float* p1; const float* p2; void* p3; int ldc; float scale;
    __device__ __forceinline__ void operator()(const f32x4 (&acc)[2][2][4][2], const Unit& u, int wr, int wc, int fr_, int fq_) const {
        int fr = fr_, fq = fq_; asm volatile("" : "+v"(fr), "+v"(fq));
        bf16_t* const O = (bf16_t*)p0; const ssq_t* const ssq = (const ssq_t*)p1;
        bf16_t* const xb = (bf16_t*)p0; ssq_t* const ssq_out = (ssq_t*)p3;
        float* const outk = (float*)p0; float* const outv = outk + 4194304; bf16_t* const kb = (bf16_t*)p3; bf16_t* const vt = kb + 4194304;
        const int rl0 = wr * 64 + fr;
        if (mode == EM_SWIGLU) {
            typedef float f32x2e __attribute__((ext_vector_type(2)));
            const int col0 = u.pn * HALF + wc * 32 + 8 * fq;
            float rsv[8];
#pragma unroll
            for (int q = 0; q < 8; ++q) rsv[q] = ssq_val(ssq[u.pm * BM + rl0 + (q >> 2) * HALF + (q & 3) * 16]);
#pragma unroll
            for (int ai = 0; ai < 2; ++ai)
#pragma unroll
                for (int m = 0; m < 4; ++m) {
                    const int row = u.pm * BM + rl0 + ai * HALF + m * 16;
                    const float rs = __builtin_amdgcn_rsqf(rsv[ai * 4 + m] * (1.0f / 1024.0f) + 1e-6f);
                    const float c1 = -1.4426950408889634f * rs, c2 = rs * rs;
                    unsigned wq[4];
#pragma unroll
                    for (int n = 0; n < 2; ++n)
#pragma unroll
                        for (int hp = 0; hp < 2; ++hp) {
                            const f32x2e g = {acc[ai][0][m][n][2 * hp], acc[ai][0][m][n][2 * hp + 1]}, uu = {acc[ai][1][m][n][2 * hp], acc[ai][1][m][n][2 * hp + 1]};
                            const f32x2e t = g * c1; f32x2e ex; ex.x = __builtin_amdgcn_exp2f(t.x); ex.y = __builtin_amdgcn_exp2f(t.y);
                            const f32x2e d = ex + 1.0f; f32x2e r; r.x = __builtin_amdgcn_rcpf(d.x); r.y = __builtin_amdgcn_rcpf(d.y);
                            const f32x2e y = (g * uu) * (r * c2);
                            wq[2 * n + hp] = cvt_pk_bf16(y.x, y.y);
                        }
                    u32x4 w; w.x = wq[0]; w.y = wq[1]; w.z = wq[2]; w.w = wq[3];
                    *(u32x4*)(O + (size_t)row * ldc + col0) = w;
                }
        } else if (mode == EM_SCALE) {
            const int col0 = u.pn * BM + wc * 32 + 8 * fq;
            float rsv[8];
#pragma unroll
            for (int q = 0; q < 8; ++q) rsv[q] = ssq ? ssq_val(ssq[u.pm * BM + rl0 + (q >> 2) * HALF + (q & 3) * 16]) : 0.f;
#pragma unroll
            for (int ai = 0; ai < 2; ++ai)
#pragma unroll
                for (int m = 0; m < 4; ++m) {
                    const int row = u.pm * BM + rl0 + ai * HALF + m * 16;
                    const float rs = ssq ? __builtin_amdgcn_rsqf(rsv[ai * 4 + m] * (1.0f / 1024.0f) + 1e-6f) : 1.0f;
#pragma unroll
                    for (int bj = 0; bj < 2; ++bj) {
                        const f32x4 v0 = acc[ai][bj][m][0] * rs, v1 = acc[ai][bj][m][1] * rs;
                        u32x4 w; w.x = cvt_pk_bf16(v0[0], v0[1]); w.y = cvt_pk_bf16(v0[2], v0[3]); w.z = cvt_pk_bf16(v1[0], v1[1]); w.w = cvt_pk_bf16(v1[2], v1[3]);
                        *(u32x4*)(O + (size_t)row * ldc + col0 + bj * HALF) = w;
                    }
                }
        } else if (mode == EM_RESID) {
            const int col0 = u.pn * BM + wc * 32 + 8 * fq;
            bf16_t* const xrow = xb + (size_t)(u.pm * BM) * 1024;
#pragma unroll
            for (int ai = 0; ai < 2; ++ai) {
                u32x4 xr[4][2];
#pragma unroll
                for (int m = 0; m < 4; ++m)
#pragma unroll
                    for (int bj = 0; bj < 2; ++bj) xr[m][bj] = *(const u32x4*)(xrow + (size_t)(rl0 + ai * HALF + m * 16) * 1024 + col0 + bj * HALF);
#pragma unroll
                for (int m = 0; m < 4; ++m) {
                    const int rl = rl0 + ai * HALF + m * 16; const int row = u.pm * BM + rl;
                    float s = 0.f;
#pragma unroll
                    for (int bj = 0; bj < 2; ++bj) {
                        const u32x4 q = xr[m][bj];
                        const f32x4 x0 = {__uint_as_float(q.x << 16), __uint_as_float(q.x & 0xffff0000u), __uint_as_float(q.y << 16), __uint_as_float(q.y & 0xffff0000u)};
                        const f32x4 x1 = {__uint_as_float(q.z << 16), __uint_as_float(q.z & 0xffff0000u), __uint_as_float(q.w << 16), __uint_as_float(q.w & 0xffff0000u)};
                        const f32x4 v0 = x0 + acc[ai][bj][m][0] * scale, v1 = x1 + acc[ai][bj][m][1] * scale;
                        s += ((v0[0] * v0[0] + v0[1] * v0[1]) + (v0[2] * v0[2] + v0[3] * v0[3])) + ((v1[0] * v1[0] + v1[1] * v1[1]) + (v1[2] * v1[2] + v1[3] * v1[3]));
                        u32x4 w; w.x = cvt_pk_bf16(v0[0], v0[1]); w.y = cvt_pk_bf16(v0[2], v0[3]); w.z = cvt_pk_bf16(v1[0], v1[1]); w.w = cvt_pk_bf16(v1[2], v1[3]);
                        *(u32x4*)(xrow + (size_t)rl * 1024 + col0 + bj * HALF) = w;
                    }
                    s += __shfl_xor(s, 16); s += __shfl_xor(s, 32);
                    if (fq == 0) __hip_atomic_fetch_add(ssq_out + row, ssq_fix(s), __ATOMIC_RELAXED, __HIP_MEMORY_SCOPE_AGENT);
                }
            }
        } else if (mode == EM_PARTIAL) {
            bf16_t* slab = (bf16_t*)p0 + ((size_t)((u.pm * 4 + u.pn) * ldc + u.ks) * 8 + (wr * 4 + wc)) * (32 * 64 * 4) + (fq * 16 + fr) * 4;
            float one = 1.0f; asm volatile("" : "+v"(one));
#pragma unroll
            for (int ai = 0; ai < 2; ++ai)
#pragma unroll
                for (int bj = 0; bj < 2; ++bj)
#pragma unroll
                    for (int m = 0; m < 4; ++m)
#pragma unroll
                        for (int n = 0; n < 2; ++n) { const f32x4 v = acc[ai][bj][m][n] * one; u32x2 w; w.x = cvt_pk_bf16(v[0], v[1]); w.y = cvt_pk_bf16(v[2], v[3]);
                            __hip_atomic_store((unsigned long long*)(slab + (((ai * 2 + bj) * 4 + m) * 2 + n) * 256), ((unsigned long long)w.y << 32) | (unsigned long long)w.x, __ATOMIC_RELAXED, __HIP_MEMORY_SCOPE_AGENT); }
        } else {
            const int col0 = u.pn * BM + wc * 32 + 8 * fq;
            float rsv[8];
#pragma unroll
            for (int q = 0; q < 8; ++q) rsv[q] = ssq_val(ssq[u.pm * BM + rl0 + (q >> 2) * HALF + (q & 3) * 16]);
            const bool isv = ((u.pn * BM) & 2047) >= 1024;
            PG8_LAS bf16_t* const patch = (PG8_LAS bf16_t*)(size_t)(RED_OFF + (wr * 4 + wc) * 1280);
            const int lane_ = fq * 16 + fr, cidx = lane_ >> 1, half = lane_ & 1;
#pragma unroll
            for (int ai = 0; ai < 2; ++ai)
#pragma unroll
                for (int m = 0; m < 4; ++m) {
                    const int row = u.pm * BM + rl0 + ai * HALF + m * 16;
                    const float rs = __builtin_amdgcn_rsqf(rsv[ai * 4 + m] * (1.0f / 1024.0f) + 1e-6f);
#pragma unroll
                    for (int bj = 0; bj < 2; ++bj) {
                        const int cg = col0 + bj * HALF; const int l = cg >> 11, c = cg & 1023;
                        const f32x4 v0 = acc[ai][bj][m][0] * rs, v1 = acc[ai][bj][m][1] * rs;
                        float* dst = (isv ? outv : outk) + ((size_t)l * 2048 + row) * 1024 + c;
                        *(f32x4*)dst = v0; *(f32x4*)(dst + 4) = v1;
                        const unsigned q0 = cvt_pk_bf16(v0[0], v0[1]), q1 = cvt_pk_bf16(v0[2], v0[3]), q2 = cvt_pk_bf16(v1[0], v1[1]), q3 = cvt_pk_bf16(v1[2], v1[3]);
                        if (!isv) { u32x4 w; w.x = q0; w.y = q1; w.z = q2; w.w = q3; *(u32x4*)(kb + ((size_t)l * 2048 + row) * 1024 + c) = w; }
                        else {
                            PG8_LAS bf16_t* pw = patch + (8 * fq) * 20 + fr;
                            pw[0] = (bf16_t)(q0 & 0xffffu); pw[20] = (bf16_t)(q0 >> 16); pw[40] = (bf16_t)(q1 & 0xffffu); pw[60] = (bf16_t)(q1 >> 16);
                            pw[80] = (bf16_t)(q2 & 0xffffu); pw[100] = (bf16_t)(q2 >> 16); pw[120] = (bf16_t)(q3 & 0xffffu); pw[140] = (bf16_t)(q3 >> 16);
                            asm volatile("s_waitcnt lgkmcnt(0)" ::: "memory");
                            const PG8_LAS u32x2* pr = (const PG8_LAS u32x2*)(patch + cidx * 20 + 8 * half);
                            const u32x2 t0 = pr[0], t1 = pr[1];
                            asm volatile("s_waitcnt lgkmcnt(0)" ::: "memory");
                            const int R0 = u.pm * BM + wr * 64 + ai * HALF + m * 16, C0 = (u.pn * BM + wc * 32 + bj * HALF) & 1023;
                            const int rr = R0 + 8 * half, b = rr >> 8, mm = rr & 255, cc = C0 + cidx, h = cc >> 8, d = cc & 255;
                            u32x4 w; w.x = t0.x; w.y = t0.y; w.z = t1.x; w.w = t1.y;
                            *(u32x4*)(vt + ((((size_t)l * 8 + b) * 4 + h) * 256 + d) * 256 + mm) = w;
                        }
                    }
                }
        }
    }
    template <class... T> __device__ __forceinline__ void fused(T&&...) const {}
};

template <class Epi, class Sched, bool ALIGN_EPI = false, bool SP2 = false>
__device__ __forceinline__ void gemm_phase(PG8_LAS unsigned char* lds, const Gemm g, const Sched& S, const Epi& E, int wave0) {
    int tid_l = wave0 * 64 + (int)__builtin_amdgcn_mbcnt_hi(~0u, __builtin_amdgcn_mbcnt_lo(~0u, 0u)); asm volatile("" : "+v"(tid_l));
    const int tid = tid_l, wid = __builtin_amdgcn_readfirstlane(tid >> 6), lane = tid & 63, wr = wid >> 2, wc = wid & 3, fr = lane & 15, fq = lane >> 4;
    const int K = g.K, LD = g.ld, nt = K / BK;
    unsigned voffA[2], voffB[2];
#pragma unroll
    for (int i = 0; i < 2; ++i) { int R, C; stage_rc(tid * 16 + i * 8192, R, C); const int Rb = E.perm() ? ((R & ~31) + perm32(R & 31)) : R;
        voffA[i] = (unsigned)(R * LD + C) * 2u; voffB[i] = (unsigned)(Rb * LD + C) * 2u; }
    const size_t kstep = (size_t)(BK * 2);
    const size_t hstep = (size_t)HALF * LD * 2;
    const size_t tstep = 2 * hstep;
    const unsigned ldsw = (unsigned)wid * 1024u;
    const int aoff = lds_byte(wr * 64 + fr, fq * 8), boff = lds_byte(wc * 32 + fr, fq * 8);
#define PG8_SA(b, h) (((b) * 2 + (h)) * HTB)
#define PG8_SB(b, h) ((4 + (b) * 2 + (h)) * HTB)
#define PG8_STAGE(bufoff, gbase, voff) do { _Pragma("unroll") for (int _i = 0; _i < 2; ++_i) \
        __builtin_amdgcn_global_load_lds((const unsigned*)((const char*)(gbase) + (voff)[_i]), (PG8_LAS unsigned*)(lds + (bufoff) + ldsw + _i * 8192), 16, 0, 0); } while (0)
#define PG8_LDA(dst, b, h) do { _Pragma("unroll") for (int m = 0; m < 4; ++m) _Pragma("unroll") for (int k = 0; k < 2; ++k) dst[m][k] = *(const PG8_LAS bf16x8*)(lds + PG8_SA(b, h) + aoff + m * 2048 + k * 1024); } while (0)
#define PG8_LDB(dst, b, h) do { _Pragma("unroll") for (int n = 0; n < 2; ++n) _Pragma("unroll") for (int k = 0; k < 2; ++k) dst[n][k] = *(const PG8_LAS bf16x8*)(lds + PG8_SB(b, h) + boff + n * 2048 + k * 1024); } while (0)
#define PG8_MMA(ai, bj, At, Bt) do { __builtin_amdgcn_s_setprio(1); _Pragma("unroll") for (int m = 0; m < 4; ++m) _Pragma("unroll") for (int n = 0; n < 2; ++n) _Pragma("unroll") for (int k = 0; k < 2; ++k) \
        acc[ai][bj][m][n] = __builtin_amdgcn_mfma_f32_16x16x32_bf16(Bt[n][k], At[m][k], acc[ai][bj][m][n], 0, 0, 0); __builtin_amdgcn_s_setprio(0); } while (0)
#define PG8_WAIT_V(n) asm volatile("s_waitcnt vmcnt(" #n ")" ::: "memory")
#define PG8_WAIT_L(n) asm volatile("s_waitcnt lgkmcnt(" #n ")" ::: "memory")
#define PG8_BAR __builtin_amdgcn_s_barrier()
#define PG8_SCHED __builtin_amdgcn_sched_barrier(0)
    Unit cur, nxt; int ui = 0;
    if (!S.next(0, cur)) return;
    f32x4 acc[2][2][4][2];
#pragma unroll
    for (int a = 0; a < 2; ++a)
#pragma unroll
        for (int b = 0; b < 2; ++b)
#pragma unroll
            for (int m = 0; m < 4; ++m)
#pragma unroll
                for (int n = 0; n < 2; ++n) acc[a][b][m][n] = (f32x4){0.f, 0.f, 0.f, 0.f};
    bf16x8 At[4][2], B0[2][2], B1[2][2];
    const char* cA = (const char*)g.A + (size_t)cur.pm * tstep + (size_t)cur.ks * K * 2; const char* cB = (const char*)g.Bt + (size_t)cur.pn * tstep + (size_t)cur.ks * K * 2;
    S.a_ready(cur);
    if constexpr (SP2) {
        PG8_STAGE(PG8_SB(0, 0), cB, voffB); PG8_STAGE(PG8_SB(0, 1), cB + hstep, voffB); PG8_STAGE(PG8_SA(0, 0), cA, voffA); PG8_STAGE(PG8_SA(0, 1), cA + hstep, voffA);
        if (wr == 1) PG8_BAR;
        PG8_WAIT_V(2); PG8_BAR;
        PG8_STAGE(PG8_SB(1, 0), cB + kstep, voffB); PG8_STAGE(PG8_SA(1, 0), cA + kstep, voffA); PG8_STAGE(PG8_SB(1, 1), cB + hstep + kstep, voffB);
        PG8_WAIT_V(6); PG8_BAR;
    } else {
        PG8_STAGE(PG8_SB(0, 0), cB, voffB); PG8_STAGE(PG8_SA(0, 0), cA, voffA); PG8_STAGE(PG8_SB(0, 1), cB + hstep, voffB); PG8_STAGE(PG8_SA(0, 1), cA + hstep, voffA);
        if (wr == 1) PG8_BAR;
        PG8_WAIT_V(4); PG8_BAR;
        PG8_STAGE(PG8_SB(1, 0), cB + kstep, voffB); PG8_STAGE(PG8_SA(1, 0), cA + kstep, voffA); PG8_STAGE(PG8_SB(1, 1), cB + hstep + kstep, voffB);
        PG8_WAIT_V(6); PG8_BAR;
    }
    for (;;) {
        const bool has_next = S.next(ui + 1, nxt);
        const char* nA = has_next ? (const char*)g.A + (size_t)nxt.pm * tstep + (size_t)nxt.ks * K * 2 : cA; const char* nB = has_next ? (const char*)g.Bt + (size_t)nxt.pn * tstep + (size_t)nxt.ks * K * 2 : cB;
        for (int t = 0; t < nt; t += 2) {
            const bool last = (t == nt - 2);
            const char* a1 = cA + (size_t)(t + 1) * kstep;
            const char* a2 = last ? nA : cA + (size_t)(t + 2) * kstep; const char* b2 = last ? nB : cB + (size_t)(t + 2) * kstep;
            const char* a3 = a2 + kstep; const char* b3 = b2 + kstep;
            if (last && has_next) S.a_ready(nxt);
            if constexpr (SP2) {
            PG8_LDB(B0, 0, 0); PG8_LDB(B1, 0, 1); PG8_SCHED; PG8_LDA(At, 0, 0); PG8_STAGE(PG8_SA(1, 1), a1 + hstep, voffA);
            PG8_WAIT_V(8); PG8_WAIT_L(0); PG8_BAR; PG8_MMA(0, 0, At, B0); PG8_MMA(0, 1, At, B1); PG8_BAR; PG8_SCHED;
            PG8_LDA(At, 0, 1); PG8_STAGE(PG8_SB(0, 0), b2, voffB); PG8_STAGE(PG8_SB(0, 1), b2 + hstep, voffB); PG8_STAGE(PG8_SA(0, 0), a2, voffA);
            PG8_WAIT_V(8); PG8_WAIT_L(0); PG8_BAR; PG8_MMA(1, 0, At, B0); PG8_MMA(1, 1, At, B1); PG8_BAR; PG8_SCHED;
            PG8_LDB(B0, 1, 0); PG8_LDB(B1, 1, 1); PG8_SCHED; PG8_LDA(At, 1, 0); PG8_STAGE(PG8_SA(0, 1), a2 + hstep, voffA);
            PG8_WAIT_V(8); PG8_WAIT_L(0); PG8_BAR; PG8_MMA(0, 0, At, B0); PG8_MMA(0, 1, At, B1); PG8_BAR; PG8_SCHED;
            PG8_LDA(At, 1, 1); PG8_STAGE(PG8_SB(1, 0), b3, voffB); PG8_STAGE(PG8_SB(1, 1), b3 + hstep, voffB); PG8_STAGE(PG8_SA(1, 0), a3, voffA);
            PG8_WAIT_V(8); PG8_WAIT_L(0); PG8_BAR; PG8_MMA(1, 0, At, B0); PG8_MMA(1, 1, At, B1); PG8_BAR; PG8_SCHED;
            } else {
            PG8_LDB(B0, 0, 0); PG8_SCHED; PG8_LDA(At, 0, 0); PG8_STAGE(PG8_SA(1, 1), a1 + hstep, voffA);
            PG8_WAIT_L(8); PG8_BAR; PG8_WAIT_L(0); PG8_MMA(0, 0, At, B0); PG8_BAR; PG8_SCHED;
            PG8_LDB(B1, 0, 1); PG8_STAGE(PG8_SB(0, 0), b2, voffB);
            PG8_BAR; PG8_WAIT_L(0); PG8_MMA(0, 1, At, B1); PG8_BAR;
            PG8_LDA(At, 0, 1); PG8_STAGE(PG8_SA(0, 0), a2, voffA);
            PG8_BAR; PG8_WAIT_L(0); PG8_MMA(1, 0, At, B0); PG8_BAR; PG8_SCHED;
            PG8_STAGE(PG8_SB(0, 1), b2 + hstep, voffB);
            PG8_WAIT_V(6); PG8_BAR; PG8_MMA(1, 1, At, B1); PG8_BAR;
            PG8_LDB(B0, 1, 0); PG8_SCHED; PG8_LDA(At, 1, 0); PG8_STAGE(PG8_SA(0, 1), a2 + hstep, voffA);
            PG8_WAIT_L(8); PG8_BAR; PG8_WAIT_L(0); PG8_MMA(0, 0, At, B0); PG8_BAR; PG8_SCHED;
            PG8_LDB(B1, 1, 1); PG8_STAGE(PG8_SB(1, 0), b3, voffB);
            PG8_BAR; PG8_WAIT_L(0); PG8_MMA(0, 1, At, B1); PG8_BAR;
            PG8_LDA(At, 1, 1); PG8_STAGE(PG8_SA(1, 0), a3, voffA);
            PG8_BAR; PG8_WAIT_L(0); PG8_MMA(1, 0, At, B0); PG8_BAR; PG8_SCHED;
            PG8_STAGE(PG8_SB(1, 1), b3 + hstep, voffB);
            PG8_WAIT_V(6); PG8_BAR; PG8_MMA(1, 1, At, B1); PG8_BAR;
            }
        }
        if constexpr (ALIGN_EPI) { if (wr == 0) PG8_BAR; }
        if constexpr (!Epi::AFTER_DRAIN) { E(acc, cur, wr, wc, fr, fq); S.done(cur); }
        if (!has_next) break;
#pragma unroll
        for (int a = 0; a < 2; ++a)
#pragma unroll
            for (int b = 0; b < 2; ++b)
#pragma unroll
                for (int m = 0; m < 4; ++m)
#pragma unroll
                    for (int n = 0; n < 2; ++n) acc[a][b][m][n] = (f32x4){0.f, 0.f, 0.f, 0.f};
        cur = nxt; cA = nA; cB = nB; ++ui;
        if constexpr (ALIGN_EPI) { if (wr == 1) PG8_BAR; }
    }
    PG8_WAIT_V(0);
    if constexpr (!ALIGN_EPI) { if (wr == 0) PG8_BAR; }
    PG8_BAR;
    if constexpr (Epi::AFTER_DRAIN) { E.fused(acc, cur, wr, wc, fr, fq, lds, wid, lane); S.done(cur); }
#undef PG8_SA
#undef PG8_SB
#undef PG8_STAGE
#undef PG8_LDA
#undef PG8_LDB
#undef PG8_MMA
#undef PG8_WAIT_V
#undef PG8_WAIT_L
#undef PG8_BAR
#undef PG8_SCHED
}
}

namespace cg = cooperative_groups;
#define LAS __attribute__((address_space(3)))
typedef unsigned short bf16;
typedef float f32x4 __attribute__((ext_vector_type(4)));
typedef unsigned u32x4v __attribute__((ext_vector_type(4)));
typedef unsigned u32x2v __attribute__((ext_vector_type(2)));
typedef short bf16x8 __attribute__((ext_vector_type(8)));
typedef short s16x4 __attribute__((ext_vector_type(4)));
typedef float f32x16 __attribute__((ext_vector_type(16)));

constexpr int D = 1024, MP = 16384, MS = 1024, MT = 17408, FF = 2816, NGU = 5632, EIN = 3584, OIN = 3840, PLD = 3840;
constexpr int NCHP = 1024, NCHS = 512, NCH = 1536;
constexpr int NWAVES = 8, NTHR = 512;
enum { I_XP = 0, I_XS, I_SCONV, I_SHGRN, I_SRET, I_SRWKV, I_SSHIFT, I_CMK, I_CMV, I_MEM, I_F1N, I_F1GU, I_F1DN, I_MIXN, I_EWIN, I_EWOUT, I_CONVW, I_HLB, I_HGN,
       I_OWIN, I_OWOUT, I_RGN, I_MU, I_W0, I_W2, I_A0, I_A2, I_G2, I_KK, I_KA, I_RK, I_LNG, I_LNB, I_XN, I_MEMN, I_WQ, I_WKV, I_WO, I_F2N, I_F2GU, I_F2DN, I_FN, N_IN };
constexpr size_t O_Y = 0, O_CONVP = O_Y + (size_t)MT * D, O_HGRNP = O_CONVP + 8192, O_RETP = O_HGRNP + 524288, O_RWKVP = O_RETP + 524288, O_SHIFTP = O_RWKVP + 262144,
                 O_MKP = O_SHIFTP + 14336, O_MVP = O_MKP + 4194304, O_CONVS = O_MVP + 4194304, O_HGRNS = O_CONVS + 131072, O_RETS = O_HGRNS + 8388608, O_RWKVS = O_RETS + 8388608,
                 O_SHIFTS = O_RWKVS + 4194304, O_END = O_SHIFTS + 229376;
static_assert(O_END == 48879616, "output size");

constexpr size_t MiB = 1u << 20;
constexpr size_t al(size_t x) { return (x + MiB - 1) / MiB * MiB; }
constexpr size_t WS_CTL = 0, CTL_ZERO_BYTES = 2 * MiB;
constexpr size_t CTL_SSQ_OFF = 65536;
constexpr size_t CTL_SSQM_OFF = 65536 + (size_t)9 * 17408 * 8;
static_assert(CTL_SSQM_OFF + 2048 * 8 <= CTL_ZERO_BYTES, "control block");
constexpr size_t WS_GU1 = CTL_ZERO_BYTES, SZ_GU = al((size_t)NGU * D * 2);
constexpr size_t WS_DN1 = WS_GU1 + 2 * SZ_GU, SZ_DN = al((size_t)D * FF * 2);
constexpr size_t WS_WIN = WS_DN1 + 2 * SZ_DN, SZ_WIN = al((size_t)OIN * D * 2);
constexpr size_t WS_WOUT = WS_WIN + 2 * SZ_WIN, SZ_SQ = al((size_t)D * D * 2);
constexpr size_t WS_WQ = WS_WOUT + 2 * SZ_SQ;
constexpr size_t WS_WO = WS_WQ + 2 * SZ_SQ;
constexpr size_t WS_WKV = WS_WO + 2 * SZ_SQ;
constexpr size_t WS_GU2 = WS_WKV + al((size_t)4096 * D * 2);
constexpr size_t WS_DN2 = WS_GU2 + 2 * SZ_GU;
constexpr size_t WS_LORA = WS_DN2 + 2 * SZ_DN;
constexpr size_t WS_X = WS_LORA + al((size_t)1536 * 256 * 2);
constexpr size_t WS_XB = WS_X + al((size_t)MT * D * 4);
constexpr size_t WS_HB = WS_XB + al((size_t)MT * D * 2);
constexpr size_t WS_PB = WS_HB + al((size_t)MT * FF * 2);
constexpr size_t WS_YM = WS_PB + al((size_t)MT * PLD * 2);
constexpr size_t WS_QB = WS_YM + al((size_t)MT * D * 2);
constexpr size_t WS_OB = WS_QB + al((size_t)MT * D * 2);
constexpr size_t WS_DS = WS_OB + al((size_t)MT * D * 2);
constexpr size_t WS_DEC = WS_DS + al((size_t)NCHP * 16384 * 4);
constexpr size_t WS_LB = WS_DEC + al((size_t)NCHP * 128 * 4);
constexpr size_t WS_AP = WS_LB + al((size_t)MT * 1536 * 2);
constexpr size_t WS_MEMB = WS_AP + al((size_t)MT * 256 * 2);
constexpr size_t WS_KB = WS_MEMB + al((size_t)2048 * D * 2);
constexpr size_t WS_VT = WS_KB + al((size_t)2 * 2048 * D * 2);
constexpr size_t WS_RREC = WS_VT + al((size_t)2 * 2048 * D * 2);
constexpr size_t WS_RGB = WS_RREC + al((size_t)9216 * 18432);
constexpr size_t WS_SLAB = WS_RGB + al((size_t)9216 * 16 * 64 * 4);
constexpr size_t WS_END = WS_SLAB + al((size_t)16 * 11 * 262144);
static_assert(WS_VT - WS_KB == 4194304 * 2 && O_MVP - O_MKP == 4194304, "epilogue layout assumptions");
constexpr int CW_BAR = 4096;

constexpr int MAIN_BYTES = 139264;
constexpr int LDSCTL_OFF = MAIN_BYTES, MISC_OFF = LDSCTL_OFF + 320;
constexpr int PRM_OFF = MAIN_BYTES + 1024;
constexpr int LDS_BYTES = 160 * 1024;
static_assert(LDS_BYTES <= 160 * 1024 && pg8::EpiAny::RED_OFF == PRM_OFF + 8192 && pg8::EpiAny::RED_OFF + 8 * 1280 <= LDS_BYTES, "LDS");

#define RLX_AGENT __ATOMIC_RELAXED, __HIP_MEMORY_SCOPE_AGENT
__device__ __forceinline__ int lane_id_v() { int x; asm volatile("v_mbcnt_lo_u32_b32 %0, -1, 0\n\tv_mbcnt_hi_u32_b32 %0, -1, %0" : "=v"(x)); return x; }
__device__ __forceinline__ float bf2f(bf16 u) { return __uint_as_float((unsigned)u << 16); }
__device__ __forceinline__ void unpack8(const u32x4v w, float (&f)[8]) {
    f[0] = __uint_as_float(w.x << 16); f[1] = __uint_as_float(w.x & 0xffff0000u); f[2] = __uint_as_float(w.y << 16); f[3] = __uint_as_float(w.y & 0xffff0000u);
    f[4] = __uint_as_float(w.z << 16); f[5] = __uint_as_float(w.z & 0xffff0000u); f[6] = __uint_as_float(w.w << 16); f[7] = __uint_as_float(w.w & 0xffff0000u);
}
__device__ __forceinline__ unsigned f2bf(float f) { unsigned u = __builtin_bit_cast(unsigned, f); return (u + 0x7fffu + ((u >> 16) & 1u)) >> 16; }
__device__ __forceinline__ unsigned pk2(float lo, float hi) { return f2bf(lo) | (f2bf(hi) << 16); }
template <int CTRL> __device__ __forceinline__ float dpp_f(float x) { return __builtin_bit_cast(float, __builtin_amdgcn_update_dpp(0, __builtin_bit_cast(int, x), CTRL, 0xF, 0xF, true)); }
__device__ __forceinline__ float wave_sum(float v) {
    v += dpp_f<0xB1>(v); v += dpp_f<0x4E>(v); v += dpp_f<0x141>(v); v += dpp_f<0x140>(v);
    const int iv = __builtin_bit_cast(int, v);
    return (__builtin_bit_cast(float, __builtin_amdgcn_readlane(iv, 0)) + __builtin_bit_cast(float, __builtin_amdgcn_readlane(iv, 16))) +
           (__builtin_bit_cast(float, __builtin_amdgcn_readlane(iv, 32)) + __builtin_bit_cast(float, __builtin_amdgcn_readlane(iv, 48)));
}
__device__ __forceinline__ float wave_max(float v) {
    v = fmaxf(v, dpp_f<0xB1>(v)); v = fmaxf(v, dpp_f<0x4E>(v)); v = fmaxf(v, dpp_f<0x141>(v)); v = fmaxf(v, dpp_f<0x140>(v));
    const int iv = __builtin_bit_cast(int, v);
    return fmaxf(fmaxf(__builtin_bit_cast(float, __builtin_amdgcn_readlane(iv, 0)), __builtin_bit_cast(float, __builtin_amdgcn_readlane(iv, 16))),
                 fmaxf(__builtin_bit_cast(float, __builtin_amdgcn_readlane(iv, 32)), __builtin_bit_cast(float, __builtin_amdgcn_readlane(iv, 48))));
}
__device__ __forceinline__ float fexp(float x) { return __builtin_amdgcn_exp2f(1.4426950408889634f * x); }
__device__ __forceinline__ float flog(float x) { return __builtin_amdgcn_logf(x) * 0.6931471805599453f; }
__device__ __forceinline__ float fsig(float x) { return __builtin_amdgcn_rcpf(1.f + __builtin_amdgcn_exp2f(-1.4426950408889634f * x)); }
__device__ __forceinline__ float fsilu(float x) { return x * fsig(x); }

#define XB_TMO      128
#define XB_XCNT(j)  (256  + 64 * (j))
#define XB_XSUB(j)  (1280 + 64 * (j))
#define XB_XGEN(j)  (2304 + 64 * (j))
#define XB_TOP      3328
#define XB_TOPGEN   3392
#define XCD_BAR_WORDS 3456
#define XB_SPIN_CAP (1u << 18)

__device__ __forceinline__ unsigned xb_ld(unsigned* p)              { return __hip_atomic_load(p, __ATOMIC_RELAXED, __HIP_MEMORY_SCOPE_AGENT); }
__device__ __forceinline__ unsigned xb_add(unsigned* p, unsigned v) { return __hip_atomic_fetch_add(p, v, __ATOMIC_RELAXED, __HIP_MEMORY_SCOPE_AGENT); }
__device__ __forceinline__ unsigned xb_xcc_id() { return (unsigned)__builtin_amdgcn_s_getreg((3 << 11) | 20) & 0xFu; }
#define XB_SPIN(cond, bar) do { unsigned _sp = 0; while (cond) { __builtin_amdgcn_s_sleep(1); \
    if ((++_sp & 255u) == 0u) { if (xb_ld(&(bar)[XB_TMO])) break; if (_sp > XB_SPIN_CAP) { atomicAdd(&(bar)[XB_TMO], 1u); break; } } } } while (0)

struct XcdBarrier {
    unsigned* bar; unsigned x; int w0;
    volatile LAS unsigned* st;
};

__device__ __forceinline__ XcdBarrier xcd_barrier_post(unsigned* bar, volatile LAS unsigned* st) {
    XcdBarrier b; b.bar = bar; b.x = xb_xcc_id(); b.st = st;
    if (threadIdx.x == 0) (void)xb_add(&bar[XB_XCNT(b.x)], 1u);
    return b;
}
__device__ __forceinline__ void xcd_barrier_complete(unsigned* bar, unsigned x, unsigned& nloc, unsigned& nx) {
    const unsigned G = gridDim.x * gridDim.y * gridDim.z;
    unsigned sum, cnt, mine, sp = 0u;
    for (;;) {
        sum = 0u; cnt = 0u; mine = 0u;
#pragma unroll
        for (unsigned j = 0; j < 16; ++j) { const unsigned c = xb_ld(&bar[XB_XCNT(j)]); sum += c; cnt += (c > 0u) ? 1u : 0u; }
        mine = xb_ld(&bar[XB_XCNT(x)]);
        if (sum == G) break;
        __builtin_amdgcn_s_sleep(1);
        if ((++sp & 255u) == 0u) { if (xb_ld(&bar[XB_TMO])) break; if (sp > XB_SPIN_CAP) { atomicAdd(&bar[XB_TMO], 1u); break; } }
    }
    nloc = mine > 0u ? mine : 1u; nx = cnt > 0u ? cnt : 1u;
}

__device__ __forceinline__ void xcd_barrier(const XcdBarrier& b) {
    asm volatile("s_waitcnt vmcnt(0)" ::: "memory");
    __syncthreads();
    if (b.w0 == 0 && __builtin_amdgcn_mbcnt_hi(~0u, __builtin_amdgcn_mbcnt_lo(~0u, 0u)) == 0u) {
        unsigned* bar = b.bar; asm volatile("" : "+s"(bar));
        __builtin_amdgcn_s_waitcnt(0);
        unsigned nloc = b.st[0], nx = b.st[1];
        if (nloc == 0u) { xcd_barrier_complete(bar, b.x, nloc, nx); b.st[0] = nloc; b.st[1] = nx; }
        const unsigned old = xb_add(&bar[XB_XSUB(b.x)], 1u);
        const unsigned gen = old / nloc;
        if (old + 1u == (gen + 1u) * nloc) {
            __builtin_amdgcn_fence(__ATOMIC_RELEASE, "agent");
            asm volatile("s_waitcnt vmcnt(0)" ::: "memory");
            const unsigned og = xb_add(&bar[XB_TOP], 1u);
            const unsigned tg = og / nx;
            if (og + 1u == (tg + 1u) * nx) xb_add(&bar[XB_TOPGEN], 1u);
            else XB_SPIN(xb_ld(&bar[XB_TOPGEN]) == tg, bar);
            __builtin_amdgcn_fence(__ATOMIC_ACQUIRE, "agent");
            xb_add(&bar[XB_XGEN(b.x)], 1u);
            asm volatile("s_waitcnt vmcnt(0)" ::: "memory");
        } else {
            XB_SPIN(xb_ld(&bar[XB_XGEN(b.x)]) == gen, bar);
            __builtin_amdgcn_fence(__ATOMIC_ACQUIRE, "agent");
            asm volatile("s_waitcnt vmcnt(0)" ::: "memory");
        }
    }
    __syncthreads();
}
struct Args { const float* in[42]; float* out; unsigned char* ws; };
typedef const __attribute__((address_space(4))) Args* ArgsP;
__device__ __forceinline__ ArgsP kargs() { ArgsP p = (ArgsP)__builtin_amdgcn_kernarg_segment_ptr(); asm volatile("" : "+s"(p)); return p; }

#define LDS_WAIT() asm volatile("s_waitcnt lgkmcnt(0)" ::: "memory")

typedef float f32x2p __attribute__((ext_vector_type(2)));
__device__ __forceinline__ void transpose_item(const float* W, int K, int N, const float* g, bf16* WT, int dest_row0, int k0, int n0, LAS float* scr, int lane) {
    f32x2p wv[32];
    const int cl = (lane & 31) * 2, rh = lane >> 5;
#pragma unroll
    for (int i = 0; i < 32; ++i) wv[i] = *(const f32x2p*)(W + (size_t)(k0 + 2 * i + rh) * N + n0 + cl);
    if (g) {
#pragma unroll
        for (int i = 0; i < 32; ++i) wv[i] *= g[k0 + 2 * i + rh];
    }
#pragma unroll
    for (int i = 0; i < 32; ++i) { const int kk = 2 * i + rh; scr[kk * 65 + cl] = wv[i].x; scr[kk * 65 + cl + 1] = wv[i].y; }
    LDS_WAIT(); asm volatile("" ::: "memory");
    const int c = lane & 7;
#pragma unroll
    for (int j = 0; j < 8; ++j) { const int n = (lane >> 3) + 8 * j; const LAS float* s = scr + (8 * c) * 65 + n;
        u32x4v o; o.x = pk2(s[0 * 65], s[1 * 65]); o.y = pk2(s[2 * 65], s[3 * 65]); o.z = pk2(s[4 * 65], s[5 * 65]); o.w = pk2(s[6 * 65], s[7 * 65]);
        *(u32x4v*)(WT + (size_t)(dest_row0 + n) * K + k0 + 8 * c) = o; }
    LDS_WAIT(); asm volatile("" ::: "memory");
}
struct WSeg { const float* W; const float* g; bf16* WT; int K, N, mode; };
__device__ __forceinline__ WSeg get_seg(ArgsP a, int s) {
    unsigned char* ws = a->ws; WSeg r; r.g = nullptr; r.mode = 0; r.K = D; r.N = D;
    const int l = s & 1;
    switch (s >> 1) {
    case 0: r.W = a->in[I_F1GU] + (size_t)l * D * NGU; r.g = a->in[I_F1N] + l * D; r.WT = (bf16*)(ws + WS_GU1 + l * SZ_GU); r.N = NGU; r.mode = 1; break;
    case 1: r.W = a->in[I_F1DN] + (size_t)l * FF * D; r.WT = (bf16*)(ws + WS_DN1 + l * SZ_DN); r.K = FF; break;
    case 2: if (l == 0) { r.W = a->in[I_EWIN]; r.g = a->in[I_MIXN]; r.WT = (bf16*)(ws + WS_WIN); r.N = EIN; } else { r.W = a->in[I_OWIN]; r.g = a->in[I_MIXN] + D; r.WT = (bf16*)(ws + WS_WIN + SZ_WIN); r.N = OIN; } break;
    case 3: r.W = l == 0 ? a->in[I_EWOUT] : a->in[I_OWOUT]; r.WT = (bf16*)(ws + WS_WOUT + l * SZ_SQ); break;
    case 4: r.W = a->in[I_WQ] + (size_t)l * D * D; r.g = a->in[I_XN] + l * D; r.WT = (bf16*)(ws + WS_WQ + l * SZ_SQ); break;
    case 5: r.W = a->in[I_WKV] + (size_t)l * D * 2048; r.g = a->in[I_MEMN] + l * D; r.WT = (bf16*)(ws + WS_WKV) + (size_t)l * 2048 * D; r.N = 2048; break;
    case 6: r.W = a->in[I_WO] + (size_t)l * D * D; r.WT = (bf16*)(ws + WS_WO + l * SZ_SQ); break;
    case 7: r.W = a->in[I_F2GU] + (size_t)l * D * NGU; r.g = a->in[I_F2N] + l * D; r.WT = (bf16*)(ws + WS_GU2 + l * SZ_GU); r.N = NGU; r.mode = 1; break;
    default: r.W = a->in[I_F2DN] + (size_t)l * FF * D; r.WT = (bf16*)(ws + WS_DN2 + l * SZ_DN); r.K = FF; break;
    }
    return r;
}
__device__ __forceinline__ void convert_weights(ArgsP a, LAS unsigned char* lds, unsigned mask, int gw, int NGW, int tid) {
    const int lane = tid & 63, wave = tid >> 6;
    LAS float* scr = (LAS float*)(lds + wave * 16640);
    int base = 0;
    for (int s = 0; s < 18; ++s) {
        if (!((mask >> s) & 1u)) continue;
        const WSeg sg = get_seg(a, s);
        const int nblk = sg.N / 64, cnt = (sg.K / 64) * nblk;
        int it = base + ((gw - base) % NGW + NGW) % NGW;
        for (; it < base + cnt; it += NGW) {
            const int r = it - base, kb = r / nblk, nb = r % nblk, n0 = 64 * nb;
            int dr = n0;
            if (sg.mode == 1) { const int hh = n0 < FF ? n0 : n0 - FF; dr = 256 * (hh >> 7) + (hh & 127) + (n0 < FF ? 0 : 128); }
            transpose_item(sg.W, sg.K, sg.N, sg.g, sg.WT, dr, 64 * kb, n0, scr, lane);
        }
        base += cnt;
    }
}
constexpr unsigned WMASK_PRO = (1u << 0),
                   WMASK_T0 = (1u << 2) | (1u << 4),
                   WMASK_T2 = (1u << 6) | (1u << 10) | (1u << 11) | (1u << 8) | (1u << 12),
                   WMASK_T4 = (1u << 14) | (1u << 16),
                   WMASK_T5 = (1u << 1) | (1u << 3) | (1u << 5),
                   WMASK_T6 = (1u << 7) | (1u << 9) | (1u << 13) | (1u << 15) | (1u << 17);
static_assert((WMASK_PRO | WMASK_T0 | WMASK_T2 | WMASK_T4 | WMASK_T5 | WMASK_T6) == 0x3ffffu &&
              (WMASK_PRO + WMASK_T0 + WMASK_T2 + WMASK_T4 + WMASK_T5 + WMASK_T6) == 0x3ffffu, "every segment exactly once");
__device__ __forceinline__ void p0_prologue(ArgsP a, LAS unsigned char* lds, int vcu, int G, int tid) {
    const int lane = tid & 63, wave = tid >> 6;
    const int gw = vcu * NWAVES + wave, NGW = G * NWAVES;
    unsigned char* ws = a->ws;
    convert_weights(a, lds, WMASK_PRO, gw, NGW, tid);
    {
        bf16* LW = (bf16*)(ws + WS_LORA);
        const float* w2 = a->in[I_W2]; const float* a2 = a->in[I_A2]; const float* g2 = a->in[I_G2];
        for (int e = (vcu * NTHR + tid); e < 1536 * 256; e += G * NTHR) {
            const int n = e >> 8, k = e & 255; float v = 0.f;
            if (n < 512) { if (k < 64) v = w2[k * 512 + n]; }
            else if (n < 1024) { if (k >= 64 && k < 128) v = a2[(k - 64) * 512 + (n - 512)]; }
            else { if (k >= 128) v = g2[(k - 128) * 512 + (n - 1024)]; }
            LW[e] = (bf16)f2bf(v);
        }
    }
    {
        pg8::ssq_t* ssq0 = (pg8::ssq_t*)(ws + WS_CTL + CTL_SSQ_OFF);
        pg8::ssq_t* ssqm = (pg8::ssq_t*)(ws + WS_CTL + CTL_SSQM_OFF);
        bf16* XB = (bf16*)(ws + WS_XB); bf16* MB = (bf16*)(ws + WS_MEMB);
        for (int m0 = gw; m0 < MT + 2048; m0 += 2 * NGW) {
            f32x4 v[2][4]; bf16* dst[2]; pg8::ssq_t* sq[2]; bool ok[2];
#pragma unroll
            for (int q = 0; q < 2; ++q) {
                const int m = m0 + q * NGW; ok[q] = m < MT + 2048; const int mm = ok[q] ? m : m0;
                const float* src;
                if (mm < MP) { src = a->in[I_XP] + (size_t)mm * D; dst[q] = XB + (size_t)mm * D; sq[q] = ssq0 + mm; }
                else if (mm < MT) { src = a->in[I_XS] + (size_t)(mm - MP) * D; dst[q] = XB + (size_t)mm * D; sq[q] = ssq0 + mm; }
                else { src = a->in[I_MEM] + (size_t)(mm - MT) * D; dst[q] = MB + (size_t)(mm - MT) * D; sq[q] = ssqm + (mm - MT); }
                const f32x4* xr = (const f32x4*)src + lane;
#pragma unroll
                for (int j = 0; j < 4; ++j) v[q][j] = xr[64 * j];
            }
#pragma unroll
            for (int q = 0; q < 2; ++q) {
                float s = 0.f;
#pragma unroll
                for (int j = 0; j < 4; ++j) s += (v[q][j].x * v[q][j].x + v[q][j].y * v[q][j].y) + (v[q][j].z * v[q][j].z + v[q][j].w * v[q][j].w);
                s = wave_sum(s);
                if (ok[q]) {
                    u32x2v* o8 = (u32x2v*)dst[q] + lane;
#pragma unroll
                    for (int j = 0; j < 4; ++j) { u32x2v w; w.x = pk2(v[q][j].x, v[q][j].y); w.y = pk2(v[q][j].z, v[q][j].w); o8[64 * j] = w; }
                    if (lane == 0) *sq[q] = pg8::ssq_fix(s);
                }
            }
        }
    }
}

struct ChunkInfo { int row0, h, b, pos0; bool sample; };
__device__ __forceinline__ ChunkInfo chunk_info(int cid) {
    ChunkInfo c;
    if (cid < NCHP) { c.b = cid >> 7; c.h = (cid >> 5) & 3; const int ch = cid & 31; c.row0 = c.b * 2048 + ch * 64; c.pos0 = ch * 64; c.sample = false; }
    else { const int j = cid - NCHP; c.b = j >> 2; c.h = j & 3; c.row0 = MP + c.b * 8; c.pos0 = 16384; c.sample = true; }
    return c;
}


__device__ __forceinline__ void rope_cs(int pos, float inv, float& c, float& s) {
    const float ang = (float)pos * inv;
    const double rev = (double)ang * 0.15915494309189535;
    const float fr = (float)(rev - __builtin_rint(rev));
    s = __builtin_amdgcn_sinf(fr); c = __builtin_amdgcn_cosf(fr);
}
__device__ __forceinline__ float ret_lg2(int h) { return __log2f(1.0f - __builtin_amdgcn_exp2f(-5.0f - (float)h)); }

constexpr int CB_QM = 0, CB_KM = 17408, CB_ATT = 34816, CB_VVT = 44032, CB_ST = 62464, CB_BC = 97280, CB_SK = 130048, CB_PART = 130560;
constexpr int CB_GI = CB_BC;
__device__ __forceinline__ bf16x8 ldsfrag(const LAS unsigned char* p) { return *(const LAS bf16x8*)p; }
__device__ __forceinline__ int tsw(int r, int t) { return r * 72 + ((((t >> 3) ^ (r >> 3)) & 7) << 3) + (t & 7); }
__device__ __forceinline__ int tsf(int r, int chunk) { return r * 144 + (((chunk ^ (r >> 3)) & 7) << 4); }
__device__ __forceinline__ void cumsum64(LAS float* bc, LAS float* tot, int tid) {
    const int k = tid & 127, seg = tid >> 7; float v[16]; float s = 0.f;
#pragma unroll
    for (int i = 0; i < 16; ++i) { s += bc[(16 * seg + i) * 128 + k]; v[i] = s; }
    tot[seg * 128 + k] = s;
    __syncthreads();
    float off = 0.f;
#pragma unroll
    for (int q = 0; q < 3; ++q) if (q < seg) off += tot[q * 128 + k];
#pragma unroll
    for (int i = 0; i < 16; ++i) bc[(16 * seg + i) * 128 + k] = v[i] + off;
    __syncthreads();
}
__device__ __forceinline__ void chunk_a_core64_bf16(const LAS unsigned char* lds, bf16* dS, int tid) {
    const int lane = tid & 63, wave = __builtin_amdgcn_readfirstlane(tid >> 6), ij = lane & 15, kq = lane >> 4;
    f32x4 acc[8];
#pragma unroll
    for (int q = 0; q < 8; ++q) acc[q] = (f32x4){0.f, 0.f, 0.f, 0.f};
#pragma unroll
    for (int s = 0; s < 2; ++s) {
        const bf16x8 kf = ldsfrag(lds + tsf(16 * wave + ij, 4 * s + kq));
#pragma unroll
        for (int q = 0; q < 8; ++q) acc[q] = __builtin_amdgcn_mfma_f32_16x16x32_bf16(ldsfrag(lds + CB_VVT + tsf(16 * q + ij, 4 * s + kq)), kf, acc[q], 0, 0, 0);
    }
    bf16* dst = dS + (size_t)(16 * wave + ij) * 128 + 32 * kq;
    float one = 1.0f; asm volatile("" : "+v"(one));
#pragma unroll
    for (int q2 = 0; q2 < 4; ++q2) {
        const f32x4 a0 = acc[2 * q2] * one, a1 = acc[2 * q2 + 1] * one;
        u32x4v w; w.x = pg8::cvt_pk_bf16(a0[0], a0[1]); w.y = pg8::cvt_pk_bf16(a0[2], a0[3]); w.z = pg8::cvt_pk_bf16(a1[0], a1[1]); w.w = pg8::cvt_pk_bf16(a1[2], a1[3]);
        *(u32x4v*)(dst + 8 * q2) = w;
    }
}
__device__ __forceinline__ void chunk_c_core64_bf16(LAS unsigned char* lds, const bf16* S, const float* gn, const bf16* gate, bf16* yout, int tid) {
    const int lane = tid & 63, wave = __builtin_amdgcn_readfirstlane(tid >> 6), ij = lane & 15, kq = lane >> 4;
    const LAS float* sk = (const LAS float*)(lds + CB_SK); LAS float* part = (LAS float*)(lds + CB_PART);
    {
        u32x4v sv[2][2], gv[2];
#pragma unroll
        for (int q = 0; q < 2; ++q) { const int p = tid + 512 * q, kp = p >> 4, c = p & 15;
            sv[q][0] = *(const u32x4v*)(S + (size_t)(2 * kp) * 128 + 8 * c); sv[q][1] = *(const u32x4v*)(S + (size_t)(2 * kp + 1) * 128 + 8 * c);
            gv[q] = *(const u32x4v*)(gate + (size_t)(p >> 4) * PLD + 8 * (p & 15)); }
#pragma unroll
        for (int q = 0; q < 2; ++q) { const int p = tid + 512 * q; *(LAS u32x4v*)(lds + CB_GI + (p >> 4) * 272 + 16 * (p & 15)) = gv[q]; }
#pragma unroll
        for (int q = 0; q < 2; ++q) { const int p = tid + 512 * q, k = 2 * (p >> 4), c = p & 15, vq = 4 * (c >> 2), q0 = (c & 3) * 2; const float sc0 = sk[k], sc1 = sk[k + 1];
            const unsigned wa[4] = {sv[q][0].x, sv[q][0].y, sv[q][0].z, sv[q][0].w}, wb[4] = {sv[q][1].x, sv[q][1].y, sv[q][1].z, sv[q][1].w};
#pragma unroll
            for (int j = 0; j < 8; ++j) { const int v = 16 * (q0 + (j >> 2)) + vq + (j & 3);
                const float fa = (j & 1) ? __uint_as_float(wa[j >> 1] & 0xffff0000u) : __uint_as_float(wa[j >> 1] << 16);
                const float fb = (j & 1) ? __uint_as_float(wb[j >> 1] & 0xffff0000u) : __uint_as_float(wb[j >> 1] << 16);
                LAS unsigned* dst = (LAS unsigned*)((LAS bf16*)(lds + CB_ST) + v * 136 + (((k >> 3) ^ ((v >> 3) & 7)) << 3) + (k & 7));
                dst[0] = pk2(fa * sc0, fb * sc1); }
        }
    }
    {
        const int t0 = 16 * (wave >> 1), j0 = 32 * (wave & 1);
        f32x4 c0 = (f32x4){0.f, 0.f, 0.f, 0.f}, c1 = c0;
#pragma unroll
        for (int s = 0; s < 4; ++s) { const bf16x8 af = ldsfrag(lds + CB_QM + (t0 + ij) * 272 + 64 * s + 16 * kq);
            c0 = __builtin_amdgcn_mfma_f32_16x16x32_bf16(af, ldsfrag(lds + CB_KM + (j0 + ij) * 272 + 64 * s + 16 * kq), c0, 0, 0, 0);
            c1 = __builtin_amdgcn_mfma_f32_16x16x32_bf16(af, ldsfrag(lds + CB_KM + (j0 + 16 + ij) * 272 + 64 * s + 16 * kq), c1, 0, 0, 0); }
        LAS bf16* ab = (LAS bf16*)(lds + CB_ATT);
#pragma unroll
        for (int r = 0; r < 4; ++r) { const int t = t0 + 4 * kq + r; int j = j0 + ij; ab[t * 72 + j] = (bf16)f2bf((j <= t) ? c0[r] : 0.f); j += 16; ab[t * 72 + j] = (bf16)f2bf((j <= t) ? c1[r] : 0.f); }
    }
    __syncthreads();
    const int t0 = 16 * (wave >> 1), vb = 64 * (wave & 1);
    f32x4 o[4];
#pragma unroll
    for (int q = 0; q < 4; ++q) o[q] = (f32x4){0.f, 0.f, 0.f, 0.f};
#pragma unroll
    for (int s = 0; s < 4; ++s) { const bf16x8 af = ldsfrag(lds + CB_QM + (t0 + ij) * 272 + 64 * s + 16 * kq);
#pragma unroll
        for (int q = 0; q < 4; ++q) { const int v = vb + 16 * q + ij; o[q] = __builtin_amdgcn_mfma_f32_16x16x32_bf16(af, ldsfrag(lds + CB_ST + v * 272 + 16 * ((4 * s + kq) ^ ((v >> 3) & 7))), o[q], 0, 0, 0); } }
#pragma unroll
    for (int s = 0; s < 2; ++s) { const bf16x8 af = ldsfrag(lds + CB_ATT + (t0 + ij) * 144 + 64 * s + 16 * kq);
#pragma unroll
        for (int q = 0; q < 4; ++q) o[q] = __builtin_amdgcn_mfma_f32_16x16x32_bf16(af, ldsfrag(lds + CB_VVT + tsf(vb + 16 * q + ij, 4 * s + kq)), o[q], 0, 0, 0); }
    float ss[4];
#pragma unroll
    for (int r = 0; r < 4; ++r) { float s = (o[0][r] * o[0][r] + o[1][r] * o[1][r]) + (o[2][r] * o[2][r] + o[3][r] * o[3][r]);
        s += dpp_f<0xB1>(s); s += dpp_f<0x4E>(s); s += dpp_f<0x141>(s); s += dpp_f<0x140>(s); ss[r] = s; }
    if (ij == 0) {
#pragma unroll
        for (int r = 0; r < 4; ++r) part[(wave & 1) * 64 + t0 + 4 * kq + r] = ss[r];
    }
    __syncthreads();
    float gnv[4];
#pragma unroll
    for (int q = 0; q < 4; ++q) gnv[q] = gn[vb + 16 * q + ij];
    LAS bf16* yo = (LAS bf16*)(lds + CB_QM);
    const LAS bf16* gi = (const LAS bf16*)(lds + CB_GI);
#pragma unroll
    for (int r = 0; r < 4; ++r) {
        const int t = t0 + 4 * kq + r;
        const float rs = __builtin_amdgcn_rsqf((part[t] + part[64 + t]) * (1.0f / 128.0f) + 1e-6f);
#pragma unroll
        for (int q = 0; q < 4; ++q) { const int v = vb + 16 * q + ij; yo[t * 136 + v] = (bf16)f2bf(o[q][r] * rs * gnv[q] * fsilu(bf2f(gi[t * 136 + v]))); }
    }
    __syncthreads();
#pragma unroll
    for (int q = 0; q < 2; ++q) { const int p = tid + 512 * q; *(u32x4v*)(yout + (size_t)(p >> 4) * D + 8 * (p & 15)) = *(const LAS u32x4v*)(lds + CB_QM + (p >> 4) * 272 + 16 * (p & 15)); }
    __syncthreads();
}
__device__ __forceinline__ void hgrn_a64(int cid, const bf16* P, bf16* DS, float* DEC, const LAS float* lbv, LAS unsigned char* lds, int tid) {
    const ChunkInfo ci = chunk_info(cid);
    LAS float* bc = (LAS float*)(lds + CB_BC); LAS float* tot = (LAS float*)(lds + CB_SK);
    LAS bf16* kdT = (LAS bf16*)lds; LAS bf16* vvT = (LAS bf16*)(lds + CB_VVT);
    u32x4v fw[2], iw[2];
#pragma unroll
    for (int j = 0; j < 2; ++j) { const int p = tid + 512 * j, t = p >> 4, k0 = 8 * (p & 15); const bf16* pr = P + (size_t)(ci.row0 + t) * PLD + ci.h * 128 + k0;
        fw[j] = *(const u32x4v*)(pr + 2048); iw[j] = *(const u32x4v*)(pr + 2560); }
    float omf[2][8];
#pragma unroll
    for (int j = 0; j < 2; ++j) {
        const int p = tid + 512 * j, t = p >> 4, k0 = 8 * (p & 15);
        float fb[8]; unpack8(fw[j], fb);
        const f32x4 l0 = *(const LAS f32x4*)(lbv + ci.h * 128 + k0), l1 = *(const LAS f32x4*)(lbv + ci.h * 128 + k0 + 4);
        f32x4 lg[2];
#pragma unroll
        for (int i = 0; i < 8; ++i) { const float lb = (i < 4) ? l0[i & 3] : l1[i & 3]; const float f = lb + (1.f - lb) * fsig(fb[i]); lg[i >> 2][i & 3] = flog(f); omf[j][i] = 1.f - f; }
        *(LAS f32x4*)(bc + t * 128 + k0) = lg[0]; *(LAS f32x4*)(bc + t * 128 + k0 + 4) = lg[1];
        const unsigned iv[4] = {iw[j].x, iw[j].y, iw[j].z, iw[j].w};
#pragma unroll
        for (int i = 0; i < 8; ++i) vvT[tsw(k0 + i, t)] = (bf16)((i & 1) ? (iv[i >> 1] >> 16) : (iv[i >> 1] & 0xffffu));
    }
    __syncthreads();
    cumsum64(bc, tot, tid);
#pragma unroll
    for (int j = 0; j < 2; ++j) {
        const int p = tid + 512 * j, t = p >> 4, k0 = 8 * (p & 15);
        const f32x4 e0 = *(const LAS f32x4*)(bc + 63 * 128 + k0), e1 = *(const LAS f32x4*)(bc + 63 * 128 + k0 + 4), c0 = *(const LAS f32x4*)(bc + t * 128 + k0), c1 = *(const LAS f32x4*)(bc + t * 128 + k0 + 4);
#pragma unroll
        for (int i = 0; i < 8; ++i) { const float d = ((i < 4) ? e0[i & 3] : e1[i & 3]) - ((i < 4) ? c0[i & 3] : c1[i & 3]); kdT[tsw(k0 + i, t)] = (bf16)f2bf(omf[j][i] * fexp(d)); }
    }
    if (tid < 128) DEC[cid * 128 + tid] = fexp(bc[63 * 128 + tid]);
    __syncthreads();
    chunk_a_core64_bf16(lds, DS + (size_t)cid * 16384, tid);
    __syncthreads();
}
__device__ __forceinline__ void hgrn_c64(int cid, const bf16* P, const bf16* DS, const float* gnorm, bf16* YM, const LAS float* lbv, LAS unsigned char* lds, int tid) {
    const ChunkInfo ci = chunk_info(cid);
    LAS float* bc = (LAS float*)(lds + CB_BC);
    LAS bf16* qmB = (LAS bf16*)(lds + CB_QM); LAS bf16* kmB = (LAS bf16*)(lds + CB_KM); LAS bf16* vvT = (LAS bf16*)(lds + CB_VVT); LAS float* sk = (LAS float*)(lds + CB_SK);
    u32x4v qw[2], fw[2], iw[2];
#pragma unroll
    for (int j = 0; j < 2; ++j) { const int p = tid + 512 * j, t = p >> 4, k0 = 8 * (p & 15); const bf16* pr = P + (size_t)(ci.row0 + t) * PLD + ci.h * 128 + k0;
        qw[j] = *(const u32x4v*)(pr + 1536); fw[j] = *(const u32x4v*)(pr + 2048); iw[j] = *(const u32x4v*)(pr + 2560); }
    float omf[2][8], sq[2][8];
#pragma unroll
    for (int j = 0; j < 2; ++j) {
        const int p = tid + 512 * j, t = p >> 4, k0 = 8 * (p & 15);
        float fb[8], qb[8]; unpack8(fw[j], fb); unpack8(qw[j], qb);
        const f32x4 l0 = *(const LAS f32x4*)(lbv + ci.h * 128 + k0), l1 = *(const LAS f32x4*)(lbv + ci.h * 128 + k0 + 4);
        f32x4 lg[2];
#pragma unroll
        for (int i = 0; i < 8; ++i) { const float lb = (i < 4) ? l0[i & 3] : l1[i & 3]; const float f = lb + (1.f - lb) * fsig(fb[i]); lg[i >> 2][i & 3] = flog(f); omf[j][i] = 1.f - f; sq[j][i] = fsilu(qb[i]); }
        *(LAS f32x4*)(bc + t * 128 + k0) = lg[0]; *(LAS f32x4*)(bc + t * 128 + k0 + 4) = lg[1];
        const unsigned iv[4] = {iw[j].x, iw[j].y, iw[j].z, iw[j].w};
#pragma unroll
        for (int i = 0; i < 8; ++i) vvT[tsw(k0 + i, t)] = (bf16)((i & 1) ? (iv[i >> 1] >> 16) : (iv[i >> 1] & 0xffffu));
    }
    __syncthreads();
    cumsum64(bc, (LAS float*)(lds + CB_ST), tid);
    if (tid < 128) sk[tid] = fexp(bc[32 * 128 + tid]);
#pragma unroll
    for (int j = 0; j < 2; ++j) {
        const int p = tid + 512 * j, t = p >> 4, k0 = 8 * (p & 15);
        const f32x4 m0 = *(const LAS f32x4*)(bc + 32 * 128 + k0), m1 = *(const LAS f32x4*)(bc + 32 * 128 + k0 + 4), c0 = *(const LAS f32x4*)(bc + t * 128 + k0), c1 = *(const LAS f32x4*)(bc + t * 128 + k0 + 4);
        float qv[8], kv[8];
#pragma unroll
        for (int i = 0; i < 8; ++i) { const float d = ((i < 4) ? c0[i & 3] : c1[i & 3]) - ((i < 4) ? m0[i & 3] : m1[i & 3]); qv[i] = sq[j][i] * fexp(d); kv[i] = omf[j][i] * fexp(-d); }
        u32x4v qo, ko; qo.x = pk2(qv[0], qv[1]); qo.y = pk2(qv[2], qv[3]); qo.z = pk2(qv[4], qv[5]); qo.w = pk2(qv[6], qv[7]); ko.x = pk2(kv[0], kv[1]); ko.y = pk2(kv[2], kv[3]); ko.z = pk2(kv[4], kv[5]); ko.w = pk2(kv[6], kv[7]);
        *(LAS u32x4v*)(qmB + t * 136 + k0) = qo; *(LAS u32x4v*)(kmB + t * 136 + k0) = ko;
    }
    __syncthreads();
    chunk_c_core64_bf16(lds, DS + (size_t)cid * 16384, gnorm + ci.h * 128, P + (size_t)ci.row0 * PLD + 3072 + ci.h * 128, YM + (size_t)ci.row0 * D + 512 + ci.h * 128, tid);
}
__device__ __forceinline__ void ret_a64(int cid, const bf16* P, bf16* DS, const LAS float* invf, LAS unsigned char* lds, int tid) {
    const ChunkInfo ci = chunk_info(cid);
    LAS bf16* kdT = (LAS bf16*)lds; LAS bf16* vvT = (LAS bf16*)(lds + CB_VVT);
    const float lg2 = ret_lg2(ci.h);
    const int t = tid >> 3, i0 = 8 * (tid & 7);
    const bf16* pr = P + (size_t)(ci.row0 + t) * PLD + ci.h * 128 + i0;
    const u32x4v k1w = *(const u32x4v*)(pr + 512), k2w = *(const u32x4v*)(pr + 512 + 64), v1w = *(const u32x4v*)(pr + 1024), v2w = *(const u32x4v*)(pr + 1024 + 64);
    float k1[8], k2[8]; unpack8(k1w, k1); unpack8(k2w, k2);
    const unsigned v1v[4] = {v1w.x, v1w.y, v1w.z, v1w.w}, v2v[4] = {v2w.x, v2w.y, v2w.z, v2w.w};
    const f32x4 f0 = *(const LAS f32x4*)(invf + i0), f1 = *(const LAS f32x4*)(invf + i0 + 4);
    const float sc = 0.08838834764831845f * __builtin_amdgcn_exp2f(lg2 * (float)(63 - t));
#pragma unroll
    for (int j = 0; j < 8; ++j) {
        const int i = i0 + j;
        float c, s; rope_cs(ci.pos0 + t, (j < 4) ? f0[j & 3] : f1[j & 3], c, s);
        kdT[tsw(i, t)] = (bf16)f2bf((k1[j] * c - k2[j] * s) * sc); kdT[tsw(64 + i, t)] = (bf16)f2bf((k1[j] * s + k2[j] * c) * sc);
        vvT[tsw(i, t)] = (bf16)((j & 1) ? (v1v[j >> 1] >> 16) : (v1v[j >> 1] & 0xffffu)); vvT[tsw(64 + i, t)] = (bf16)((j & 1) ? (v2v[j >> 1] >> 16) : (v2v[j >> 1] & 0xffffu));
    }
    __syncthreads();
    chunk_a_core64_bf16(lds, DS + (size_t)cid * 16384, tid);
    __syncthreads();
}
__device__ __forceinline__ void ret_c64(int cid, const bf16* P, const bf16* DS, const float* gnorm, bf16* YM, const LAS float* invf, LAS unsigned char* lds, int tid) {
    const ChunkInfo ci = chunk_info(cid);
    LAS bf16* qmB = (LAS bf16*)(lds + CB_QM); LAS bf16* kmB = (LAS bf16*)(lds + CB_KM); LAS bf16* vvT = (LAS bf16*)(lds + CB_VVT); LAS float* sk = (LAS float*)(lds + CB_SK);
    const float lg2 = ret_lg2(ci.h);
    const int t = tid >> 3, i0 = 8 * (tid & 7);
    const bf16* pr = P + (size_t)(ci.row0 + t) * PLD + ci.h * 128 + i0;
    const u32x4v q1w = *(const u32x4v*)(pr), q2w = *(const u32x4v*)(pr + 64), k1w = *(const u32x4v*)(pr + 512), k2w = *(const u32x4v*)(pr + 512 + 64), v1w = *(const u32x4v*)(pr + 1024), v2w = *(const u32x4v*)(pr + 1024 + 64);
    float q1[8], q2[8], k1[8], k2[8]; unpack8(q1w, q1); unpack8(q2w, q2); unpack8(k1w, k1); unpack8(k2w, k2);
    const unsigned v1v[4] = {v1w.x, v1w.y, v1w.z, v1w.w}, v2v[4] = {v2w.x, v2w.y, v2w.z, v2w.w};
    const f32x4 f0 = *(const LAS f32x4*)(invf + i0), f1 = *(const LAS f32x4*)(invf + i0 + 4);
    const float dq = __builtin_amdgcn_exp2f(lg2 * (float)(t - 32)), dk = 0.08838834764831845f * __builtin_amdgcn_exp2f(lg2 * (float)(32 - t));
    float qa[8], qb[8], ka[8], kb[8];
#pragma unroll
    for (int j = 0; j < 8; ++j) {
        const int i = i0 + j;
        float c, s; rope_cs(ci.pos0 + t, (j < 4) ? f0[j & 3] : f1[j & 3], c, s);
        qa[j] = (q1[j] * c - q2[j] * s) * dq; qb[j] = (q1[j] * s + q2[j] * c) * dq; ka[j] = (k1[j] * c - k2[j] * s) * dk; kb[j] = (k1[j] * s + k2[j] * c) * dk;
        vvT[tsw(i, t)] = (bf16)((j & 1) ? (v1v[j >> 1] >> 16) : (v1v[j >> 1] & 0xffffu)); vvT[tsw(64 + i, t)] = (bf16)((j & 1) ? (v2v[j >> 1] >> 16) : (v2v[j >> 1] & 0xffffu));
    }
    { u32x4v w; w.x = pk2(qa[0], qa[1]); w.y = pk2(qa[2], qa[3]); w.z = pk2(qa[4], qa[5]); w.w = pk2(qa[6], qa[7]); *(LAS u32x4v*)(qmB + t * 136 + i0) = w;
      w.x = pk2(qb[0], qb[1]); w.y = pk2(qb[2], qb[3]); w.z = pk2(qb[4], qb[5]); w.w = pk2(qb[6], qb[7]); *(LAS u32x4v*)(qmB + t * 136 + 64 + i0) = w;
      w.x = pk2(ka[0], ka[1]); w.y = pk2(ka[2], ka[3]); w.z = pk2(ka[4], ka[5]); w.w = pk2(ka[6], ka[7]); *(LAS u32x4v*)(kmB + t * 136 + i0) = w;
      w.x = pk2(kb[0], kb[1]); w.y = pk2(kb[2], kb[3]); w.z = pk2(kb[4], kb[5]); w.w = pk2(kb[6], kb[7]); *(LAS u32x4v*)(kmB + t * 136 + 64 + i0) = w; }
    if (tid < 128) sk[tid] = __builtin_amdgcn_exp2f(lg2 * 33.0f);
    __syncthreads();
    chunk_c_core64_bf16(lds, DS + (size_t)cid * 16384, gnorm + ci.h * 128, P + (size_t)ci.row0 * PLD + 1536 + ci.h * 128, YM + (size_t)ci.row0 * D + ci.h * 128, tid);
}

__device__ __forceinline__ void sample_state_load(const float* S0, float (&S)[32], int tid) {
    const int v = tid & 127, kq = tid >> 7;
#pragma unroll
    for (int i = 0; i < 32; ++i) S[i] = S0[(size_t)(kq * 32 + i) * 128 + v];
}
__device__ __forceinline__ void sample_rec_core(float (&S)[32], float* Sout, const float* gn, bf16* yout  , LAS unsigned char* lds, int tid) {
    const LAS float* dk = (const LAS float*)lds; const LAS float* kk = dk + 1024; const LAS float* qq = kk + 1024; const LAS float* vv = qq + 1024; const LAS float* gg = vv + 1024; LAS float* op = (LAS float*)(lds + 20480);
    const int v = tid & 127, kq = tid >> 7, lane = tid & 63, w = tid >> 6;
#pragma unroll 1
    for (int t = 0; t < 8; ++t) {
        const float x = vv[t * 128 + v]; float o = 0.f;
        const LAS f32x4* d4 = (const LAS f32x4*)(dk + t * 128 + kq * 32); const LAS f32x4* k4 = (const LAS f32x4*)(kk + t * 128 + kq * 32); const LAS f32x4* q4 = (const LAS f32x4*)(qq + t * 128 + kq * 32);
#pragma unroll
        for (int i = 0; i < 8; ++i) {
            const f32x4 d = d4[i], k = k4[i], q = q4[i];
            S[4 * i + 0] = d.x * S[4 * i + 0] + k.x * x; o += q.x * S[4 * i + 0];
            S[4 * i + 1] = d.y * S[4 * i + 1] + k.y * x; o += q.y * S[4 * i + 1];
            S[4 * i + 2] = d.z * S[4 * i + 2] + k.z * x; o += q.z * S[4 * i + 2];
            S[4 * i + 3] = d.w * S[4 * i + 3] + k.w * x; o += q.w * S[4 * i + 3];
        }
        op[(t * 4 + kq) * 128 + v] = o;
    }
#pragma unroll
    for (int i = 0; i < 32; ++i) Sout[(size_t)(kq * 32 + i) * 128 + v] = S[i];
    __syncthreads();
    {
        float o0 = 0.f, o1 = 0.f;
#pragma unroll
        for (int q = 0; q < 4; ++q) { o0 += op[(w * 4 + q) * 128 + lane]; o1 += op[(w * 4 + q) * 128 + 64 + lane]; }
        const float rs = __builtin_amdgcn_rsqf(wave_sum(o0 * o0 + o1 * o1) * (1.0f / 128.0f) + 1e-6f);
        yout[(size_t)w * D + lane] = (bf16)f2bf(o0 * rs * gn[lane] * fsilu(gg[w * 128 + lane]));
        yout[(size_t)w * D + 64 + lane] = (bf16)f2bf(o1 * rs * gn[64 + lane] * fsilu(gg[w * 128 + 64 + lane]));
    }
    __syncthreads();
}
__device__ __forceinline__ void hgrn_sample_unit(int j  , const bf16* P, const float* state_s, float* out_s, const float* gnorm, bf16* YM, const LAS float* lbv, LAS unsigned char* lds, int tid) {
    const int b = j >> 2, h = j & 3, row0 = MP + b * 8;
    LAS float* dk = (LAS float*)lds; LAS float* kk = dk + 1024; LAS float* qq = kk + 1024; LAS float* vv = qq + 1024; LAS float* gg = vv + 1024;
    float S[32]; sample_state_load(state_s + (size_t)j * 16384, S, tid);
#pragma unroll
    for (int q = 0; q < 2; ++q) {
        const int e = tid + 512 * q, t = e >> 7, k = e & 127; const size_t ro = (size_t)(row0 + t) * PLD + h * 128 + k;
        const float fb = bf2f(P[ro + 2048]), ib = bf2f(P[ro + 2560]), qb = bf2f(P[ro + 1536]), gb = bf2f(P[ro + 3072]); const float lb = lbv[h * 128 + k];
        const float f = lb + (1.f - lb) * fsig(fb);
        dk[e] = f; kk[e] = 1.f - f; qq[e] = fsilu(qb); vv[e] = ib; gg[e] = gb;
    }
    __syncthreads();
    sample_rec_core(S, out_s + (size_t)j * 16384, gnorm + h * 128, YM + (size_t)row0 * D + 512 + h * 128, lds, tid);
}
__device__ __forceinline__ void ret_sample_unit(int j, const bf16* P, const float* state_s, float* out_s, const float* gnorm, bf16* YM, const LAS float* invf, LAS unsigned char* lds, int tid) {
    const int b = j >> 2, h = j & 3, row0 = MP + b * 8;
    LAS float* dk = (LAS float*)lds; LAS float* kk = dk + 1024; LAS float* qq = kk + 1024; LAS float* vv = qq + 1024; LAS float* gg = vv + 1024;
    const float gam = 1.0f - __builtin_amdgcn_exp2f(-5.0f - (float)h);
    float S[32]; sample_state_load(state_s + (size_t)j * 16384, S, tid);
    {
        const int t = tid >> 6, i = tid & 63; const size_t ro = (size_t)(row0 + t) * PLD + h * 128 + i;
        float c, s; rope_cs(16384 + t, invf[i], c, s);
        const float q1 = bf2f(P[ro]), q2 = bf2f(P[ro + 64]), k1 = bf2f(P[ro + 512]), k2 = bf2f(P[ro + 512 + 64]);
        qq[t * 128 + i] = q1 * c - q2 * s; qq[t * 128 + 64 + i] = q1 * s + q2 * c;
        kk[t * 128 + i] = (k1 * c - k2 * s) * 0.08838834764831845f; kk[t * 128 + 64 + i] = (k1 * s + k2 * c) * 0.08838834764831845f;
        dk[t * 128 + i] = gam; dk[t * 128 + 64 + i] = gam;
        vv[t * 128 + i] = bf2f(P[ro + 1024]); vv[t * 128 + 64 + i] = bf2f(P[ro + 1024 + 64]);
        gg[t * 128 + i] = bf2f(P[ro + 1536]); gg[t * 128 + 64 + i] = bf2f(P[ro + 1536 + 64]);
    }
    __syncthreads();
    sample_rec_core(S, out_s + (size_t)j * 16384, gnorm + h * 128, YM + (size_t)row0 * D + h * 128, lds, tid);
}

template <bool HGRN> __device__ __forceinline__ void chunk_scan(const bf16* DS, bf16* SB, const float* DEC, float* out_p, int gtid, int gthreads) {
    for (int e4 = gtid; e4 < 32 * 4096; e4 += gthreads) {
        const int bh = e4 >> 12, kv4 = e4 & 4095, k = kv4 >> 5, vp = (kv4 & 31) * 4;
        float gC = 0.f; if (!HGRN) gC = __builtin_amdgcn_exp2f(ret_lg2(bh & 3) * 64.0f);
        const bf16* p0 = DS + (size_t)(bh * 32) * 16384 + kv4 * 4; bf16* p1 = SB + (size_t)(bh * 32) * 16384 + kv4 * 4;
        f32x4 S = (f32x4){0.f, 0.f, 0.f, 0.f};
#pragma unroll 1
        for (int c0 = 0; c0 < 32; c0 += 16) {
            u32x2v tv[16]; float dv[16];
#pragma unroll
            for (int c = 0; c < 16; ++c) { tv[c] = *(const u32x2v*)(p0 + (size_t)(c0 + c) * 16384); dv[c] = HGRN ? DEC[(bh * 32 + c0 + c) * 128 + k] : gC; }
#pragma unroll
            for (int c = 0; c < 16; ++c) {
                u32x2v o; o.x = pg8::cvt_pk_bf16(S[0], S[1]); o.y = pg8::cvt_pk_bf16(S[2], S[3]);
                *(u32x2v*)(p1 + (size_t)(c0 + c) * 16384) = o;
                const f32x4 t = {__uint_as_float(tv[c].x << 16), __uint_as_float(tv[c].x & 0xffff0000u), __uint_as_float(tv[c].y << 16), __uint_as_float(tv[c].y & 0xffff0000u)};
                S = S * dv[c] + t;
            }
        }
        *(f32x4*)(out_p + (size_t)bh * 16384 + k * 128 + 16 * ((vp >> 2) & 7) + 4 * (vp >> 5)) = S;
    }
}

__device__ __forceinline__ void conv_phase(const bf16* P, const float* cw, const float* sconv, bf16* YM, float* conv_p, float* conv_s, int gtid, int gthreads) {
    for (int it = gtid; it < (MT / 4) * 64; it += gthreads) {
        const int row0 = (it >> 6) * 4, c = (it & 63) * 8;
        int t0, T, b; if (row0 < MP) { b = row0 >> 11; t0 = row0 & 2047; T = 2048; } else { const int r2 = row0 - MP; b = r2 >> 3; t0 = r2 & 7; T = 8; }
        const bool first = (t0 == 0);
        const bf16* pr = P + (size_t)row0 * PLD + c;
        u32x4v va[6], ca[6], ba[4];
#pragma unroll
        for (int q = 0; q < 6; ++q) { const int dq = (first && q < 2) ? 2 : q;
            va[q] = *(const u32x4v*)(pr + (long)(dq - 2) * PLD); ca[q] = *(const u32x4v*)(pr + (long)(dq - 2) * PLD + 1024); }
#pragma unroll
        for (int r = 0; r < 4; ++r) ba[r] = *(const u32x4v*)(pr + (long)r * PLD + 512);
        f32x4 w0[2], w1[2], w2[2];
#pragma unroll
        for (int h = 0; h < 2; ++h) { w0[h] = *(const f32x4*)(cw + c + 4 * h); w1[h] = *(const f32x4*)(cw + 512 + c + 4 * h); w2[h] = *(const f32x4*)(cw + 1024 + c + 4 * h); }
        f32x4 s0[2], s1[2];
#pragma unroll
        for (int h = 0; h < 2; ++h) { s0[h] = (f32x4){0.f, 0.f, 0.f, 0.f}; s1[h] = s0[h]; }
        if (first && row0 >= MP) {
#pragma unroll
            for (int h = 0; h < 2; ++h) { s0[h] = *(const f32x4*)(sconv + (b * 2 + 0) * 512 + c + 4 * h); s1[h] = *(const f32x4*)(sconv + (b * 2 + 1) * 512 + c + 4 * h); } }
        float u[6][8];
#pragma unroll
        for (int q = 0; q < 6; ++q) { float fa[8], fc[8]; unpack8(va[q], fa); unpack8(ca[q], fc);
#pragma unroll
            for (int j = 0; j < 8; ++j) u[q][j] = fc[j] * fa[j]; }
        if (first) {
#pragma unroll
            for (int j = 0; j < 8; ++j) { u[0][j] = s0[j >> 2][j & 3]; u[1][j] = s1[j >> 2][j & 3]; } }
#pragma unroll
        for (int r = 0; r < 4; ++r) {
            float fb[8], y[8]; unpack8(ba[r], fb);
#pragma unroll
            for (int j = 0; j < 8; ++j) y[j] = fb[j] * (w0[j >> 2][j & 3] * u[r][j] + w1[j >> 2][j & 3] * u[r + 1][j] + w2[j >> 2][j & 3] * u[r + 2][j]);
            u32x4v o; o.x = pk2(y[0], y[1]); o.y = pk2(y[2], y[3]); o.z = pk2(y[4], y[5]); o.w = pk2(y[6], y[7]);
            *(u32x4v*)(YM + (size_t)(row0 + r) * D + c) = o;
        }
        if (t0 + 4 == T) {
#pragma unroll
            for (int i = 0; i < 2; ++i) { float* op = ((row0 < MP) ? conv_p : conv_s) + (b * 2 + i) * 512 + c;
                *(f32x4*)op = (f32x4){u[4 + i][0], u[4 + i][1], u[4 + i][2], u[4 + i][3]}; *(f32x4*)(op + 4) = (f32x4){u[4 + i][4], u[4 + i][5], u[4 + i][6], u[4 + i][7]}; }
        }
    }
}

__device__ __forceinline__ float pd_mix(const bf16* P, int row, int t, int b, bool sample, int col  , const float* mu, const float* sshift) {
    const float cur = bf2f(P[(size_t)row * PLD + 2048 + col]);
    const float prev = (t > 0) ? bf2f(P[(size_t)(row - 1) * PLD + 2048 + col]) : (sample ? sshift[b * 1792 + col] : 0.f);
    return cur + mu[col] * (prev - cur);
}
__device__ __forceinline__ float ftanh(float x) { return 1.0f - 2.0f * __builtin_amdgcn_rcpf(1.0f + __builtin_amdgcn_exp2f(2.885390081777927f * x)); }
__device__ __forceinline__ void lora_prep_phase(const bf16* P, const float* mu, const float* sshift, bf16* AP, float* shift_p, float* shift_s, int gtid, int gthreads) {
    for (int it = gtid; it < (MT / 4) * 32; it += gthreads) {
        const int row0 = (it >> 5) * 4, j0 = (it & 31) * 8;
        int t0, b; bool sample; if (row0 < MP) { b = row0 >> 11; t0 = row0 & 2047; sample = false; } else { const int r2 = row0 - MP; b = r2 >> 3; t0 = r2 & 7; sample = true; }
        const bf16* pr = P + (size_t)row0 * PLD + 2048 + 1536 + j0;
        u32x4v rv[5];
#pragma unroll
        for (int q = 0; q < 5; ++q) { const int dq = (t0 == 0 && q == 0) ? 1 : q; rv[q] = *(const u32x4v*)(pr + (long)(dq - 1) * PLD); }
        const f32x4 m0 = *(const f32x4*)(mu + 1536 + j0), m1 = *(const f32x4*)(mu + 1536 + j0 + 4);
        f32x4 h0 = (f32x4){0.f, 0.f, 0.f, 0.f}, h1 = h0;
        if (t0 == 0 && sample) { h0 = *(const f32x4*)(sshift + b * 1792 + 1536 + j0); h1 = *(const f32x4*)(sshift + b * 1792 + 1536 + j0 + 4); }
        float prv[8];
        if (t0 == 0) {
#pragma unroll
            for (int j = 0; j < 8; ++j) prv[j] = (j < 4) ? h0[j & 3] : h1[j & 3];
        } else unpack8(rv[0], prv);
#pragma unroll
        for (int r = 0; r < 4; ++r) {
            float cur[8], y[8]; unpack8(rv[r + 1], cur);
#pragma unroll
            for (int j = 0; j < 8; ++j) { const float x = cur[j] + ((j < 4) ? m0[j & 3] : m1[j & 3]) * (prv[j] - cur[j]); y[j] = (j0 < 64) ? ftanh(x) : (j0 < 128) ? x : fsig(x); prv[j] = cur[j]; }
            u32x4v o; o.x = pk2(y[0], y[1]); o.y = pk2(y[2], y[3]); o.z = pk2(y[4], y[5]); o.w = pk2(y[6], y[7]);
            *(u32x4v*)(AP + (size_t)(row0 + r) * 256 + j0) = o;
        }
    }
    for (int e = gtid; e < (8 + 128) * 1792; e += gthreads) {
        const int bb = e / 1792, col = e % 1792;
        if (bb < 8) shift_p[e] = bf2f(P[(size_t)(bb * 2048 + 2047) * PLD + 2048 + col]);
        else shift_s[(bb - 8) * 1792 + col] = bf2f(P[(size_t)(MP + (bb - 8) * 8 + 7) * PLD + 2048 + col]);
    }
}

typedef float f32x2 __attribute__((ext_vector_type(2)));
struct RwkvPar { float w0, a0, k_k, k_a, r_k, lng, lnb; };
struct RwkvRaw { float r, kd, vd, lw, la, gt; };
__device__ __forceinline__ RwkvRaw rwkv_load_raw(const bf16* P, const bf16* LB, const float* mu, const float* sshift, int row, int t, int b, bool sample, int hc) {
    RwkvRaw x;
    x.r = pd_mix(P, row, t, b, sample, hc, mu, sshift);
    x.kd = pd_mix(P, row, t, b, sample, 512 + hc, mu, sshift);
    x.vd = pd_mix(P, row, t, b, sample, 1024 + hc, mu, sshift);
    x.lw = bf2f(LB[(size_t)row * 1536 + hc]); x.la = bf2f(LB[(size_t)row * 1536 + 512 + hc]); x.gt = bf2f(LB[(size_t)row * 1536 + 1024 + hc]);
    return x;
}
__device__ __forceinline__ RwkvPar rwkv_params(ArgsP a, int hc) {
    RwkvPar p; p.w0 = a->in[I_W0][hc]; p.a0 = a->in[I_A0][hc]; p.k_k = a->in[I_KK][hc]; p.k_a = a->in[I_KA][hc]; p.r_k = a->in[I_RK][hc]; p.lng = a->in[I_LNG][hc]; p.lnb = a->in[I_LNB][hc]; return p;
}

constexpr int NRCP = 8192, NRC = 9216;
constexpr int REC_BYTES = 18432, REC_Q1T = 0, REC_Q2T = 2176, REC_GT = 2944, REC_HT = 11648, REC_VT = 14720, REC_GC = 17792;
__device__ __forceinline__ void rwkv_r1_unit4(int cu4, ArgsP a, const bf16* P, const bf16* LB, unsigned char* RREC, float* RGB, LAS unsigned char* lds, int tid) {
    constexpr int RL = 68;
    const int lane = tid & 63, g4 = __builtin_amdgcn_readfirstlane(tid >> 7), wl = __builtin_amdgcn_readfirstlane((tid >> 6) & 1), tg = tid & 127;
    const int cu = cu4 * 4 + g4;
    const bool sample = cu >= NRCP;
    int b, h, row0, t0, ntok;
    if (!sample) { const int bh = cu >> 7, c = cu & 127; b = bh >> 3; h = bh & 7; row0 = b * 2048 + c * 16; t0 = c * 16; ntok = 16; }
    else { const int bh = cu - NRCP; b = bh >> 3; h = bh & 7; row0 = MP + b * 8; t0 = 0; ntok = 8; }
    const int hc = h * 64 + lane;
    LAS float* base = (LAS float*)(lds + g4 * 34816);
    LAS float* Rr = base; LAS float* Kk = Rr + 16 * RL; LAS float* Aa = Kk + 16 * RL; LAS float* Bb = Aa + 16 * RL;
    LAS float* Ww = Bb + 16 * RL;
    LAS float* MAT = Ww;
    LAS float* TT = MAT + 1024;
    LAS float* P2 = TT + 256;
    LAS float* P1 = P2 + 256;
    LAS float* GC = P1 + 1088;
    LAS float* Vv = GC + 64;
    unsigned char* rec = RREC + (size_t)cu * REC_BYTES;
    bf16* q1t = (bf16*)(rec + REC_Q1T); bf16* q2t = (bf16*)(rec + REC_Q2T); bf16* gt = (bf16*)(rec + REC_GT); bf16* ht = (bf16*)(rec + REC_HT); bf16* vt = (bf16*)(rec + REC_VT);
    {
        const int tt = lane >> 3, c0 = 8 * (lane & 7), hc0 = h * 64 + c0, tl = wl * 8 + tt;
        const bool live = tl < ntok;
        const int row = row0 + (live ? tl : 0), t = t0 + (live ? tl : 0);
        const bf16* pr = P + (size_t)row * PLD + 2048 + hc0; const bf16* lr = LB + (size_t)row * 1536 + hc0;
        const bool hasprev = t > 0;
        const bf16* pp = hasprev ? pr - PLD : pr;
        u32x4v cw[3], pw[3], lw_[3];
#pragma unroll
        for (int g = 0; g < 3; ++g) { cw[g] = *(const u32x4v*)(pr + 512 * g); pw[g] = *(const u32x4v*)(pp + 512 * g); lw_[g] = *(const u32x4v*)(lr + 512 * g); }
        const float* mu = a->in[I_MU];
        f32x4 mv[3][2], sh[3][2];
#pragma unroll
        for (int g = 0; g < 3; ++g)
#pragma unroll
            for (int hq = 0; hq < 2; ++hq) { mv[g][hq] = *(const f32x4*)(mu + 512 * g + hc0 + 4 * hq); sh[g][hq] = (f32x4){0.f, 0.f, 0.f, 0.f}; }
        if (!hasprev && sample) {
#pragma unroll
            for (int g = 0; g < 3; ++g)
#pragma unroll
                for (int hq = 0; hq < 2; ++hq) sh[g][hq] = *(const f32x4*)(a->in[I_SSHIFT] + (size_t)b * 1792 + 512 * g + hc0 + 4 * hq);
        }
        f32x4 pw0[2], pa0[2], pkk[2], pka[2], prk[2];
#pragma unroll
        for (int hq = 0; hq < 2; ++hq) { pw0[hq] = *(const f32x4*)(a->in[I_W0] + hc0 + 4 * hq); pa0[hq] = *(const f32x4*)(a->in[I_A0] + hc0 + 4 * hq); pkk[hq] = *(const f32x4*)(a->in[I_KK] + hc0 + 4 * hq);
            pka[hq] = *(const f32x4*)(a->in[I_KA] + hc0 + 4 * hq); prk[hq] = *(const f32x4*)(a->in[I_RK] + hc0 + 4 * hq); }
        float xr[8], xk[8], xv[8], xlw[8], xla[8], xgt[8];
        {
            float cur[8], prv[8];
#pragma unroll
            for (int g = 0; g < 3; ++g) {
                unpack8(cw[g], cur); unpack8(pw[g], prv);
#pragma unroll
                for (int j = 0; j < 8; ++j) { const float pv = hasprev ? prv[j] : sh[g][j >> 2][j & 3]; const float m = mv[g][j >> 2][j & 3]; const float y = cur[j] + m * (pv - cur[j]);
                    if (g == 0) xr[j] = y; else if (g == 1) xk[j] = y; else xv[j] = y; }
            }
            unpack8(lw_[0], xlw); unpack8(lw_[1], xla); unpack8(lw_[2], xgt);
        }
        float wd[8], km[8], av_[8], bv_[8], kkr[8], asg[8];
        float n2 = 0.f, cf = 0.f;
#pragma unroll
        for (int j = 0; j < 8; ++j) {
            const float z = -(pw0[j >> 2][j & 3] + xlw[j]);
            const float sp = (z > 20.f) ? z : flog(1.f + fexp(z));
            wd[j] = fexp(-fexp(-sp - 0.5f));
            asg[j] = fsig(pa0[j >> 2][j & 3] + xla[j]);
            kkr[j] = xk[j] * pkk[j >> 2][j & 3]; n2 += kkr[j] * kkr[j];
            km[j] = xk[j] * (1.f + (asg[j] - 1.f) * pka[j >> 2][j & 3]);
            cf += xr[j] * km[j] * prk[j >> 2][j & 3];
        }
        n2 += dpp_f<0xB1>(n2); n2 += dpp_f<0x4E>(n2); n2 += dpp_f<0x141>(n2);
        cf += dpp_f<0xB1>(cf); cf += dpp_f<0x4E>(cf); cf += dpp_f<0x141>(cf);
        const float inrm = 1.0f / fmaxf(sqrtf(n2), 1e-12f);
#pragma unroll
        for (int j = 0; j < 8; ++j) { const float kk = kkr[j] * inrm; av_[j] = -kk; bv_[j] = kk * asg[j]; }
        if (live) {
            u32x4v g0, g1;
            g0.x = pk2(xgt[0], cf * xv[0]); g0.y = pk2(xgt[1], cf * xv[1]); g0.z = pk2(xgt[2], cf * xv[2]); g0.w = pk2(xgt[3], cf * xv[3]);
            g1.x = pk2(xgt[4], cf * xv[4]); g1.y = pk2(xgt[5], cf * xv[5]); g1.z = pk2(xgt[6], cf * xv[6]); g1.w = pk2(xgt[7], cf * xv[7]);
            unsigned* gp = (unsigned*)RGB + ((size_t)cu * 16 + tl) * 64 + c0;
            *(u32x4v*)gp = g0; *(u32x4v*)(gp + 4) = g1;
        } else {
#pragma unroll
            for (int j = 0; j < 8; ++j) { xr[j] = 0.f; wd[j] = 1.f; km[j] = 0.f; xv[j] = 0.f; av_[j] = 0.f; bv_[j] = 0.f; }
        }
#pragma unroll
        for (int hq = 0; hq < 2; ++hq) {
            *(LAS f32x4*)(Rr + tl * RL + c0 + 4 * hq) = (f32x4){xr[4 * hq], xr[4 * hq + 1], xr[4 * hq + 2], xr[4 * hq + 3]};
            *(LAS f32x4*)(Ww + tl * 64 + c0 + 4 * hq) = (f32x4){wd[4 * hq], wd[4 * hq + 1], wd[4 * hq + 2], wd[4 * hq + 3]};
            *(LAS f32x4*)(Kk + tl * RL + c0 + 4 * hq) = (f32x4){km[4 * hq], km[4 * hq + 1], km[4 * hq + 2], km[4 * hq + 3]};
            *(LAS f32x4*)(Aa + tl * RL + c0 + 4 * hq) = (f32x4){av_[4 * hq], av_[4 * hq + 1], av_[4 * hq + 2], av_[4 * hq + 3]};
            *(LAS f32x4*)(Bb + tl * RL + c0 + 4 * hq) = (f32x4){bv_[4 * hq], bv_[4 * hq + 1], bv_[4 * hq + 2], bv_[4 * hq + 3]};
            *(LAS f32x4*)(Vv + tl * 64 + c0 + 4 * hq) = (f32x4){xv[4 * hq], xv[4 * hq + 1], xv[4 * hq + 2], xv[4 * hq + 3]};
        }
    }
    __syncthreads();
    if (tg < 64) {
        const int k = tg; float g = 1.f;
#pragma unroll
        for (int t = 0; t < 16; ++t) {
            const float gp = g; g *= Ww[t * 64 + k]; const float inv = 1.0f / g;
            Aa[t * RL + k] *= gp; Bb[t * RL + k] *= inv; Kk[t * RL + k] *= inv; Rr[t * RL + k] *= g;
        }
        GC[k] = g; ((float*)(rec + REC_GC))[k] = g;
    }
    __syncthreads();
    const int ij = lane & 15, kq = lane >> 4;
    {
        f32x4 cm[2];
#pragma unroll
        for (int mm = 0; mm < 2; ++mm) {
            const int m = 2 * wl + mm;
            const LAS float* X = ((m & 1) ? Kk : Bb) + ij * RL; const LAS float* Y = ((m & 2) ? Rr : Aa) + ij * RL;
            f32x4 cacc = (f32x4){0.f, 0.f, 0.f, 0.f};
#pragma unroll
            for (int s_ = 0; s_ < 16; ++s_) cacc = __builtin_amdgcn_mfma_f32_16x16x4f32(X[4 * s_ + kq], Y[4 * s_ + kq], cacc, 0, 0, 0);
            cm[mm] = cacc;
        }
#pragma unroll
        for (int mm = 0; mm < 2; ++mm) { const int m = 2 * wl + mm;
#pragma unroll
            for (int r = 0; r < 4; ++r) { const int i = 4 * kq + r, t = ij; const bool keep = (m & 2) ? (i <= t) : (i < t); MAT[m * 256 + i * 16 + t] = keep ? cm[mm][r] : 0.f; } }
    }
    __syncthreads();
    if (tg < 16) {
        const int i = tg; float x[16];
#pragma unroll
        for (int t = 0; t < 16; ++t) {
            float acc = (i == t) ? 1.f : 0.f;
#pragma unroll
            for (int j = 0; j < 16; ++j) if (j < t) acc += x[j] * MAT[j * 16 + t];
            x[t] = acc;
        }
#pragma unroll
        for (int t = 0; t < 16; ++t) TT[i * 16 + t] = x[t];
    }
    __syncthreads();
    {
#pragma unroll
        for (int q = 0; q < 2; ++q) {
            const int k0 = 16 * (2 * wl + q); f32x4 cacc = (f32x4){0.f, 0.f, 0.f, 0.f};
#pragma unroll
            for (int s_ = 0; s_ < 4; ++s_) { const int j = 4 * s_ + kq; cacc = __builtin_amdgcn_mfma_f32_16x16x4f32(Aa[j * RL + k0 + ij], TT[j * 16 + ij], cacc, 0, 0, 0); }
#pragma unroll
            for (int r = 0; r < 4; ++r) P1[(k0 + 4 * kq + r) * 17 + ij] = cacc[r];
        }
        if (wl == 0) {
            f32x4 cacc = (f32x4){0.f, 0.f, 0.f, 0.f};
#pragma unroll
            for (int s_ = 0; s_ < 4; ++s_) { const int j = 4 * s_ + kq; cacc = __builtin_amdgcn_mfma_f32_16x16x4f32(MAT[256 + ij * 16 + j], TT[j * 16 + ij], cacc, 0, 0, 0); }
#pragma unroll
            for (int r = 0; r < 4; ++r) P2[(4 * kq + r) * 16 + ij] = cacc[r];
        }
    }
    __syncthreads();
    {
#pragma unroll
        for (int q = 0; q < 2; ++q) {
            const int k0 = 16 * (2 * wl + q);
            f32x4 cacc; { const f32x4 r4 = *(const LAS f32x4*)(Rr + ij * RL + k0 + 4 * kq); cacc = r4; }
#pragma unroll
            for (int s_ = 0; s_ < 4; ++s_) { const int j = 4 * s_ + kq; cacc = __builtin_amdgcn_mfma_f32_16x16x4f32(P1[(k0 + ij) * 17 + j], MAT[512 + j * 16 + ij], cacc, 0, 0, 0); }
            u32x2v w; w.x = pk2(cacc[0], cacc[1]); w.y = pk2(cacc[2], cacc[3]);
            *(u32x2v*)(q1t + ij * 68 + k0 + 4 * kq) = w;
        }
        if (wl == 1) {
            f32x4 cacc;
#pragma unroll
            for (int r = 0; r < 4; ++r) cacc[r] = MAT[768 + (4 * kq + r) * 16 + ij];
#pragma unroll
            for (int s_ = 0; s_ < 4; ++s_) { const int j = 4 * s_ + kq; cacc = __builtin_amdgcn_mfma_f32_16x16x4f32(P2[ij * 16 + j], MAT[512 + j * 16 + ij], cacc, 0, 0, 0); }
            u32x2v w; w.x = pk2(cacc[0], cacc[1]); w.y = pk2(cacc[2], cacc[3]);
            *(u32x2v*)(q2t + ij * 24 + 4 * kq) = w;
        }
#pragma unroll
        for (int q = 0; q < 2; ++q) {
            const int k0 = 16 * (2 * wl + q); f32x4 cacc;
#pragma unroll
            for (int r = 0; r < 4; ++r) cacc[r] = Kk[(4 * kq + r) * RL + k0 + ij];
#pragma unroll
            for (int s_ = 0; s_ < 4; ++s_) { const int j = 4 * s_ + kq; cacc = __builtin_amdgcn_mfma_f32_16x16x4f32(P2[ij * 16 + j], Bb[j * RL + k0 + ij], cacc, 0, 0, 0); }
            const float gcv = GC[k0 + ij];
            u32x2v w; w.x = pk2(cacc[0] * gcv, cacc[1] * gcv); w.y = pk2(cacc[2] * gcv, cacc[3] * gcv);
            *(u32x2v*)(ht + (k0 + ij) * 24 + 4 * kq) = w;
        }
        { const int v = tg >> 1, hf = tg & 1; u32x4v o; o.x = pk2(Vv[(8 * hf + 0) * 64 + v], Vv[(8 * hf + 1) * 64 + v]); o.y = pk2(Vv[(8 * hf + 2) * 64 + v], Vv[(8 * hf + 3) * 64 + v]);
          o.z = pk2(Vv[(8 * hf + 4) * 64 + v], Vv[(8 * hf + 5) * 64 + v]); o.w = pk2(Vv[(8 * hf + 6) * 64 + v], Vv[(8 * hf + 7) * 64 + v]); *(u32x4v*)(vt + v * 24 + 8 * hf) = o; }
#pragma unroll
        for (int q = 0; q < 2; ++q) {
            const int kk0 = 16 * (2 * wl + q);
            float pa[4];
#pragma unroll
            for (int s_ = 0; s_ < 4; ++s_) pa[s_] = P1[(kk0 + ij) * 17 + 4 * s_ + kq];
#pragma unroll
            for (int kt = 0; kt < 4; ++kt) {
                const int k0 = 16 * kt; f32x4 cacc = (f32x4){0.f, 0.f, 0.f, 0.f};
#pragma unroll
                for (int s_ = 0; s_ < 4; ++s_) { const int j = 4 * s_ + kq; cacc = __builtin_amdgcn_mfma_f32_16x16x4f32(pa[s_], Bb[j * RL + k0 + ij], cacc, 0, 0, 0); }
                const float gcv = GC[k0 + ij];
                u32x2v w; w.x = pk2(cacc[0] * gcv, cacc[1] * gcv); w.y = pk2(cacc[2] * gcv, cacc[3] * gcv);
                *(u32x2v*)(gt + (k0 + ij) * 68 + kk0 + 4 * kq) = w;
            }
        }
    }
    __syncthreads();
}
struct R2Frags { bf16x8 q1[2][2], q2, g[2][2][2], hq[2], v; };
__device__ __forceinline__ void rwkv_r2_load(R2Frags& F, const LAS unsigned char* rec, int vt, int r32, int hh) {
    F.v = *(const LAS bf16x8*)(rec + REC_VT + (32 * vt + r32) * 48 + 16 * hh);
    const int cr = r32 & 15;
#pragma unroll
    for (int kt = 0; kt < 2; ++kt)
#pragma unroll
        for (int sp = 0; sp < 2; ++sp) {
            const LAS unsigned char* p = rec + REC_Q1T + cr * 136 + (32 * kt + 16 * sp + 4 * hh) * 2;
            const s16x4 lo = *(const LAS s16x4*)p, hi = *(const LAS s16x4*)(p + 16);
            F.q1[kt][sp] = (bf16x8){lo[0], lo[1], lo[2], lo[3], hi[0], hi[1], hi[2], hi[3]};
        }
    F.q2 = *(const LAS bf16x8*)(rec + REC_Q2T + cr * 48 + 16 * hh);
#pragma unroll
    for (int kp = 0; kp < 2; ++kp) {
#pragma unroll
        for (int kt = 0; kt < 2; ++kt)
#pragma unroll
            for (int sp = 0; sp < 2; ++sp) {
                const LAS unsigned char* p = rec + REC_GT + (32 * kp + r32) * 136 + (32 * kt + 16 * sp + 4 * hh) * 2;
                const s16x4 lo = *(const LAS s16x4*)p, hi = *(const LAS s16x4*)(p + 16);
                F.g[kp][kt][sp] = (bf16x8){lo[0], lo[1], lo[2], lo[3], hi[0], hi[1], hi[2], hi[3]};
            }
        F.hq[kp] = *(const LAS bf16x8*)(rec + REC_HT + (32 * kp + r32) * 48 + 16 * hh);
    }
}
__device__ __forceinline__ void rwkv_r2_issue(const R2Frags& F, const LAS unsigned char* rec, int hh, f32x16 (&Sacc)[2], f32x16& O) {
    const LAS float* gcp = (const LAS float*)(rec + REC_GC);
    bf16x8 Sb[2][2];
#pragma unroll
    for (int kt = 0; kt < 2; ++kt)
#pragma unroll
        for (int sp = 0; sp < 2; ++sp) {
            u32x4v pw; pw.x = pg8::cvt_pk_bf16(Sacc[kt][8 * sp + 0], Sacc[kt][8 * sp + 1]); pw.y = pg8::cvt_pk_bf16(Sacc[kt][8 * sp + 2], Sacc[kt][8 * sp + 3]);
            pw.z = pg8::cvt_pk_bf16(Sacc[kt][8 * sp + 4], Sacc[kt][8 * sp + 5]); pw.w = pg8::cvt_pk_bf16(Sacc[kt][8 * sp + 6], Sacc[kt][8 * sp + 7]);
            Sb[kt][sp] = __builtin_bit_cast(bf16x8, pw);
        }
#pragma unroll
    for (int kt = 0; kt < 2; ++kt)
#pragma unroll
        for (int g = 0; g < 4; ++g) { const f32x4 g4 = *(const LAS f32x4*)(gcp + 32 * kt + 8 * g + 4 * hh); Sacc[kt][4 * g + 0] *= g4.x; Sacc[kt][4 * g + 1] *= g4.y; Sacc[kt][4 * g + 2] *= g4.z; Sacc[kt][4 * g + 3] *= g4.w; }
#pragma unroll
    for (int r = 0; r < 16; ++r) O[r] = 0.f;
#pragma unroll
    for (int kt = 0; kt < 2; ++kt)
#pragma unroll
        for (int sp = 0; sp < 2; ++sp) {
            O = __builtin_amdgcn_mfma_f32_32x32x16_bf16(F.q1[kt][sp], Sb[kt][sp], O, 0, 0, 0);
            Sacc[0] = __builtin_amdgcn_mfma_f32_32x32x16_bf16(F.g[0][kt][sp], Sb[kt][sp], Sacc[0], 0, 0, 0);
            Sacc[1] = __builtin_amdgcn_mfma_f32_32x32x16_bf16(F.g[1][kt][sp], Sb[kt][sp], Sacc[1], 0, 0, 0);
        }
    O = __builtin_amdgcn_mfma_f32_32x32x16_bf16(F.q2, F.v, O, 0, 0, 0);
    Sacc[0] = __builtin_amdgcn_mfma_f32_32x32x16_bf16(F.hq[0], F.v, Sacc[0], 0, 0, 0);
    Sacc[1] = __builtin_amdgcn_mfma_f32_32x32x16_bf16(F.hq[1], F.v, Sacc[1], 0, 0, 0);
}
__device__ __forceinline__ void rwkv_r2_store(const f32x16& O, LAS float* ob, int vt, int r32, int hh) {
#pragma unroll
    for (int r = 0; r < 8; ++r) ob[((r & 3) + 8 * (r >> 2) + 4 * hh) * 64 + 32 * vt + r32] = O[r];
}
__device__ __forceinline__ void rwkv_r2_step(const LAS unsigned char* rec, f32x16 (&Sacc)[2], LAS float* ob, int vt, int r32, int hh) {
    R2Frags F; f32x16 O; rwkv_r2_load(F, rec, vt, r32, hh); rwkv_r2_issue(F, rec, hh, Sacc, O); rwkv_r2_store(O, ob, vt, r32, hh);
}
__device__ __forceinline__ void rwkv_r2_post(const LAS float* ob, const float* gbp, const RwkvPar& pr, bf16* YM, int row, int hc, int lane) {
    const unsigned gbw = ((const unsigned*)gbp)[lane]; const float gt = __uint_as_float(gbw << 16), bon = __uint_as_float(gbw & 0xffff0000u);
    const float o = ob[lane];
    const float mean = wave_sum(o) * (1.0f / 64.0f); const float dlt = o - mean;
    const float var = wave_sum(dlt * dlt) * (1.0f / 64.0f);
    const float on = dlt * __builtin_amdgcn_rsqf(var + 64e-5f) * pr.lng + pr.lnb;
    YM[(size_t)row * D + 512 + hc] = (bf16)f2bf((on + bon) * gt);
}
__device__ __forceinline__ float xchg32(float send, bool hi) { unsigned a_ = __float_as_uint(send), b_ = a_; asm volatile("" : "+v"(b_)); auto rr = __builtin_amdgcn_permlane32_swap(a_, b_, false, false); return __uint_as_float(hi ? rr[0] : rr[1]); }
__device__ __forceinline__ float xchg16(float send, bool hi) { unsigned a_ = __float_as_uint(send), b_ = a_; asm volatile("" : "+v"(b_)); auto rr = __builtin_amdgcn_permlane16_swap(a_, b_, false, false); return __uint_as_float(hi ? rr[0] : rr[1]); }
__device__ __forceinline__ float reduce8(const float (&v)[8], int lane) {
    float v4[4], v2[2];
    const bool h32 = lane & 32, h16 = lane & 16, h8 = lane & 8;
#pragma unroll
    for (int i = 0; i < 4; ++i) { const float send = h32 ? v[i] : v[i + 4], keep = h32 ? v[i + 4] : v[i]; v4[i] = keep + xchg32(send, h32); }
#pragma unroll
    for (int i = 0; i < 2; ++i) { const float send = h16 ? v4[i] : v4[i + 2], keep = h16 ? v4[i + 2] : v4[i]; v2[i] = keep + xchg16(send, h16); }
    const float send = h8 ? v2[0] : v2[1], keep = h8 ? v2[1] : v2[0];
    float r = keep + dpp_f<0x128>(send);
    r += dpp_f<0xB1>(r); r += dpp_f<0x4E>(r); r += dpp_f<0x141>(r);
    return r;
}
#define R2_BAR() asm volatile("s_waitcnt lgkmcnt(0)\n\ts_barrier" ::: "memory")
template <bool DO_POST = true> __device__ __forceinline__ void rwkv_r2_prompt(int b, int h, ArgsP a, const unsigned char* RREC, const float* RGB, bf16* YM, LAS unsigned char* lds, int tid) {
    const int lane = tid & 63, wave = __builtin_amdgcn_readfirstlane(tid >> 6), r32 = lane & 31, hh = lane >> 5;
    const int cu0 = (b * 8 + h) * 128, hc = h * 64 + lane;
    LAS unsigned char* recb = lds;
    LAS float* obuf = (LAS float*)(lds + 7 * REC_BYTES);
    const RwkvPar pr = rwkv_params(a, hc);
    f32x16 Sacc[2];
#pragma unroll
    for (int kt = 0; kt < 2; ++kt)
#pragma unroll
        for (int r = 0; r < 16; ++r) Sacc[kt][r] = 0.f;
    for (int i = tid; i < 6 * REC_BYTES / 16; i += NTHR) *(LAS u32x4v*)(recb + i * 16) = *(const u32x4v*)(RREC + (size_t)cu0 * REC_BYTES + i * 16);
    LAS unsigned* gbuf = (LAS unsigned*)(lds + PRM_OFF);
    for (int i = tid; i < 3 * 4096 / 16; i += NTHR) *(LAS u32x4v*)((LAS unsigned char*)gbuf + i * 16) = *(const u32x4v*)((const unsigned char*)RGB + (size_t)cu0 * 4096 + i * 16);
    __syncthreads();
    if (wave < 2) {
        __builtin_amdgcn_s_setprio(3);
        R2Frags F0, F1;
        rwkv_r2_load(F0, recb, wave, r32, hh);
#define R2_SCAN(c, FC, FN) do { \
            f32x16 O_; rwkv_r2_issue(FC, recb + ((c) % 7) * REC_BYTES, hh, Sacc, O_); \
            asm volatile("" ::: "memory");        \
            if ((c) + 1 < 128) rwkv_r2_load(FN, recb + (((c) + 1) % 7) * REC_BYTES, wave, r32, hh);         \
            rwkv_r2_store(O_, obuf + ((c) & 1) * 1024, wave, r32, hh); \
            R2_BAR(); \
        } while (0)
#pragma unroll 1
        for (int c = 0; c < 128; c += 2) { R2_SCAN(c, F0, F1); R2_SCAN(c + 1, F1, F0); }
#undef R2_SCAN
        __builtin_amdgcn_s_setprio(0);
    } else if (wave < 6) {
        R2_BAR();
#pragma unroll 1
        for (int c = 1; c < 128; ++c) {
            if (DO_POST) {
                const LAS float* ob = obuf + ((c & 1) ^ 1) * 1024; const LAS unsigned* gb = gbuf + ((c - 1) % 5) * 1024;
                float o[4]; unsigned gw[4]; float part[8];
#pragma unroll
                for (int tt = 0; tt < 4; ++tt) { const int tl = (wave - 2) * 4 + tt; o[tt] = ob[tl * 64 + lane]; gw[tt] = gb[tl * 64 + lane]; part[2 * tt] = o[tt]; part[2 * tt + 1] = o[tt] * o[tt]; }
                const int red = __builtin_bit_cast(int, reduce8(part, lane));
#pragma unroll
                for (int tt = 0; tt < 4; ++tt) {
                    const int tl = (wave - 2) * 4 + tt;
                    const int i1 = 2 * tt, i2 = 2 * tt + 1;
                    const float s1 = __builtin_bit_cast(float, __builtin_amdgcn_readlane(red, ((i1 & 4) ? 32 : 0) + ((i1 & 2) ? 16 : 0) + ((i1 & 1) ? 8 : 0)));
                    const float s2 = __builtin_bit_cast(float, __builtin_amdgcn_readlane(red, ((i2 & 4) ? 32 : 0) + ((i2 & 2) ? 16 : 0) + ((i2 & 1) ? 8 : 0)));
                    const float mean = s1 * (1.0f / 64.0f), var = fmaxf(s2 * (1.0f / 64.0f) - mean * mean, 0.f);
                    const float on = (o[tt] - mean) * __builtin_amdgcn_rsqf(var + 64e-5f) * pr.lng + pr.lnb;
                    YM[(size_t)(b * 2048 + (c - 1) * 16 + tl) * D + 512 + hc] = (bf16)f2bf((on + __uint_as_float(gw[tt] & 0xffff0000u)) * __uint_as_float(gw[tt] << 16));
                }
            }
            R2_BAR();
        }
    } else {
        const int lw = wave - 6;
#pragma unroll 1
        for (int c = 0; c < 128; ++c) {
            if (c + 3 < 128) {
                const unsigned char* src = (const unsigned char*)RGB + (size_t)(cu0 + c + 3) * 4096 + lw * 2048 + lane * 16;
                LAS unsigned char* dst = (LAS unsigned char*)gbuf + ((c + 3) % 5) * 4096 + lw * 2048;
#pragma unroll
                for (int q = 0; q < 2; ++q) __builtin_amdgcn_global_load_lds((const unsigned*)(src + q * 1024), (LAS unsigned*)(dst + q * 1024), 16, 0, 0);
            }
            if (c + 6 < 128) {
                const unsigned char* src = RREC + (size_t)(cu0 + c + 6) * REC_BYTES + lw * 9216 + lane * 16;
                LAS unsigned char* dst = recb + ((c + 6) % 7) * REC_BYTES + lw * 9216;
#pragma unroll
                for (int q = 0; q < 9; ++q) __builtin_amdgcn_global_load_lds((const unsigned*)(src + q * 1024), (LAS unsigned*)(dst + q * 1024), 16, 0, 0);
                asm volatile("s_waitcnt vmcnt(42)" ::: "memory");
            } else asm volatile("s_waitcnt vmcnt(0)" ::: "memory");
            R2_BAR();
        }
    }
    __syncthreads();
#pragma unroll
    for (int tt = 0; tt < 2; ++tt) { const int tl = wave * 2 + tt; if (DO_POST) rwkv_r2_post(obuf + 1024 + tl * 64, RGB + ((size_t)(cu0 + 127) * 16 + tl) * 64, pr, YM, b * 2048 + 127 * 16 + tl, hc, lane); }
    if (wave < 2) {
        float* sp = a->out + O_RWKVP + (((size_t)b * 8 + h) * 64 + 32 * wave + r32) * 64;
#pragma unroll
        for (int kt = 0; kt < 2; ++kt)
#pragma unroll
            for (int g = 0; g < 4; ++g) *(f32x4*)(sp + 32 * kt + 8 * g + 4 * hh) = (f32x4){Sacc[kt][4 * g], Sacc[kt][4 * g + 1], Sacc[kt][4 * g + 2], Sacc[kt][4 * g + 3]};
    }
    __syncthreads();
}
__device__ __forceinline__ void rwkv_r2_sample(int b, int h, ArgsP a, const unsigned char* RREC, const float* RGB, bf16* YM, LAS unsigned char* lds, int tid) {
    const int lane = tid & 63, wave = __builtin_amdgcn_readfirstlane(tid >> 6), r32 = lane & 31, hh = lane >> 5;
    const int cu = NRCP + b * 8 + h, hc = h * 64 + lane;
    LAS unsigned char* recb = lds; LAS float* obuf = (LAS float*)(lds + REC_BYTES);
    for (int i = tid; i < REC_BYTES / 16; i += NTHR) *(LAS u32x4v*)(recb + i * 16) = *(const u32x4v*)(RREC + (size_t)cu * REC_BYTES + i * 16);
    f32x16 Sacc[2];
    if (wave < 2) {
        const float* sp = a->in[I_SRWKV] + (((size_t)b * 8 + h) * 64 + 32 * wave + r32) * 64;
#pragma unroll
        for (int kt = 0; kt < 2; ++kt)
#pragma unroll
            for (int g = 0; g < 4; ++g) { const f32x4 x = *(const f32x4*)(sp + 32 * kt + 8 * g + 4 * hh); Sacc[kt][4 * g] = x.x; Sacc[kt][4 * g + 1] = x.y; Sacc[kt][4 * g + 2] = x.z; Sacc[kt][4 * g + 3] = x.w; }
    }
    __syncthreads();
    if (wave < 2) {
        rwkv_r2_step(recb, Sacc, obuf, wave, r32, hh);
        float* sp = a->out + O_RWKVS + (((size_t)b * 8 + h) * 64 + 32 * wave + r32) * 64;
#pragma unroll
        for (int kt = 0; kt < 2; ++kt)
#pragma unroll
            for (int g = 0; g < 4; ++g) *(f32x4*)(sp + 32 * kt + 8 * g + 4 * hh) = (f32x4){Sacc[kt][4 * g], Sacc[kt][4 * g + 1], Sacc[kt][4 * g + 2], Sacc[kt][4 * g + 3]};
    }
    __syncthreads();
    { const RwkvPar pr = rwkv_params(a, hc); rwkv_r2_post(obuf + wave * 64, RGB + ((size_t)cu * 16 + wave) * 64, pr, YM, MP + b * 8 + wave, hc, lane); }
    __syncthreads();
}

template <int S> __device__ __forceinline__ void tail_combine(int mode, const bf16* slab, bf16* xb, pg8::ssq_t* ssq_out, float scale, bf16* O, int ldc, const pg8::ssq_t* ssq_in,
                                             int bxl, int Gl, int tid) {
    const int lane = tid & 63, w = tid >> 6, ai = w >> 2, m = w & 3, fr = lane & 15, fq = lane >> 4;
    for (int task = bxl; task < 128; task += Gl) {
        const int tile = task >> 3, wid = task & 7, pm = tile >> 2, pn = tile & 3, wr = wid >> 2, wc = wid & 3;
        f32x4 v[2][2];
#pragma unroll
        for (int bj = 0; bj < 2; ++bj)
#pragma unroll
            for (int n = 0; n < 2; ++n) v[bj][n] = (f32x4){0.f, 0.f, 0.f, 0.f};
        u32x2v ld[S][2][2];
#pragma unroll
        for (int ks = 0; ks < S; ++ks) {
            const bf16* sp = slab + ((size_t)(tile * S + ks) * 8 + wid) * (32 * 64 * 4) + lane * 4;
#pragma unroll
            for (int bj = 0; bj < 2; ++bj)
#pragma unroll
                for (int n = 0; n < 2; ++n) {
                    const unsigned long long q_ = __hip_atomic_load((const unsigned long long*)(sp + (((ai * 2 + bj) * 4 + m) * 2 + n) * 256), __ATOMIC_RELAXED, __HIP_MEMORY_SCOPE_AGENT);
                    ld[ks][bj][n].x = (unsigned)q_; ld[ks][bj][n].y = (unsigned)(q_ >> 32); }
        }
#pragma unroll
        for (int ks = 0; ks < S; ++ks)
#pragma unroll
            for (int bj = 0; bj < 2; ++bj)
#pragma unroll
                for (int n = 0; n < 2; ++n) { const u32x2v q = ld[ks][bj][n];
                    v[bj][n] += (f32x4){__uint_as_float(q.x << 16), __uint_as_float(q.x & 0xffff0000u), __uint_as_float(q.y << 16), __uint_as_float(q.y & 0xffff0000u)}; }
        const int rl = pm * 256 + ai * 128 + wr * 64 + m * 16 + fr, row = MP + rl;
        const int col0 = pn * 256 + wc * 32 + 4 * fq;
        if (mode == pg8::EM_RESID) {
            float s = 0.f; u32x2v xiv[2][2];
#pragma unroll
            for (int bj = 0; bj < 2; ++bj)
#pragma unroll
                for (int n = 0; n < 2; ++n) xiv[bj][n] = *(const u32x2v*)(xb + (size_t)row * D + col0 + bj * 128 + n * 16);
#pragma unroll
            for (int bj = 0; bj < 2; ++bj)
#pragma unroll
                for (int n = 0; n < 2; ++n) {
                    const int c = col0 + bj * 128 + n * 16;
                    const u32x2v q = xiv[bj][n];
                    const f32x4 xi = {__uint_as_float(q.x << 16), __uint_as_float(q.x & 0xffff0000u), __uint_as_float(q.y << 16), __uint_as_float(q.y & 0xffff0000u)};
                    const f32x4 y = xi + v[bj][n] * scale;
                    s += (y[0] * y[0] + y[1] * y[1]) + (y[2] * y[2] + y[3] * y[3]);
                    u32x2v wv; wv.x = pg8::cvt_pk_bf16(y[0], y[1]); wv.y = pg8::cvt_pk_bf16(y[2], y[3]);
                    *(u32x2v*)(xb + (size_t)row * D + c) = wv;
                }
            s += __shfl_xor(s, 16); s += __shfl_xor(s, 32);
            if (fq == 0) __hip_atomic_fetch_add(ssq_out + row, pg8::ssq_fix(s), __ATOMIC_RELAXED, __HIP_MEMORY_SCOPE_AGENT);
        } else {
            const float rs = __builtin_amdgcn_rsqf(pg8::ssq_val(ssq_in[row]) * (1.0f / 1024.0f) + 1e-6f);
#pragma unroll
            for (int bj = 0; bj < 2; ++bj)
#pragma unroll
                for (int n = 0; n < 2; ++n) {
                    const int c = col0 + bj * 128 + n * 16; const f32x4 y = v[bj][n] * rs;
                    u32x2v wv; wv.x = pg8::cvt_pk_bf16(y[0], y[1]); wv.y = pg8::cvt_pk_bf16(y[2], y[3]);
                    *(u32x2v*)(O + (size_t)row * ldc + c) = wv;
                }
        }
    }
}

template <int NB> __device__ __forceinline__ void attn_stage_tile(const bf16* src, int src_pitch, LAS unsigned char* lds, int tid) {
#pragma unroll 1
    for (int i0 = 0; i0 < 16; i0 += NB) {
        u32x4v v[NB];
#pragma unroll
        for (int i = 0; i < NB; ++i) { const int p = tid + 512 * (i0 + i), row = p >> 5, c16 = p & 31; v[i] = *(const u32x4v*)(src + (size_t)row * src_pitch + c16 * 8); }
#pragma unroll
        for (int i = 0; i < NB; ++i) { const int p = tid + 512 * (i0 + i), row = p >> 5, c16 = p & 31; *(LAS u32x4v*)(lds + row * 528 + c16 * 16) = v[i]; }
    }
}
__device__ __forceinline__ void attn_prompt_unit(int l, int b, int h, int qt, const bf16* Q, const bf16* KBp, const bf16* VTp, bf16* O, LAS unsigned char* lds, int tid) {
    const int lane = tid & 63, w = tid >> 6, r32 = lane & 31, hh = lane >> 5;
    const int row0 = b * 2048 + qt * 256 + w * 32;
    const bf16* qp = Q + (size_t)(row0 + r32) * D + h * 256 + 8 * hh;
    bf16x8 qa = *(const bf16x8*)(qp), qb = *(const bf16x8*)(qp + 16), qc = *(const bf16x8*)(qp + 32), qd = *(const bf16x8*)(qp + 48);
    attn_stage_tile<16>(KBp + ((size_t)l * 2048 + b * 256) * D + h * 256, D, lds, tid);
    __syncthreads();
    f32x16 S[8];
#pragma unroll
    for (int mt = 0; mt < 8; ++mt)
#pragma unroll
        for (int r = 0; r < 16; ++r) S[mt][r] = 0.f;
    const LAS unsigned char* kl0 = lds + r32 * 528 + 16 * hh; const LAS unsigned char* kl1 = kl0 + 4 * 32 * 528;
#pragma unroll 1
    for (int s2 = 0; s2 < 8; ++s2) {
        const int sn = (s2 < 6) ? s2 + 2 : 7;
        const bf16x8 qna = *(const bf16x8*)(qp + 32 * sn), qnb = *(const bf16x8*)(qp + 32 * sn + 16);
#pragma unroll
        for (int mt = 0; mt < 4; ++mt) {
            const bf16x8 kf0 = *(const LAS bf16x8*)(kl0 + mt * 32 * 528 + 64 * s2), kf1 = *(const LAS bf16x8*)(kl1 + mt * 32 * 528 + 64 * s2);
            S[mt] = __builtin_amdgcn_mfma_f32_32x32x16_bf16(kf0, qa, S[mt], 0, 0, 0);
            S[mt + 4] = __builtin_amdgcn_mfma_f32_32x32x16_bf16(kf1, qa, S[mt + 4], 0, 0, 0);
        }
#pragma unroll
        for (int mt = 0; mt < 4; ++mt) {
            const bf16x8 kf0 = *(const LAS bf16x8*)(kl0 + mt * 32 * 528 + 64 * s2 + 32), kf1 = *(const LAS bf16x8*)(kl1 + mt * 32 * 528 + 64 * s2 + 32);
            S[mt] = __builtin_amdgcn_mfma_f32_32x32x16_bf16(kf0, qb, S[mt], 0, 0, 0);
            S[mt + 4] = __builtin_amdgcn_mfma_f32_32x32x16_bf16(kf1, qb, S[mt + 4], 0, 0, 0);
        }
        qa = qc; qb = qd; qc = qna; qd = qnb;
    }
    __syncthreads();
    float mx = -3.0e38f;
#pragma unroll
    for (int mt = 0; mt < 8; ++mt)
#pragma unroll
        for (int r = 0; r < 16; ++r) mx = fmaxf(mx, S[mt][r]);
    mx = fmaxf(mx, __shfl_xor(mx, 32));
    const float c2 = 0.0625f * 1.4426950408889634f;
    float lsum = 0.f;
    bf16x8 pf[8][2];
#pragma unroll
    for (int mt = 0; mt < 8; ++mt) {
#pragma unroll
        for (int r = 0; r < 16; ++r) { const float p = __builtin_amdgcn_exp2f((S[mt][r] - mx) * c2); S[mt][r] = p; lsum += p; }
#pragma unroll
        for (int sp = 0; sp < 2; ++sp) {
            u32x4v pw; pw.x = pg8::cvt_pk_bf16(S[mt][8 * sp + 0], S[mt][8 * sp + 1]); pw.y = pg8::cvt_pk_bf16(S[mt][8 * sp + 2], S[mt][8 * sp + 3]);
            pw.z = pg8::cvt_pk_bf16(S[mt][8 * sp + 4], S[mt][8 * sp + 5]); pw.w = pg8::cvt_pk_bf16(S[mt][8 * sp + 6], S[mt][8 * sp + 7]);
            pf[mt][sp] = __builtin_bit_cast(bf16x8, pw);
        }
    }
    lsum += __shfl_xor(lsum, 32);
    const float il = 1.0f / lsum;
    attn_stage_tile<8>(VTp + (((size_t)l * 8 + b) * 4 + h) * 65536, 256, lds, tid);
    __syncthreads();
    const LAS unsigned char* vl = lds + r32 * 528 + 8 * hh;
    bf16* orow = O + (size_t)(row0 + r32) * D + h * 256;
#pragma unroll 1
    for (int dg = 0; dg < 2; ++dg) {
        f32x16 acc[4];
#pragma unroll
        for (int q = 0; q < 4; ++q)
#pragma unroll
            for (int r = 0; r < 16; ++r) acc[q][r] = 0.f;
        const LAS unsigned char* vb = vl + dg * 4 * 32 * 528;
#pragma unroll
        for (int mt = 0; mt < 8; ++mt) {
#pragma unroll
            for (int sp = 0; sp < 2; ++sp) {
                const int m0 = mt * 32 + 16 * sp;
#pragma unroll
                for (int q = 0; q < 4; ++q) {
                    const LAS unsigned char* vq = vb + q * 32 * 528 + m0 * 2;
                    const s16x4 lo = *(const LAS s16x4*)vq, hi = *(const LAS s16x4*)(vq + 16);
                    const bf16x8 vf = (bf16x8){lo[0], lo[1], lo[2], lo[3], hi[0], hi[1], hi[2], hi[3]};
                    acc[q] = __builtin_amdgcn_mfma_f32_32x32x16_bf16(vf, pf[mt][sp], acc[q], 0, 0, 0);
                }
            }
            asm volatile("" ::: "memory");
        }
#pragma unroll
        for (int q = 0; q < 4; ++q)
#pragma unroll
            for (int g2 = 0; g2 < 2; ++g2) {
                const int ga = 8 * g2, gb = 8 * g2 + 4;
                unsigned ax = pg8::cvt_pk_bf16(acc[q][ga] * il, acc[q][ga + 1] * il), ay = pg8::cvt_pk_bf16(acc[q][ga + 2] * il, acc[q][ga + 3] * il);
                unsigned bx = pg8::cvt_pk_bf16(acc[q][gb] * il, acc[q][gb + 1] * il), by = pg8::cvt_pk_bf16(acc[q][gb + 2] * il, acc[q][gb + 3] * il);
                asm volatile("s_nop 1" : "+v"(ax), "+v"(bx), "+v"(ay), "+v"(by));
                { auto r_ = __builtin_amdgcn_permlane32_swap(ax, bx, false, false); ax = r_[0]; bx = r_[1]; }
                { auto r_ = __builtin_amdgcn_permlane32_swap(ay, by, false, false); ay = r_[0]; by = r_[1]; }
                u32x4v wv; wv.x = ax; wv.y = ay; wv.z = bx; wv.w = by;
                *(u32x4v*)(orow + (dg * 4 + q) * 32 + 16 * g2 + 8 * hh) = wv;
            }
    }
    __syncthreads();
}
__device__ __forceinline__ void attn_sample_unit(int l, int b, int h, const bf16* Q, const float* CK, const float* CV, bf16* O, LAS unsigned char* lds, int tid) {
    const int lane = tid & 63, w = tid >> 6;
    LAS float* red = (LAS float*)lds;
    LAS float* ml = red + 16384;
    float qv[8][4];
#pragma unroll
    for (int t = 0; t < 8; ++t) { const u32x2v qq = *(const u32x2v*)(Q + (size_t)(MP + b * 8 + t) * D + h * 256 + 4 * lane);
        qv[t][0] = __uint_as_float(qq.x << 16); qv[t][1] = __uint_as_float(qq.x & 0xffff0000u); qv[t][2] = __uint_as_float(qq.y << 16); qv[t][3] = __uint_as_float(qq.y & 0xffff0000u); }
    const size_t base = (((size_t)l * 128 + b) * 256 + w * 32) * D + h * 256 + 4 * lane;
    const float* kbase = CK + base; const float* vbase = CV + base;
    float sc[32];
    f32x4 vr[16];
#pragma unroll
    for (int bt = 0; bt < 4; ++bt) {
        f32x4 kr[8];
#pragma unroll
        for (int i = 0; i < 8; ++i) kr[i] = *(const f32x4*)(kbase + (size_t)(bt * 8 + i) * D);
        if (bt < 2) {
#pragma unroll
            for (int i = 0; i < 8; ++i) vr[bt * 8 + i] = *(const f32x4*)(vbase + (size_t)(bt * 8 + i) * D);
        }
#pragma unroll
        for (int i = 0; i < 8; ++i) {
            float part[8];
            const f32x2 klo = {kr[i].x, kr[i].y}, khi = {kr[i].z, kr[i].w};
#pragma unroll
            for (int t = 0; t < 8; ++t) { const f32x2 ql = {qv[t][0], qv[t][1]}, qh = {qv[t][2], qv[t][3]}; f32x2 a2 = ql * klo; a2 = qh * khi + a2; part[t] = a2.x + a2.y; }
            sc[bt * 8 + i] = reduce8(part, lane) * 0.0625f;
        }
    }
    f32x4 vr2[16];
#pragma unroll
    for (int i = 0; i < 16; ++i) vr2[i] = *(const f32x4*)(vbase + (size_t)(16 + i) * D);
    float mx = sc[0];
#pragma unroll
    for (int i = 1; i < 32; ++i) mx = fmaxf(mx, sc[i]);
    float lsum = 0.f;
#pragma unroll
    for (int i = 0; i < 32; ++i) { sc[i] = fexp(sc[i] - mx); lsum += sc[i]; }
    f32x4 acc[8];
#pragma unroll
    for (int t = 0; t < 8; ++t) acc[t] = (f32x4){0.f, 0.f, 0.f, 0.f};
#pragma unroll
    for (int i = 0; i < 32; ++i) {
        const f32x4 vrow = (i < 16) ? vr[i & 15] : vr2[i & 15];
#pragma unroll
        for (int t = 0; t < 8; ++t) {
            const int src = ((t & 4) ? 32 : 0) + ((t & 2) ? 16 : 0) + ((t & 1) ? 8 : 0);
            const float p = __builtin_bit_cast(float, __builtin_amdgcn_readlane(__builtin_bit_cast(int, sc[i]), src));
            acc[t] += vrow * p;
        }
    }
#pragma unroll
    for (int t = 0; t < 8; ++t) *(LAS f32x4*)(red + (w * 8 + t) * 256 + 4 * lane) = acc[t];
    if ((lane & 7) == 0) { const int t = ((lane >> 5) & 1) * 4 + ((lane >> 4) & 1) * 2 + ((lane >> 3) & 1); ml[w * 16 + t] = mx; ml[w * 16 + 8 + t] = lsum; }
    __syncthreads();
    {
        const int t = w; float M = -3.0e38f;
#pragma unroll
        for (int ww = 0; ww < 8; ++ww) M = fmaxf(M, ml[ww * 16 + t]);
        float L = 0.f; f32x4 s = (f32x4){0.f, 0.f, 0.f, 0.f};
#pragma unroll
        for (int ww = 0; ww < 8; ++ww) { const float f = fexp(ml[ww * 16 + t] - M); L += ml[ww * 16 + 8 + t] * f; s += *(const LAS f32x4*)(red + (ww * 8 + t) * 256 + 4 * lane) * f; }
        const float il = 1.0f / L;
        u32x2v o; o.x = pk2(s.x * il, s.y * il); o.y = pk2(s.z * il, s.w * il);
        *(u32x2v*)(O + (size_t)(MP + b * 8 + t) * D + h * 256 + 4 * lane) = o;
    }
    __syncthreads();
}


constexpr int REP_R2B = 0, REP_CONV = 1, REP_O1 = 1, REP_BAR = 0, REP_RESID_K = -1, REP_ATTS = 1, REP_R1 = 1, REP_R2 = 1, REP_O3A = 1, REP_O3B = 1, REP_O3 = 1, REP_EVEN = 1, REP_ATT = 1, REP_PRO = 1, REP_GEMM_K = -1  ;
__global__ void __launch_bounds__(NTHR, 2) hybrid_fwd(Args a_unused) {
#define KA (kargs())
    extern __shared__ __attribute__((aligned(16))) unsigned char lds_raw[];
    LAS unsigned char* lds = (LAS unsigned char*)lds_raw;
    volatile LAS unsigned* MISC = (volatile LAS unsigned*)(lds + MISC_OFF);
    LAS float* prm = (LAS float*)(lds + PRM_OFF);
    const int wave0 = __builtin_amdgcn_readfirstlane((int)threadIdx.x >> 6);
#define tid0 (wave0 * 64 + lane_id_v())
    const int G = gridDim.x, bx = blockIdx.x;
    const int vcu = (G % 8 == 0) ? (bx % 8) * (G / 8) + bx / 8 : bx;

#define WSP (KA->ws)
#define SSQ ((pg8::ssq_t*)(KA->ws + WS_CTL + CTL_SSQ_OFF))
#define SSQM ((const float*)(KA->ws + WS_CTL + CTL_SSQM_OFF))
    unsigned* ctl = (unsigned*)(KA->ws + WS_CTL);
#define B_XB ((bf16*)(KA->ws + WS_XB))
#define B_HB ((bf16*)(KA->ws + WS_HB))
#define B_PB ((bf16*)(KA->ws + WS_PB))
#define B_YM ((bf16*)(KA->ws + WS_YM))
#define B_QB ((bf16*)(KA->ws + WS_QB))
#define B_OB ((bf16*)(KA->ws + WS_OB))
#define B_DS ((bf16*)(KA->ws + WS_DS))
#define B_SB ((bf16*)(KA->ws + WS_DS + 32 * MiB))
#define B_DEC ((float*)(KA->ws + WS_DEC))
#define B_LB ((bf16*)(KA->ws + WS_LB))
#define B_AP ((bf16*)(KA->ws + WS_AP))
#define B_KB ((bf16*)(KA->ws + WS_KB))
#define B_VT ((bf16*)(KA->ws + WS_VT))

    for (int u = tid0; u < (LDS_BYTES - LDSCTL_OFF) / 4; u += NTHR) ((LAS unsigned*)(lds + LDSCTL_OFF))[u] = 0u;
    __syncthreads();
    XcdBarrier bar = xcd_barrier_post(ctl + CW_BAR, MISC + 8); bar.w0 = wave0;
#define GRID_BAR() xcd_barrier(bar)

    for (int rep = 0; rep < REP_PRO; ++rep) { p0_prologue(KA, lds, vcu, G, tid0); __syncthreads(); }
    __syncthreads();
    GRID_BAR();
    for (int r9 = 0; r9 < REP_BAR; ++r9) GRID_BAR();

#define NEW_E() pg8::EpiAny E; E.p0 = nullptr; E.p1 = nullptr; E.p2 = nullptr; E.p3 = nullptr; E.ldc = 0; E.scale = 0.f; E.mode = 0
#define RUN_GEMM(Aptr, Btptr, Mv, Nv, Kv, LDv, Sv, Gv, Cv) do { pg8::Gemm g_{(const pg8::bf16_t*)(Aptr), (const pg8::bf16_t*)(Btptr), (Mv), (Nv), (Kv), (LDv)}; pg8::StaticOrder S_; S_.init((Mv), (Nv), (Gv), (Cv), (Sv)); \
        pg8::gemm_phase<pg8::EpiAny, pg8::StaticOrder, true, true>(lds, g_, S_, E, wave0); } while (0)

#pragma unroll 1
    for (int step = 1; step < 19; ++step) {
        const int l = (step - 1) / 9, k = (step == 0) ? -1 : (step - 1) % 9;
        pg8::ssq_t* ssq_l = SSQ + (size_t)(4 * l) * MT;
        int bxl = bx, Gl = G; asm volatile("" : "+s"(bxl), "+s"(Gl));
#define tid tid0
#define gtid (bxl * NTHR + tid0)
        if (k == 3) {
            if (l == 0) {
                if (tid < 512) { const float* hl = KA->in[I_HLB]; prm[tid] = 1.0f / (1.0f + fexp(hl[512 + tid] - hl[tid])); }
                __syncthreads();
                for (int rep = 0; rep < REP_EVEN; ++rep)
                for (int cid = bxl; cid < NCHP; cid += Gl) hgrn_a64(cid, B_PB, B_DS, B_DEC, prm, lds, tid);
                for (int j = bxl; j < NCHS; j += Gl) hgrn_sample_unit(j, B_PB, KA->in[I_SHGRN], KA->out + O_HGRNS, KA->in[I_HGN], B_YM, prm, lds, tid);
                for (int r4 = 0; r4 < REP_CONV; ++r4) conv_phase(B_PB, KA->in[I_CONVW], KA->in[I_SCONV], B_YM, KA->out + O_CONVP, KA->out + O_CONVS, gtid, (Gl * NTHR));
                GRID_BAR();
                chunk_scan<true>(B_DS, B_SB, B_DEC, KA->out + O_HGRNP, gtid, (Gl * NTHR));
                GRID_BAR();
                for (int rep = 0; rep < REP_EVEN; ++rep)
                for (int cid = bxl; cid < NCHP; cid += Gl) hgrn_c64(cid, B_PB, B_SB, KA->in[I_HGN], B_YM, prm, lds, tid);
                GRID_BAR();
                continue;
            } else {
                if (tid < 64) prm[tid] = __builtin_amdgcn_exp2f(-(float)tid * (13.287712379549449f / 64.0f));
                __syncthreads();
                for (int r4 = 0; r4 < REP_O1; ++r4) {
                for (int cid = bxl; cid < NCHP; cid += Gl) ret_a64(cid, B_PB, B_DS, prm, lds, tid);
                for (int j = bxl; j < NCHS; j += Gl) ret_sample_unit(j, B_PB, KA->in[I_SRET], KA->out + O_RETS, KA->in[I_RGN], B_YM, prm, lds, tid);
                lora_prep_phase(B_PB, KA->in[I_MU], KA->in[I_SSHIFT], B_AP, KA->out + O_SHIFTP, KA->out + O_SHIFTS, gtid, (Gl * NTHR));
                }
                GRID_BAR();
                chunk_scan<false>(B_DS, B_SB, B_DEC, KA->out + O_RETP, gtid, (Gl * NTHR));
            }
        }
        if (k == 4 && l == 1) {
            for (int r2 = 0; r2 < REP_R1; ++r2)
            for (int cu4 = bxl; cu4 < NRC / 4; cu4 += Gl) rwkv_r1_unit4(cu4, KA, B_PB, B_LB, WSP + WS_RREC, (float*)(WSP + WS_RGB), lds, tid);
            GRID_BAR();
            for (int r2 = 0; r2 < REP_R2; ++r2)
            if (bxl < 64) rwkv_r2_prompt(bxl >> 3, bxl & 7, KA, WSP + WS_RREC, (const float*)(WSP + WS_RGB), B_YM, lds, tid);
            else {
                for (int u = bxl - 64; u < 1024; u += Gl - 64) rwkv_r2_sample(u >> 3, u & 7, KA, WSP + WS_RREC, (const float*)(WSP + WS_RGB), B_YM, lds, tid);
                for (int i = bxl - 64; i < NCHP; i += Gl - 64) ret_c64(i, B_PB, B_SB, KA->in[I_RGN], B_YM, prm, lds, tid);
            }
            GRID_BAR();
            if (REP_R2B) { if (bxl < 64) rwkv_r2_prompt<true>(bxl >> 3, bxl & 7, KA, WSP + WS_RREC, (const float*)(WSP + WS_RGB), B_YM, lds, tid); GRID_BAR(); }
        }
        if (k == 6) {
            const int ll = l;
#pragma unroll 1
            for (int ph = 0; ph < 2; ++ph) {
                if (((ph ^ (bxl >> 3)) & 1) == 0) attn_prompt_unit(ll, bxl >> 5, (bxl >> 3) & 3, bxl & 7, B_QB, B_KB, B_VT, B_OB, lds, tid);
                else for (int i = bxl; i < 512; i += Gl) attn_sample_unit(ll, i >> 2, i & 3, B_QB, KA->in[I_CMK], KA->in[I_CMV], B_OB, lds, tid);
            }
            GRID_BAR();
        }
        NEW_E();
        const void* gA; const void* gB; int gM = MT, gN = D, gK = D;
        switch (k) {
        case -1: E.mode = pg8::EM_MEMKV; E.p1 = SSQM; E.p0 = KA->out + O_MKP; E.p3 = B_KB;
            gA = WSP + WS_MEMB; gB = WSP + WS_WKV; gM = 2048; gN = 4096; break;
        case 0: case 7: E.mode = pg8::EM_SWIGLU; E.p0 = B_HB; E.ldc = FF; E.p1 = (const float*)(ssq_l + (k == 0 ? 0 : 3) * (size_t)MT);
            gA = B_XB; gB = WSP + (k == 0 ? WS_GU1 : WS_GU2) + l * SZ_GU; gN = NGU; break;
        case 1: case 8: E.mode = pg8::EM_RESID; E.scale = 0.5f; E.p0 = B_XB; E.p3 = ssq_l + (k == 1 ? 1 : 4) * (size_t)MT;
            gA = B_HB; gB = WSP + (k == 1 ? WS_DN1 : WS_DN2) + l * SZ_DN; gK = FF; break;
        case 2: E.mode = pg8::EM_SCALE; E.p0 = B_PB; E.ldc = PLD; E.p1 = (const float*)(ssq_l + 1 * (size_t)MT);
            gA = B_XB; gB = WSP + WS_WIN + l * SZ_WIN; gN = (l == 0 ? EIN : OIN); break;
        case 3: E.mode = pg8::EM_SCALE; E.p0 = B_LB; E.ldc = 1536; E.p1 = nullptr;
            gA = B_AP; gB = WSP + WS_LORA; gN = 1536; gK = 256; break;
        case 4: E.mode = pg8::EM_RESID; E.scale = 1.0f; E.p0 = B_XB; E.p3 = ssq_l + 2 * (size_t)MT;
            gA = B_YM; gB = WSP + WS_WOUT + l * SZ_SQ; break;
        case 5: E.mode = pg8::EM_SCALE; E.p0 = B_QB; E.ldc = D; E.p1 = (const float*)(ssq_l + 2 * (size_t)MT);
            gA = B_XB; gB = WSP + WS_WQ + l * SZ_SQ; break;
        default:   E.mode = pg8::EM_RESID; E.scale = 1.0f; E.p0 = B_XB; E.p3 = ssq_l + 3 * (size_t)MT;
            gA = B_OB; gB = WSP + WS_WO + l * SZ_SQ; break;
        }
#ifndef X_NO_GEMM
        const bool tail11 = (k == 1 || k == 8);
        const bool tail4 = (l == 1 && G == 256 && (k == 4 || k == 5 || k == 6));
        const bool tail = tail11 || tail4;
        const bool ride = (l == 0 && k == 4 && G == 256);
        const int tS = tail11 ? 11 : 4;
        unsigned* tflag = ctl + 8192 + 64 * (l * 9 + k);
        const pg8::EpiAny Emain = E; const void* gAmain = gA; const int gKmain = gK;
#pragma unroll 1
        for (int pass = 0; pass < ((tail || ride) ? 2 : 1); ++pass) {
            int gG = G, gC = bx, gS = 1, gLD = gK;
            if (tail && pass == 0) {
                gS = tS; pg8::EpiAny E2 = E; E2.mode = pg8::EM_PARTIAL; E2.p0 = WSP + WS_SLAB; E2.ldc = gS; E = E2;
                gA = (const bf16*)gA + (size_t)MP * gK; gM = MS; gLD = gK; gK = gK / gS;
            }
            if (tail && pass == 1) { E = Emain; gA = gAmain; gK = gKmain; gLD = gKmain; gM = MP; }
            if (ride && pass == 1) {
                pg8::EpiAny E2 = E; E2.mode = pg8::EM_MEMKV; E2.p1 = SSQM; E2.p0 = KA->out + O_MKP; E2.p3 = B_KB; E = E2;
                gA = WSP + WS_MEMB; gB = WSP + WS_WKV; gM = 2048; gN = 4096; gK = D; gLD = D; gG = 128; gC = (bx >= 16 && bx < 144) ? bx - 16 : 128;
            }
            RUN_GEMM(gA, gB, gM, gN, gK, gLD, gS, gG, gC);
            if (tail && pass == 0) {
                asm volatile("s_waitcnt vmcnt(0)" ::: "memory");
                __syncthreads();
                const int nit = 16 * tS, mine = (bx < nit) ? (nit - bx + G - 1) / G : 0;
                if (tid0 == 0 && mine > 0) (void)xb_add(tflag, (unsigned)mine);
            }
        }
        if (REP_GEMM_K >= 0 && k == REP_GEMM_K) { RUN_GEMM(gA, gB, gM, gN, gK, gK, 1, G, bx); }
        if (l == 0 && G == 256) {
            unsigned wm = 0u; int wb0 = 256;
            if (k == 0) { wm = WMASK_T0; wb0 = 216; } else if (k == 2) { wm = WMASK_T2; wb0 = 184; } else if (k == 4) { wm = WMASK_T4; wb0 = 144; }
            else if (k == 5) { wm = WMASK_T5; wb0 = 16; } else if (k == 6) { wm = WMASK_T6; wb0 = 16; }
            if (wm != 0u && bx >= wb0) convert_weights(KA, lds, wm, (bx - wb0) * NWAVES + (tid >> 6), (256 - wb0) * NWAVES, tid);
        }
        const int cb0 = (Gl == 256) ? (tail11 ? 176 : 128) : 0, cG = Gl - cb0;
        if (tail && bxl >= cb0) {
            if (tid0 == 0) XB_SPIN(xb_ld(tflag) < (unsigned)(16 * tS), bar.bar);
            __syncthreads();
            pg8::ssq_t* so = SSQ + (size_t)(4 * l) * MT + (size_t)(k == 1 ? 1 : k == 4 ? 2 : k == 6 ? 3 : 4) * MT;
            if (tail11) tail_combine<11>(pg8::EM_RESID, (const bf16*)(WSP + WS_SLAB), B_XB, so, 0.5f, nullptr, 0, nullptr, bxl - cb0, cG, tid);
            else if (k == 5) tail_combine<4>(pg8::EM_SCALE, (const bf16*)(WSP + WS_SLAB), nullptr, nullptr, 0.f, B_QB, D, SSQ + (size_t)(4 * l) * MT + (size_t)2 * MT, bxl - cb0, cG, tid);
            else tail_combine<4>(pg8::EM_RESID, (const bf16*)(WSP + WS_SLAB), B_XB, so, 1.0f, nullptr, 0, nullptr, bxl - cb0, cG, tid);
        }
#endif
        if (step == 0) continue;
        GRID_BAR();
    }
#undef tid
#undef gtid
    {
        const pg8::ssq_t* fs = SSQ + (size_t)8 * MT; const float* fg = KA->in[I_FN];
        const int tidf = tid0; const int lane = tidf & 63, wave = tidf >> 6;
        const int gw = vcu * NWAVES + wave, NGW = G * NWAVES;
        for (int m0 = gw; m0 < MT; m0 += 2 * NGW) {
            u32x2v xv[2][4]; float rs[2]; bool ok[2];
#pragma unroll
            for (int q = 0; q < 2; ++q) { const int m = m0 + q * NGW; ok[q] = m < MT; const int mm = ok[q] ? m : m0; rs[q] = pg8::ssq_val(fs[mm]);
                const u32x2v* xr = (const u32x2v*)(B_XB + (size_t)mm * D) + lane;
#pragma unroll
                for (int j = 0; j < 4; ++j) xv[q][j] = xr[64 * j]; }
            f32x4 gv[4]; const f32x4* gg = (const f32x4*)fg + lane;
#pragma unroll
            for (int j = 0; j < 4; ++j) gv[j] = gg[64 * j];
#pragma unroll
            for (int q = 0; q < 2; ++q) if (ok[q]) { const int m = m0 + q * NGW; const float r = __builtin_amdgcn_rsqf(rs[q] * (1.0f / 1024.0f) + 1e-6f);
                f32x4* yo = (f32x4*)(KA->out + O_Y + (size_t)m * D) + lane;
#pragma unroll
                for (int j = 0; j < 4; ++j) { const u32x2v qq = xv[q][j];
                    const f32x4 xi = {__uint_as_float(qq.x << 16), __uint_as_float(qq.x & 0xffff0000u), __uint_as_float(qq.y << 16), __uint_as_float(qq.y & 0xffff0000u)};
                    yo[64 * j] = xi * r * gv[j]; } }
        }
    }
}

extern "C" void kernel_launch(void* const* d_in, const int* in_sizes, int n_in, void* d_out, int out_size, void* d_ws, size_t ws_size, hipStream_t stream) {
    static int grid = 0;
    if (grid == 0) {
        if (n_in != N_IN || (size_t)out_size != O_END || ws_size < WS_END) { fprintf(stderr, "kernel_launch: unexpected shapes: n_in %d out %d ws %zu (need %zu)\n", n_in, out_size, ws_size, (size_t)WS_END); grid = -1; return; }
        int dev = 0, cus = 0, per_cu = 0;
        if (hipGetDevice(&dev) != hipSuccess || hipDeviceGetAttribute(&cus, hipDeviceAttributeMultiprocessorCount, dev) != hipSuccess) { grid = -1; return; }
        if (hipFuncSetAttribute((const void*)hybrid_fwd, hipFuncAttributeMaxDynamicSharedMemorySize, LDS_BYTES) != hipSuccess) { fprintf(stderr, "kernel_launch: hipFuncSetAttribute failed\n"); grid = -1; return; }
        if (hipOccupancyMaxActiveBlocksPerMultiprocessor(&per_cu, (const void*)hybrid_fwd, NTHR, LDS_BYTES) != hipSuccess || per_cu < 1) { fprintf(stderr, "kernel_launch: occupancy query says %d\n", per_cu); }
        (void)hipGetLastError();
        if (per_cu < 1 || cus != 256) { fprintf(stderr, "kernel_launch: %d CUs, %d workgroups per CU by the occupancy query; this kernel is built for 256 CUs x 1 resident workgroup: nothing launched\n", cus, per_cu); grid = -1; return; }
        grid = cus;
    }
    if (grid < 0) return;
    (void)hipMemsetAsync((char*)d_ws + WS_CTL, 0, CTL_ZERO_BYTES, stream);
    Args a{};
    for (int i = 0; i < N_IN; ++i) a.in[i] = (const float*)d_in[i];
    a.out = (float*)d_out; a.ws = (unsigned char*)d_ws;
    void* args[] = {&a};
    hipError_t e = hipLaunchCooperativeKernel((const void*)hybrid_fwd, dim3(grid), dim3(NTHR), args, LDS_BYTES, stream);
    if (e != hipSuccess) fprintf(stderr, "kernel_launch: cooperative launch failed: %s (grid %d)\n", hipGetErrorString(e), grid);
}
```
